# Optimizing an MI355X kernel written in HIP

```python
import math
import numpy as np
import jax
import jax.numpy as jnp
from jax import lax

D_MODEL = 1024
BATCH = 2
SEQ = 16384
DEPTH = 4

CTX_LEN = 256
GRID_W = 64
N_MIXERS = 4
GROUP_W = D_MODEL // N_MIXERS
D_FF = 4 * D_MODEL
NORM_EPS = 1e-6

S5_CH = 16
S5_GROUPS = GROUP_W // S5_CH
S5_STATE = 64
S5_DT_MIN = 1e-3
S5_DT_MAX = 1e-1

ML_HEADS = 4
ML_DH = GROUP_W // ML_HEADS
ML_CHUNK = 128
ML_CONV = 3

DA_HEADS = 4
DA_DQK = GROUP_W // (2 * DA_HEADS)
DA_DV = 2 * DA_DQK
Q_BLOCK = 128
ROPE_BASE = 10000.0

GLA_HEADS = 4
GLA_DK = GROUP_W // (2 * GLA_HEADS)
GLA_DV = GROUP_W // GLA_HEADS
GLA_RANK = 16
GLA_TAU = 16.0
GLA_CHUNK = 16

IN_WIDTHS = (
    GROUP_W,
    GROUP_W, GROUP_W, GROUP_W, GROUP_W, 4 * ML_HEADS,
    GROUP_W, GROUP_W, GROUP_W,
    GLA_HEADS * GLA_DK, GLA_HEADS * GLA_DK, GROUP_W, GROUP_W, 2 * GLA_RANK,
)
IN_DIM = sum(IN_WIDTHS)

kernel_name = 'hymba_style_s5_mlstm_diffattn_gla_dit'

F32 = jnp.float32


def rms_norm(x, g):
    xf = x.astype(F32)
    y = xf * lax.rsqrt(jnp.mean(xf * xf, axis=-1, keepdims=True) + NORM_EPS)
    return y * g.astype(F32)


def split_cols(z):
    idx = np.cumsum(IN_WIDTHS)[:-1].tolist()
    return jnp.split(z, idx, axis=-1)


def to_heads(t, n_heads, dh):
    return t.astype(F32).reshape(t.shape[0], t.shape[1], n_heads, dh).transpose(0, 2, 1, 3)


def merge_heads(t):
    b, h, l, d = t.shape
    return t.transpose(0, 2, 1, 3).reshape(b, l, h * d)


def rev(t, d, axis):
    return jnp.flip(t, axis=axis) if d == 1 else t


def short_conv(x, w, b):
    pad = w.shape[0] // 2
    y = lax.conv_general_dilated(x, w[:, None, :].astype(x.dtype), window_strides=(1,), padding=[(pad, pad)],
                                 dimension_numbers=('NWC', 'WIO', 'NWC'), feature_group_count=x.shape[-1])
    return y + b


def axial_rope(n_tok, dim):
    rows = n_tok // GRID_W
    row = jnp.repeat(jnp.arange(rows, dtype=F32), GRID_W)
    col = jnp.tile(jnp.arange(GRID_W, dtype=F32), rows)
    n_freq = dim // 4
    inv = ROPE_BASE ** (-jnp.arange(n_freq, dtype=F32) / n_freq)
    ang = jnp.concatenate([row[:, None] * inv, col[:, None] * inv], axis=-1)
    return jnp.cos(ang), jnp.sin(ang)


def apply_rope(x, cos, sin):
    c = cos[None, :, None, None, :]
    s = sin[None, :, None, None, :]
    x1, x2 = x[..., 0::2], x[..., 1::2]
    return jnp.stack([x1 * c - x2 * s, x1 * s + x2 * c], axis=-1).reshape(x.shape)


def s5_discretize(lam_re, lam_im, log_step, b_re, b_im):
    lam_re, lam_im = lam_re.astype(F32), lam_im.astype(F32)
    b_re, b_im = b_re.astype(F32), b_im.astype(F32)
    dt = jnp.exp(log_step.astype(F32))[:, None]
    mag = jnp.exp(lam_re * dt)
    lb_re, lb_im = mag * jnp.cos(lam_im * dt), mag * jnp.sin(lam_im * dt)
    den = lam_re * lam_re + lam_im * lam_im
    fr = ((lb_re - 1.0) * lam_re + lb_im * lam_im) / den
    fi = (lb_im * lam_re - (lb_re - 1.0) * lam_im) / den
    bb_re = fr[..., None] * b_re - fi[..., None] * b_im
    bb_im = fr[..., None] * b_im + fi[..., None] * b_re
    return lb_re, lb_im, bb_re, bb_im


def complex_linear_combine(e1, e2):
    a1r, a1i, b1r, b1i = e1
    a2r, a2i, b2r, b2i = e2
    return (a2r * a1r - a2i * a1i, a2r * a1i + a2i * a1r,
            a2r * b1r - a2i * b1i + b2r, a2r * b1i + a2i * b1r + b2i)


def s5_scan(u, lb_re, lb_im, bb_re, bb_im, h0_re, h0_im):
    bu_re = jnp.einsum('blgh,gph->blgp', u, bb_re)
    bu_im = jnp.einsum('blgh,gph->blgp', u, bb_im)
    bu_re = bu_re.at[:, 0].add(lb_re * h0_re - lb_im * h0_im)
    bu_im = bu_im.at[:, 0].add(lb_re * h0_im + lb_im * h0_re)
    a_re = jnp.broadcast_to(lb_re, bu_re.shape)
    a_im = jnp.broadcast_to(lb_im, bu_im.shape)
    _, _, h_re, h_im = lax.associative_scan(complex_linear_combine, (a_re, a_im, bu_re, bu_im), axis=1)
    return h_re, h_im


def s5_readout(h_re, h_im, c_re, c_im):
    return (jnp.einsum('blgp,ghp->blgh', h_re, c_re.astype(F32))
            - jnp.einsum('blgp,ghp->blgh', h_im, c_im.astype(F32)))


def s5_direction(u_ctx, u_lat, lam_re, lam_im, log_step, b_re, b_im, c_re, c_im, d, need_ctx):
    lb_re, lb_im, bb_re, bb_im = s5_discretize(lam_re, lam_im, log_step, b_re, b_im)
    uc, ul = rev(u_ctx, d, 1), rev(u_lat, d, 1)
    zero = jnp.zeros((uc.shape[0], S5_GROUPS, S5_STATE), F32)
    hc_re, hc_im = s5_scan(uc, lb_re, lb_im, bb_re, bb_im, zero, zero)
    hl_re, hl_im = s5_scan(ul, lb_re, lb_im, bb_re, bb_im, hc_re[:, -1], hc_im[:, -1])
    y_lat = rev(s5_readout(hl_re, hl_im, c_re, c_im), d, 1)
    y_ctx = rev(s5_readout(hc_re, hc_im, c_re, c_im), d, 1) if need_ctx else None
    return y_ctx, y_lat


def s5_mixer(u_ctx, u_lat, p, need_ctx):
    def grouped(u):
        return u.astype(F32).reshape(u.shape[0], u.shape[1], S5_GROUPS, S5_CH)
    uc, ul = grouped(u_ctx), grouped(u_lat)
    outs = [s5_direction(uc, ul, p['s5_lam_re'][d], p['s5_lam_im'][d], p['s5_log_step'][d],
                         p['s5_b_re'][d], p['s5_b_im'][d], p['s5_c_re'][d], p['s5_c_im'][d], d, need_ctx)
            for d in range(2)]
    d_skip = p['s5_d'].reshape(S5_GROUPS, S5_CH)

    def glu(y, u):
        y = (y + d_skip * u).reshape(u.shape[0], u.shape[1], GROUP_W)
        g = jax.nn.gelu(y)
        return g * jax.nn.sigmoid(g @ p['s5_glu_w'] + p['s5_glu_b'])

    y_lat = glu(outs[0][1] + outs[1][1], ul)
    y_ctx = glu(outs[0][0] + outs[1][0], uc) if need_ctx else None
    return y_ctx, y_lat


def mlstm_chunked(q, k, v, ig, lf, state, chunk, need_out):
    bsz, nh, n_tok, dh = q.shape
    nc = n_tok // chunk
    qc = q.reshape(bsz, nh, nc, chunk, dh)
    kc = k.reshape(bsz, nh, nc, chunk, dh)
    vc = v.reshape(bsz, nh, nc, chunk, dh)
    igc = ig.reshape(bsz, nh, nc, chunk)
    bcum = jnp.cumsum(lf.reshape(bsz, nh, nc, chunk), axis=-1)
    btot = bcum[..., -1]
    w = btot[..., None] - bcum + igc
    g = jnp.max(w, axis=-1)
    e = jnp.exp(w - g[..., None])
    c_chunk = jnp.einsum('bhcs,bhcsv,bhcsk->bhcvk', e, vc, kc)
    n_chunk = jnp.einsum('bhcs,bhcsk->bhck', e, kc)

    def step(carry, inp):
        c_st, n_st, m_st = carry
        bt, gt, ct, nt = inp
        m_new = jnp.maximum(bt + m_st, gt)
        a = jnp.exp(bt + m_st - m_new)
        s = jnp.exp(gt - m_new)
        c_new = a[..., None, None] * c_st + s[..., None, None] * ct
        n_new = a[..., None] * n_st + s[..., None] * nt
        return (c_new, n_new, m_new), (c_st, n_st, m_st)

    mv = lambda t: jnp.moveaxis(t, 2, 0)
    final, (c_prev, n_prev, m_prev) = lax.scan(step, state, (mv(btot), mv(g), mv(c_chunk), mv(n_chunk)))
    if not need_out:
        return None, final
    c_prev = jnp.moveaxis(c_prev, 0, 2)
    n_prev = jnp.moveaxis(n_prev, 0, 2)
    m_prev = jnp.moveaxis(m_prev, 0, 2)

    lower = jnp.tril(jnp.ones((chunk, chunk), bool))
    dmat = jnp.where(lower, bcum[..., :, None] - bcum[..., None, :] + igc[..., None, :], -jnp.inf)
    inter = bcum + m_prev[..., None]
    m_t = jnp.maximum(inter, jnp.max(dmat, axis=-1))
    sc = jnp.einsum('bhctd,bhcsd->bhcts', qc, kc) * jnp.exp(dmat - m_t[..., None])
    a_int = jnp.exp(inter - m_t)
    num = (jnp.einsum('bhcts,bhcsv->bhctv', sc, vc)
           + a_int[..., None] * jnp.einsum('bhcvk,bhctk->bhctv', c_prev, qc))
    den = jnp.sum(sc, axis=-1) + a_int * jnp.einsum('bhck,bhctk->bhct', n_prev, qc)
    h = num / jnp.maximum(jnp.abs(den), jnp.exp(-m_t))[..., None]
    return h.reshape(bsz, nh, n_tok, dh), final


def mlstm_prep(q_in, k_in, v, gates, p):
    bsz, n_tok = q_in.shape[:2]
    qk = jax.nn.silu(short_conv(jnp.concatenate([q_in, k_in], axis=-1).astype(F32), p['ml_conv_w'], p['ml_conv_b']))
    q, k = jnp.split(qk, 2, axis=-1)
    gt = (gates + p['ml_gate_b']).astype(F32).reshape(bsz, n_tok, 4, ML_HEADS).transpose(0, 2, 3, 1)
    ig = gt[:, 0::2]
    lf = jax.nn.log_sigmoid(gt[:, 1::2])
    return (to_heads(q, ML_HEADS, ML_DH), to_heads(k, ML_HEADS, ML_DH) * ML_DH ** -0.5,
            to_heads(v, ML_HEADS, ML_DH), ig, lf)


def mlstm_mixer(zc, zl, p, need_ctx):
    cq, ck, cv, cig, clf = mlstm_prep(zc[0], zc[1], zc[2], zc[4], p)
    lq, lk, lv, lig, llf = mlstm_prep(zl[0], zl[1], zl[2], zl[4], p)
    bsz = lq.shape[0]
    zero = (jnp.zeros((bsz, ML_HEADS, ML_DH, ML_DH), F32), jnp.zeros((bsz, ML_HEADS, ML_DH), F32),
            jnp.zeros((bsz, ML_HEADS), F32))
    h_lat, h_ctx = 0.0, 0.0
    for d in range(2):
        hc, st = mlstm_chunked(rev(cq, d, 2), rev(ck, d, 2), rev(cv, d, 2), rev(cig[:, d], d, 2),
                               rev(clf[:, d], d, 2), zero, ML_CHUNK, need_ctx)
        hl, _ = mlstm_chunked(rev(lq, d, 2), rev(lk, d, 2), rev(lv, d, 2), rev(lig[:, d], d, 2),
                              rev(llf[:, d], d, 2), st, ML_CHUNK, True)
        h_lat = h_lat + rev(hl, d, 2)
        if need_ctx:
            h_ctx = h_ctx + rev(hc, d, 2)
    gain = p['ml_norm_g'].reshape(ML_HEADS, 1, ML_DH)

    def finish(h, o):
        return jax.nn.sigmoid(o.astype(F32)) * merge_heads(rms_norm(h, gain))

    y_ctx = finish(h_ctx, zc[3]) if need_ctx else None
    return y_ctx, finish(h_lat, zl[3])


def diff_attention_mixer(zc, zl, p, layer_idx, need_ctx):
    def heads_qk(t):
        return t.astype(F32).reshape(t.shape[0], t.shape[1], DA_HEADS, 2, DA_DQK)

    def heads_v(t):
        return t.astype(F32).reshape(t.shape[0], t.shape[1], DA_HEADS, DA_DV)

    scale = DA_DQK ** -0.5
    bsz, n_tok = zl[0].shape[:2]
    cos, sin = axial_rope(n_tok, DA_DQK)
    ql = apply_rope(heads_qk(zl[0]), cos, sin) * scale
    kl = apply_rope(heads_qk(zl[1]), cos, sin)
    vl = heads_v(zl[2])
    qc, kc, vc = heads_qk(zc[0]) * scale, heads_qk(zc[1]), heads_v(zc[2])
    lam_init = 0.8 - 0.6 * math.exp(-0.3 * layer_idx)
    lp = p['da_lam'].astype(F32)
    lam = jnp.exp(jnp.sum(lp[0] * lp[1])) - jnp.exp(jnp.sum(lp[2] * lp[3])) + lam_init
    k_all = jnp.concatenate([kc, kl], axis=1)
    v_all = jnp.concatenate([vc, vl], axis=1)

    def attend(qb, keys, vals):
        s = jnp.einsum('bqhmd,bkhmd->bhmqk', qb, keys)
        pr = jax.nn.softmax(s, axis=-1)
        w = pr[:, :, 0] - lam * pr[:, :, 1]
        return jnp.einsum('bhqk,bkhv->bqhv', w, vals)

    nb = n_tok // Q_BLOCK
    qblocks = jnp.moveaxis(ql.reshape(bsz, nb, Q_BLOCK, DA_HEADS, 2, DA_DQK), 1, 0)
    o_l = lax.map(lambda qb: attend(qb, k_all, v_all), qblocks)
    o_l = jnp.moveaxis(o_l, 0, 1).reshape(bsz, n_tok, DA_HEADS, DA_DV)

    def finish(o):
        o = rms_norm(o, p['da_norm_g']) * (1.0 - lam_init)
        return o.reshape(o.shape[0], o.shape[1], GROUP_W)

    y_ctx = finish(attend(qc, kc, vc)) if need_ctx else None
    return y_ctx, finish(o_l)


def gla_chunked(q, k, v, la, s0, chunk, need_out):
    bsz, nh, n_tok, dk = q.shape
    dv = v.shape[-1]
    nc = n_tok // chunk
    qc = q.reshape(bsz, nh, nc, chunk, dk)
    kc = k.reshape(bsz, nh, nc, chunk, dk)
    vc = v.reshape(bsz, nh, nc, chunk, dv)
    bcum = jnp.cumsum(la.reshape(bsz, nh, nc, chunk, dk), axis=3)
    btot = bcum[:, :, :, -1]
    s_chunk = jnp.einsum('bhctk,bhctv->bhckv', kc * jnp.exp(btot[:, :, :, None] - bcum), vc)

    def step(s, inp):
        dec, sc = inp
        return jnp.exp(dec)[..., None] * s + sc, s

    s_final, s_prev = lax.scan(step, s0, (jnp.moveaxis(btot, 2, 0), jnp.moveaxis(s_chunk, 2, 0)))
    if not need_out:
        return None, s_final
    s_prev = jnp.moveaxis(s_prev, 0, 2)
    o_inter = jnp.einsum('bhctk,bhckv->bhctv', qc * jnp.exp(bcum), s_prev)
    lower = jnp.tril(jnp.ones((chunk, chunk), bool))[:, :, None]
    decay = jnp.exp(jnp.where(lower, bcum[:, :, :, :, None, :] - bcum[:, :, :, None, :, :], -jnp.inf))
    att = jnp.einsum('bhctk,bhcsk,bhctsk->bhcts', qc, kc, decay)
    o = o_inter + jnp.einsum('bhcts,bhcsv->bhctv', att, vc)
    return o.reshape(bsz, nh, n_tok, dv), s_final


def gla_prep(q, k, v, a_lr, p):
    bsz, n_tok = q.shape[:2]
    a_lr = a_lr.astype(F32).reshape(bsz, n_tok, 2, GLA_RANK)
    la = jax.nn.log_sigmoid(jnp.einsum('bldr,drk->bldk', a_lr, p['gla_alpha_w']) + p['gla_alpha_b']) / GLA_TAU
    la = la.reshape(bsz, n_tok, 2, GLA_HEADS, GLA_DK).transpose(2, 0, 3, 1, 4)
    return (to_heads(q, GLA_HEADS, GLA_DK) * GLA_DK ** -0.5, to_heads(k, GLA_HEADS, GLA_DK),
            to_heads(v, GLA_HEADS, GLA_DV), la)


def gla_mixer(zc, zl, p, need_ctx):
    cq, ck, cv, cla = gla_prep(zc[0], zc[1], zc[2], zc[4], p)
    lq, lk, lv, lla = gla_prep(zl[0], zl[1], zl[2], zl[4], p)
    zero = jnp.zeros((lq.shape[0], GLA_HEADS, GLA_DK, GLA_DV), F32)
    o_lat, o_ctx = 0.0, 0.0
    for d in range(2):
        oc, st = gla_chunked(rev(cq, d, 2), rev(ck, d, 2), rev(cv, d, 2), rev(cla[d], d, 2), zero, GLA_CHUNK, need_ctx)
        ol, _ = gla_chunked(rev(lq, d, 2), rev(lk, d, 2), rev(lv, d, 2), rev(lla[d], d, 2), st, GLA_CHUNK, True)
        o_lat = o_lat + rev(ol, d, 2)
        if need_ctx:
            o_ctx = o_ctx + rev(oc, d, 2)

    def finish(o, r):
        return merge_heads(rms_norm(o, p['gla_norm_g'])) * jax.nn.silu(r.astype(F32))

    y_ctx = finish(o_ctx, zc[3]) if need_ctx else None
    return y_ctx, finish(o_lat, zl[3])


def sq_relu_mlp(h, w1, w2):
    return jnp.square(jax.nn.relu(h @ w1)) @ w2


def hybrid_layer(x_lat, x_ctx, mod_lat, mod_ctx, p, layer_idx, need_ctx):
    sh1, sc1, g1, sh2, sc2, g2 = jnp.split(mod_lat[:, None, :], 6, axis=-1)
    csh1, csc1, cg1, csh2, csc2, cg2 = jnp.split(mod_ctx, 6, axis=-1)
    hl = rms_norm(x_lat, p['norm1_g']) * (1.0 + sc1) + sh1
    hc = rms_norm(x_ctx, p['norm1_g']) * (1.0 + csc1) + csh1
    zl = split_cols(hl @ p['w_in'])
    zc = split_cols(hc @ p['w_in'])
    s5 = s5_mixer(zc[0], zl[0], p, need_ctx)
    ml = mlstm_mixer(zc[1:6], zl[1:6], p, need_ctx)
    da = diff_attention_mixer(zc[6:9], zl[6:9], p, layer_idx, need_ctx)
    gl = gla_mixer(zc[9:14], zl[9:14], p, need_ctx)
    mix_l = jnp.concatenate([s5[1], ml[1], da[1], gl[1]], axis=-1) @ p['w_out']
    x_lat = x_lat + g1 * mix_l
    hl2 = rms_norm(x_lat, p['norm2_g']) * (1.0 + sc2) + sh2
    x_lat = x_lat + g2 * sq_relu_mlp(hl2, p['mlp_w1'], p['mlp_w2'])
    if need_ctx:
        mix_c = jnp.concatenate([s5[0], ml[0], da[0], gl[0]], axis=-1) @ p['w_out']
        x_ctx = x_ctx + cg1 * mix_c
        hc2 = rms_norm(x_ctx, p['norm2_g']) * (1.0 + csc2) + csh2
        x_ctx = x_ctx + cg2 * sq_relu_mlp(hc2, p['mlp_w1'], p['mlp_w2'])
    return x_lat, x_ctx


def setup_inputs(seed: int = 0) -> dict:
    key = jax.random.key(seed)
    ks = list(jax.random.split(key, 40))
    cnt = [0]

    def nk():
        cnt[0] += 1
        return ks[cnt[0] - 1]

    def nrm(shape, scale):
        return jax.random.normal(nk(), shape, F32) * scale

    L = DEPTH
    G, P = S5_GROUPS, S5_STATE
    f_bias = jnp.linspace(3.0, 6.0, ML_HEADS, dtype=F32)
    log_dt = (jax.random.uniform(nk(), (L, 2, G), F32) * (math.log(S5_DT_MAX) - math.log(S5_DT_MIN))
              + math.log(S5_DT_MIN))
    return {
        'x': nrm((BATCH, SEQ, D_MODEL), 1.0),
        'c': nrm((BATCH, D_MODEL), 1.0),
        'ctx': nrm((BATCH, CTX_LEN, D_MODEL), 1.0),
        'c_ctx': nrm((D_MODEL,), 1.0),
        'ada_w': nrm((L, D_MODEL, 6 * D_MODEL), 0.5 * D_MODEL ** -0.5),
        'ada_b': nrm((L, 6 * D_MODEL), 0.02),
        'norm1_g': 1.0 + nrm((L, D_MODEL), 0.02),
        'norm2_g': 1.0 + nrm((L, D_MODEL), 0.02),
        'w_in': nrm((L, D_MODEL, IN_DIM), D_MODEL ** -0.5),
        's5_lam_re': -0.5 + nrm((L, 2, G, P), 0.01),
        's5_lam_im': math.pi * jnp.arange(P, dtype=F32) + nrm((L, 2, G, P), 0.01),
        's5_log_step': log_dt,
        's5_b_re': nrm((L, 2, G, P, S5_CH), (2 * S5_CH) ** -0.5),
        's5_b_im': nrm((L, 2, G, P, S5_CH), (2 * S5_CH) ** -0.5),
        's5_c_re': nrm((L, 2, G, S5_CH, P), P ** -0.5),
        's5_c_im': nrm((L, 2, G, S5_CH, P), P ** -0.5),
        's5_d': nrm((L, GROUP_W), 1.0),
        's5_glu_w': nrm((L, GROUP_W, GROUP_W), GROUP_W ** -0.5),
        's5_glu_b': nrm((L, GROUP_W), 0.02),
        'ml_conv_w': nrm((L, ML_CONV, 2 * GROUP_W), ML_CONV ** -0.5),
        'ml_conv_b': nrm((L, 2 * GROUP_W), 0.02),
        'ml_gate_b': jnp.concatenate([nrm((L, ML_HEADS), 0.1), f_bias + nrm((L, ML_HEADS), 0.1),
                                      nrm((L, ML_HEADS), 0.1), f_bias + nrm((L, ML_HEADS), 0.1)], axis=-1),
        'ml_norm_g': 1.0 + nrm((L, GROUP_W), 0.02),
        'da_lam': nrm((L, 4, DA_DQK), 0.1),
        'da_norm_g': 1.0 + nrm((L, DA_DV), 0.02),
        'gla_alpha_w': nrm((L, 2, GLA_RANK, GLA_HEADS * GLA_DK), GLA_RANK ** -0.5),
        'gla_alpha_b': nrm((L, 2, GLA_HEADS * GLA_DK), 0.1),
        'gla_norm_g': 1.0 + nrm((L, GLA_DV), 0.02),
        'w_out': nrm((L, D_MODEL, D_MODEL), D_MODEL ** -0.5),
        'mlp_w1': nrm((L, D_MODEL, D_FF), D_MODEL ** -0.5),
        'mlp_w2': nrm((L, D_FF, D_MODEL), D_FF ** -0.5),
        'final_norm_g': 1.0 + nrm((D_MODEL,), 0.02),
    }


def reference(x, c, ctx, c_ctx, ada_w, ada_b, norm1_g, norm2_g, w_in, s5_lam_re, s5_lam_im, s5_log_step,
              s5_b_re, s5_b_im, s5_c_re, s5_c_im, s5_d, s5_glu_w, s5_glu_b, ml_conv_w, ml_conv_b, ml_gate_b,
              ml_norm_g, da_lam, da_norm_g, gla_alpha_w, gla_alpha_b, gla_norm_g, w_out, mlp_w1, mlp_w2,
              final_norm_g):
    x_lat, x_ctx = x, ctx
    for l in range(DEPTH):
        p = dict(norm1_g=norm1_g[l], norm2_g=norm2_g[l], w_in=w_in[l],
                 s5_lam_re=s5_lam_re[l], s5_lam_im=s5_lam_im[l], s5_log_step=s5_log_step[l],
                 s5_b_re=s5_b_re[l], s5_b_im=s5_b_im[l], s5_c_re=s5_c_re[l], s5_c_im=s5_c_im[l],
                 s5_d=s5_d[l], s5_glu_w=s5_glu_w[l], s5_glu_b=s5_glu_b[l],
                 ml_conv_w=ml_conv_w[l], ml_conv_b=ml_conv_b[l], ml_gate_b=ml_gate_b[l], ml_norm_g=ml_norm_g[l],
                 da_lam=da_lam[l], da_norm_g=da_norm_g[l],
                 gla_alpha_w=gla_alpha_w[l], gla_alpha_b=gla_alpha_b[l], gla_norm_g=gla_norm_g[l],
                 w_out=w_out[l], mlp_w1=mlp_w1[l], mlp_w2=mlp_w2[l])
        mod_lat = jax.nn.silu(c) @ ada_w[l] + ada_b[l]
        mod_ctx = jax.nn.silu(c_ctx) @ ada_w[l] + ada_b[l]
        x_lat, x_ctx = hybrid_layer(x_lat, x_ctx, mod_lat, mod_ctx, p, l, l < DEPTH - 1)
    return rms_norm(x_lat, final_norm_g)
```

```cpp
#include <hip/hip_runtime.h>
#include <hip/hip_cooperative_groups.h>
#include <stdint.h>
#include <stdio.h>
namespace cg = cooperative_groups;

#ifndef MEGA
#define MEGA 1
#endif

#define NT 256
typedef unsigned short ushort_t;
using bf16x8 = __attribute__((ext_vector_type(8))) short;
using f32x4 = __attribute__((ext_vector_type(4))) float;

constexpr int B_ = 2, SEQ = 16384, CTX = 256, TOK = SEQ + CTX, NTOK = B_ * TOK, DM = 1024, DEPTH = 4;
constexpr int IND = 2864, INDP = 2944, DFF = 4096, NCH = 130;
constexpr int MLST_SZ = 4224;
constexpr int GLST_SZ = 2112;
constexpr int SMEM_BYTES = 50 * 1024;

constexpr int ZC_S5U = 0, ZC_MLQ = 256, ZC_MLK = 512, ZC_MLV = 768, ZC_MLO = 1024, ZC_MLG = 1280;
constexpr int ZC_DAQ = 1296, ZC_DAK = 1552, ZC_DAV = 1808;
constexpr int ZC_GLQ = 2064, ZC_GLK = 2192, ZC_GLV = 2320, ZC_GLR = 2576, ZC_GLA = 2832;

struct Params {
  const float *x, *c, *ctx, *c_ctx, *ada_w, *ada_b, *norm1_g, *norm2_g, *w_in, *s5_lam_re, *s5_lam_im, *s5_log_step,
      *s5_b_re, *s5_b_im, *s5_c_re, *s5_c_im, *s5_d, *s5_glu_w, *s5_glu_b, *ml_conv_w, *ml_conv_b, *ml_gate_b,
      *ml_norm_g, *da_lam, *da_norm_g, *gla_alpha_w, *gla_alpha_b, *gla_norm_g, *w_out, *mlp_w1, *mlp_w2, *final_norm_g;
  float* out;
  float* xres;
  ushort_t* z;
  ushort_t* mix;
  ushort_t* hidden;
  ushort_t *wt_in, *wt_out, *w1t, *w2t, *glut;
  ushort_t* mlqk;
  ushort_t* s5g;
  float* mlst;
  float* mod;
  ushort_t* h;
  float* alpha;
  float* gates;
  float* s5st;
  float* glast;
};

__device__ __forceinline__ float bf2f(ushort_t u) { return __uint_as_float(((unsigned)u) << 16); }
__device__ __forceinline__ ushort_t f2bf(float f) {
  unsigned u = __float_as_uint(f);
  u += 0x7fffu + ((u >> 16) & 1u);
  return (ushort_t)(u >> 16);
}
__device__ __forceinline__ unsigned pack2(float a, float b) { return (unsigned)f2bf(a) | ((unsigned)f2bf(b) << 16); }
__device__ __forceinline__ float wave_sum(float v) {
#pragma unroll
  for (int o = 32; o; o >>= 1) v += __shfl_xor(v, o);
  return v;
}
__device__ __forceinline__ float sigmoidf_(float x) { return 1.f / (1.f + __expf(-x)); }
__device__ __forceinline__ float logsigmoidf_(float x) { return fminf(x, 0.f) - log1pf(__expf(-fabsf(x))); }
__device__ __forceinline__ void unpack8(uint4 v, float* f) {
  f[0] = __uint_as_float(v.x << 16); f[1] = __uint_as_float(v.x & 0xffff0000u);
  f[2] = __uint_as_float(v.y << 16); f[3] = __uint_as_float(v.y & 0xffff0000u);
  f[4] = __uint_as_float(v.z << 16); f[5] = __uint_as_float(v.z & 0xffff0000u);
  f[6] = __uint_as_float(v.w << 16); f[7] = __uint_as_float(v.w & 0xffff0000u);
}
__device__ __forceinline__ int dir_chunk(int d, int c) { return d == 0 ? c : (c < 2 ? 1 - c : 131 - c); }

__device__ void phase_init(const Params& P, int bid, int nblk, char* smem) {
  const int tid = threadIdx.x;
  size_t total4 = (size_t)NTOK * 256;
  for (size_t i = (size_t)bid * NT + tid; i < total4; i += (size_t)nblk * NT) {
    int r = (int)(i >> 8), c4 = (int)(i & 255);
    int b = r / TOK, t = r % TOK;
    const float4* src = (t < CTX) ? (const float4*)(P.ctx + ((size_t)(b * CTX + t)) * DM)
                                  : (const float4*)(P.x + ((size_t)(b * SEQ + t - CTX)) * DM);
    ((float4*)P.xres)[i] = src[c4];
  }
  float* sv = (float*)smem;
  float* red = sv + 3072;
  for (int i = tid; i < 3072; i += NT) {
    int row = i >> 10, k = i & 1023;
    float v = (row < 2) ? P.c[row * DM + k] : P.c_ctx[k];
    sv[i] = v / (1.f + expf(-v));
  }
  __syncthreads();
  for (int item = bid; item < 4 * 96; item += nblk) {
    int l = item / 96, cgp = item % 96;
    int jj = tid & 63, kq = tid >> 6;
    int col = cgp * 64 + jj;
    const float* w = P.ada_w + (size_t)l * DM * 6144 + col;
    float a0 = 0, a1 = 0, a2 = 0;
    for (int k = kq * 256; k < kq * 256 + 256; ++k) {
      float wv = w[(size_t)k * 6144];
      a0 += sv[k] * wv; a1 += sv[1024 + k] * wv; a2 += sv[2048 + k] * wv;
    }
    red[(kq * 3 + 0) * 64 + jj] = a0; red[(kq * 3 + 1) * 64 + jj] = a1; red[(kq * 3 + 2) * 64 + jj] = a2;
    __syncthreads();
    if (tid < 192) {
      int row = tid >> 6;
      float s = red[(0 * 3 + row) * 64 + jj] + red[(1 * 3 + row) * 64 + jj] + red[(2 * 3 + row) * 64 + jj] +
                red[(3 * 3 + row) * 64 + jj] + P.ada_b[l * 6144 + col];
      P.mod[(l * 3 + row) * 6144 + col] = s;
    }
    __syncthreads();
  }
}

__device__ void conv_tile(const float* __restrict__ W, int Nsrc, int K, ushort_t* Wt, int kt, int nt, int Nvalid, float* tile) {
  const int tid = threadIdx.x;
#pragma unroll
  for (int p = 0; p < 4; ++p) {
    int kk = p * 16 + (tid >> 4), nn = (tid & 15) * 4;
    int n = nt * 64 + nn;
    float4 v = make_float4(0, 0, 0, 0);
    if (n < Nvalid) v = *(const float4*)(W + (size_t)(kt * 64 + kk) * Nsrc + n);
    tile[kk * 65 + nn + 0] = v.x; tile[kk * 65 + nn + 1] = v.y; tile[kk * 65 + nn + 2] = v.z; tile[kk * 65 + nn + 3] = v.w;
  }
  __syncthreads();
#pragma unroll
  for (int p = 0; p < 4; ++p) {
    int nn = p * 16 + (tid >> 4), kk = (tid & 15) * 4;
    uint2 o;
    o.x = pack2(tile[(kk + 0) * 65 + nn], tile[(kk + 1) * 65 + nn]);
    o.y = pack2(tile[(kk + 2) * 65 + nn], tile[(kk + 3) * 65 + nn]);
    *(uint2*)(Wt + (size_t)(nt * 64 + nn) * K + kt * 64 + kk) = o;
  }
  __syncthreads();
}
__device__ void phase_convw(const Params& P, int l, int bid, int nblk, char* smem) {
  float* tile = (float*)smem;
  const int n0 = 16 * 46, n1 = n0 + 256, n2 = n1 + 1024, n3 = n2 + 1024, n4 = n3 + 16;
  for (int it = bid; it < n4; it += nblk) {
    if (it < n0) conv_tile(P.w_in + (size_t)l * DM * IND, IND, DM, P.wt_in, it / 46, it % 46, IND, tile);
    else if (it < n1) { int i = it - n0; conv_tile(P.w_out + (size_t)l * DM * DM, DM, DM, P.wt_out, i / 16, i % 16, DM, tile); }
    else if (it < n2) { int i = it - n1; conv_tile(P.mlp_w1 + (size_t)l * DM * DFF, DFF, DM, P.w1t, i / 64, i % 64, DFF, tile); }
    else if (it < n3) { int i = it - n2; conv_tile(P.mlp_w2 + (size_t)l * DFF * DM, DM, DFF, P.w2t, i / 16, i % 16, DM, tile); }
    else { int i = it - n3; conv_tile(P.s5_glu_w + (size_t)l * 256 * 256, 256, 256, P.glut, i / 4, i % 4, 256, tile); }
  }
}

__device__ void phase_norm(const Params& P, int l, int which, int bid, int nblk) {
  const int wid = threadIdx.x >> 6, lane = threadIdx.x & 63;
  const float* g = (which == 0 ? P.norm1_g : P.norm2_g) + l * DM;
  const int shoff = which == 0 ? 0 : 3072, scoff = shoff + 1024;
  for (int r = bid * 4 + wid; r < NTOK; r += nblk * 4) {
    int b = r / TOK, t = r % TOK;
    int mrow = (t < CTX) ? 2 : b;
    const float* md = P.mod + (l * 3 + mrow) * 6144;
    const float4* xr = (const float4*)(P.xres + (size_t)r * DM);
    float4 v[4];
    float ss = 0;
#pragma unroll
    for (int i = 0; i < 4; ++i) {
      v[i] = xr[lane + 64 * i];
      ss += v[i].x * v[i].x + v[i].y * v[i].y + v[i].z * v[i].z + v[i].w * v[i].w;
    }
    ss = wave_sum(ss);
    float rstd = rsqrtf(ss * (1.f / DM) + 1e-6f);
#pragma unroll
    for (int i = 0; i < 4; ++i) {
      int col = (lane + 64 * i) * 4;
      float4 gg = *(const float4*)(g + col);
      float4 sc = *(const float4*)(md + scoff + col);
      float4 sh = *(const float4*)(md + shoff + col);
      float y0 = v[i].x * rstd * gg.x * (1.f + sc.x) + sh.x;
      float y1 = v[i].y * rstd * gg.y * (1.f + sc.y) + sh.y;
      float y2 = v[i].z * rstd * gg.z * (1.f + sc.z) + sh.z;
      float y3 = v[i].w * rstd * gg.w * (1.f + sc.w) + sh.w;
      uint2 o; o.x = pack2(y0, y1); o.y = pack2(y2, y3);
      *(uint2*)(P.h + (size_t)r * DM + col) = o;
    }
  }
}

enum { G_ZIN = 0, G_GLU = 1, G_WOUT = 2, G_W1 = 3, G_W2 = 4 };
template <int MODE>
__device__ void gemm_phase(const Params& P, int l, const ushort_t* A, const ushort_t* Bt, int K, int ntn, int bid, int nblk, char* smem) {
  ushort_t* As = (ushort_t*)smem;
  ushort_t* Bs = As + 128 * 72;
  const int tid = threadIdx.x, wid = tid >> 6, lane = tid & 63, fr = lane & 15, fq = lane >> 4, wr = wid >> 1, wc = wid & 1;
  const int ntiles = (NTOK / 128) * ntn;
  const int nk = K / 64;
  for (int tile = bid; tile < ntiles; tile += nblk) {
    const int mt = tile / ntn, nt = tile % ntn;
    const int row0 = mt * 128, col0 = nt * 128;
    f32x4 acc[4][4];
#pragma unroll
    for (int m = 0; m < 4; ++m)
#pragma unroll
      for (int n = 0; n < 4; ++n) acc[m][n] = f32x4{0.f, 0.f, 0.f, 0.f};
    const ushort_t* Ag = A + (size_t)row0 * K;
    const ushort_t* Bg = Bt + (size_t)col0 * K;
    const int lrr = tid >> 3, lck = tid & 7;
    const ushort_t* Ap = Ag + (size_t)lrr * K + lck * 8;
    const ushort_t* Bp = Bg + (size_t)lrr * K + lck * 8;
    const size_t rs32 = (size_t)32 * K;
    uint4 ra0 = *(const uint4*)(Ap), ra1 = *(const uint4*)(Ap + rs32), ra2 = *(const uint4*)(Ap + 2 * rs32), ra3 = *(const uint4*)(Ap + 3 * rs32);
    uint4 rb0 = *(const uint4*)(Bp), rb1 = *(const uint4*)(Bp + rs32), rb2 = *(const uint4*)(Bp + 2 * rs32), rb3 = *(const uint4*)(Bp + 3 * rs32);
    ushort_t* Asw = As + lrr * 72 + lck * 8;
    ushort_t* Bsw = Bs + lrr * 72 + lck * 8;
    for (int kt = 0; kt < nk; ++kt) {
      *(uint4*)(Asw) = ra0; *(uint4*)(Asw + 32 * 72) = ra1; *(uint4*)(Asw + 64 * 72) = ra2; *(uint4*)(Asw + 96 * 72) = ra3;
      *(uint4*)(Bsw) = rb0; *(uint4*)(Bsw + 32 * 72) = rb1; *(uint4*)(Bsw + 64 * 72) = rb2; *(uint4*)(Bsw + 96 * 72) = rb3;
      __syncthreads();
      if (kt + 1 < nk) {
        const int ko = (kt + 1) * 64;
        ra0 = *(const uint4*)(Ap + ko); ra1 = *(const uint4*)(Ap + rs32 + ko); ra2 = *(const uint4*)(Ap + 2 * rs32 + ko); ra3 = *(const uint4*)(Ap + 3 * rs32 + ko);
        rb0 = *(const uint4*)(Bp + ko); rb1 = *(const uint4*)(Bp + rs32 + ko); rb2 = *(const uint4*)(Bp + 2 * rs32 + ko); rb3 = *(const uint4*)(Bp + 3 * rs32 + ko);
      }
#pragma unroll
      for (int ks = 0; ks < 2; ++ks) {
        bf16x8 a[4], b[4];
#pragma unroll
        for (int m = 0; m < 4; ++m) a[m] = *(const bf16x8*)(As + (wr * 64 + m * 16 + fr) * 72 + ks * 32 + fq * 8);
#pragma unroll
        for (int n = 0; n < 4; ++n) b[n] = *(const bf16x8*)(Bs + (wc * 64 + n * 16 + fr) * 72 + ks * 32 + fq * 8);
#pragma unroll
        for (int m = 0; m < 4; ++m)
#pragma unroll
          for (int n = 0; n < 4; ++n) acc[m][n] = __builtin_amdgcn_mfma_f32_16x16x32_bf16(a[m], b[n], acc[m][n], 0, 0, 0);
      }
      __syncthreads();
    }
#pragma unroll
    for (int m = 0; m < 4; ++m) {
#pragma unroll
      for (int j = 0; j < 4; ++j) {
        const int row = row0 + wr * 64 + m * 16 + fq * 4 + j;
        int mrow = 0;
        if (MODE == G_WOUT || MODE == G_W2) { int b = row / TOK, t = row % TOK; mrow = (t < CTX) ? 2 : b; }
#pragma unroll
        for (int n = 0; n < 4; ++n) {
          const int col = col0 + wc * 64 + n * 16 + fr;
          const float v = acc[m][n][j];
          if (MODE == G_ZIN) {
            if (col < IND) {
              P.z[(size_t)row * IND + col] = f2bf(v);
              if (col >= ZC_MLG && col < ZC_MLG + 16) P.gates[(size_t)row * 48 + col - ZC_MLG] = v;
              else if (col >= ZC_GLA) P.gates[(size_t)row * 48 + 16 + col - ZC_GLA] = v;
            }
          } else if (MODE == G_GLU) {
            float g = bf2f(P.s5g[(size_t)row * 256 + col]);
            float val = v + P.s5_glu_b[l * 256 + col];
            P.mix[(size_t)row * DM + col] = f2bf(g * sigmoidf_(val));
          } else if (MODE == G_WOUT) {
            float gate = P.mod[(l * 3 + mrow) * 6144 + 2048 + col];
            P.xres[(size_t)row * DM + col] += gate * v;
          } else if (MODE == G_W1) {
            float rl = fmaxf(v, 0.f);
            P.hidden[(size_t)row * DFF + col] = f2bf(rl * rl);
          } else {
            float gate = P.mod[(l * 3 + mrow) * 6144 + 5120 + col];
            P.xres[(size_t)row * DM + col] += gate * v;
          }
        }
      }
    }
  }
}

__device__ void phase_prep(const Params& P, int l, int bid, int nblk) {
  const size_t gtid = (size_t)bid * NT + threadIdx.x, gstride = (size_t)nblk * NT;
  for (size_t idx = gtid; idx < (size_t)NTOK * 512; idx += gstride) {
    int r = (int)(idx >> 9), c = (int)(idx & 511);
    int t = r % TOK;
    const float* cw = P.ml_conv_w + (size_t)l * 3 * 512;
    float x0 = bf2f(P.z[(size_t)r * IND + ZC_MLQ + c]);
    float y = cw[512 + c] * x0 + P.ml_conv_b[l * 512 + c];
    if (t != 0 && t != CTX) y += cw[c] * bf2f(P.z[(size_t)(r - 1) * IND + ZC_MLQ + c]);
    if (t != CTX - 1 && t != TOK - 1) y += cw[1024 + c] * bf2f(P.z[(size_t)(r + 1) * IND + ZC_MLQ + c]);
    float s = y * sigmoidf_(y);
    if (c >= 256) s *= 0.125f;
    P.mlqk[(size_t)r * 512 + c] = f2bf(s);
  }
  for (size_t idx = gtid; idx < (size_t)NTOK * 256; idx += gstride) {
    int r = (int)(idx >> 8), dk = (int)(idx & 255);
    int d = dk >> 7, kk = dk & 127;
    const float* W = P.gla_alpha_w + ((size_t)(l * 2 + d) * 16) * 128 + kk;
    const float* a = P.gates + (size_t)r * 48 + 16 + d * 16;
    float v = P.gla_alpha_b[(l * 2 + d) * 128 + kk];
#pragma unroll
    for (int rr = 0; rr < 16; ++rr) v += a[rr] * W[rr * 128];
    float la = logsigmoidf_(v) * (1.f / 16.f);
    P.alpha[(size_t)r * 256 + dk] = __expf(la);
  }
  const float qscale = 0.17677669529663687f;
  for (size_t idx = gtid; idx < (size_t)NTOK * 256; idx += gstride) {
    int r = (int)(idx >> 8), rem = (int)(idx & 255);
    int which = rem >> 7, hm = (rem >> 4) & 7, i = rem & 15;
    int t = r % TOK;
    unsigned* p = (unsigned*)(P.z + (size_t)r * IND + (which ? ZC_DAK : ZC_DAQ) + hm * 32 + 2 * i);
    unsigned u = *p;
    float x1 = __uint_as_float(u << 16), x2 = __uint_as_float(u & 0xffff0000u);
    float o1 = x1, o2 = x2;
    if (t >= CTX) {
      int tl = t - CTX;
      float posv = (i < 8) ? (float)(tl >> 6) : (float)(tl & 63);
      float inv = powf(10000.f, -(float)(i & 7) * 0.125f);
      float ang = posv * inv;
      float cs = cosf(ang), sn = sinf(ang);
      o1 = x1 * cs - x2 * sn;
      o2 = x1 * sn + x2 * cs;
    }
    if (!which) { o1 *= qscale; o2 *= qscale; }
    *p = pack2(o1, o2);
  }
}

struct S5Par { float lbr, lbi; float bbr[16], bbi[16]; };
__device__ __forceinline__ void s5_params(const Params& P, int l, int d, int g, int p, S5Par& q) {
  int gi = (l * 2 + d) * 16 + g, idx = gi * 64 + p;
  float lre = P.s5_lam_re[idx], lim = P.s5_lam_im[idx];
  float dt = expf(P.s5_log_step[gi]);
  float mag = expf(lre * dt);
  q.lbr = mag * cosf(lim * dt); q.lbi = mag * sinf(lim * dt);
  float den = lre * lre + lim * lim;
  float fr_ = ((q.lbr - 1.f) * lre + q.lbi * lim) / den;
  float fi_ = (q.lbi * lre - (q.lbr - 1.f) * lim) / den;
#pragma unroll
  for (int h = 0; h < 16; ++h) {
    float br = P.s5_b_re[(size_t)idx * 16 + h], bi = P.s5_b_im[(size_t)idx * 16 + h];
    q.bbr[h] = fr_ * br - fi_ * bi;
    q.bbi[h] = fr_ * bi + fi_ * br;
  }
}
__device__ __forceinline__ void s5_stage_u(const Params& P, int b, int g, int j, int d, int lane, ushort_t* us) {
#pragma unroll
  for (int q = 0; q < 2; ++q) {
    int s = lane * 2 + q;
    int nl = d == 0 ? s : 127 - s;
    const uint4* src = (const uint4*)(P.z + (size_t)(b * TOK + j * 128 + nl) * IND + ZC_S5U + g * 16);
    uint4 v0 = src[0], v1 = src[1];
    *(uint4*)(us + s * 16) = v0;
    *(uint4*)(us + s * 16 + 8) = v1;
  }
}
__device__ void phase_s5_p1(const Params& P, int l, int bid, int nblk, char* smem) {
  const int wid = threadIdx.x >> 6, lane = threadIdx.x & 63;
  ushort_t* us = (ushort_t*)smem + wid * 2048;
  const int nitems = B_ * 2 * 16 * NCH;
  for (int base = bid * 4; base < nitems; base += nblk * 4) {
    int item = base + wid;
    int c = item % NCH, g = (item / NCH) % 16, d = (item / (NCH * 16)) % 2, b = item / (NCH * 32);
    int j = dir_chunk(d, c);
    S5Par q;
    s5_params(P, l, d, g, lane, q);
    __syncthreads();
    s5_stage_u(P, b, g, j, d, lane, us);
    __syncthreads();
    float hr = 0.f, hi = 0.f;
    for (int s = 0; s < 128; ++s) {
      float u[16];
      unpack8(*(const uint4*)(us + s * 16), u);
      unpack8(*(const uint4*)(us + s * 16 + 8), u + 8);
      float bur = 0.f, bui = 0.f;
#pragma unroll
      for (int h = 0; h < 16; ++h) { bur += q.bbr[h] * u[h]; bui += q.bbi[h] * u[h]; }
      float nr = q.lbr * hr - q.lbi * hi + bur;
      float ni = q.lbr * hi + q.lbi * hr + bui;
      hr = nr; hi = ni;
    }
    float2* st = (float2*)(P.s5st + (size_t)item * 128);
    st[lane] = make_float2(hr, hi);
  }
}
__device__ void phase_s5_p2(const Params& P, int l, int bid, int nblk) {
  const int wid = threadIdx.x >> 6, lane = threadIdx.x & 63;
  for (int it = bid * 4 + wid; it < B_ * 2 * 16; it += nblk * 4) {
    int g = it % 16, d = (it / 16) % 2;
    int gi = (l * 2 + d) * 16 + g, idx = gi * 64 + lane;
    float lre = P.s5_lam_re[idx], lim = P.s5_lam_im[idx];
    float dt = expf(P.s5_log_step[gi]);
    float mag = expf(lre * dt);
    float ar = mag * cosf(lim * dt), ai = mag * sinf(lim * dt);
#pragma unroll
    for (int i = 0; i < 7; ++i) { float nr = ar * ar - ai * ai, ni = 2.f * ar * ai; ar = nr; ai = ni; }
    float cr = 0.f, ci = 0.f;
    float2* st = (float2*)(P.s5st + (size_t)it * NCH * 128);
    for (int c = 0; c < NCH; ++c) {
      float2 x = st[c * 64 + lane];
      st[c * 64 + lane] = make_float2(cr, ci);
      float nr = ar * cr - ai * ci + x.x;
      float ni = ar * ci + ai * cr + x.y;
      cr = nr; ci = ni;
    }
  }
}
template <int DIR>
__device__ __forceinline__ void s5_p3_dir(const Params& P, int l, int b, int g, int j, int lane, ushort_t* us, ushort_t* hs, f32x4 (&acc)[8]) {
  const int fr = lane & 15, fq = lane >> 4;
  const int c = dir_chunk(DIR, j);
  S5Par q;
  s5_params(P, l, DIR, g, lane, q);
  bf16x8 cb[4];
  {
    const float* cre = P.s5_c_re + ((size_t)((l * 2 + DIR) * 16 + g) * 16 + fr) * 64;
    const float* cim = P.s5_c_im + ((size_t)((l * 2 + DIR) * 16 + g) * 16 + fr) * 64;
#pragma unroll
    for (int ks = 0; ks < 4; ++ks) {
#pragma unroll
      for (int e = 0; e < 8; ++e) {
        int k = ks * 32 + fq * 8 + e, p = k >> 1;
        float v = (e & 1) ? -cim[p] : cre[p];
        cb[ks][e] = (short)f2bf(v);
      }
    }
  }
  float2 st = ((const float2*)(P.s5st + (size_t)(((b * 2 + DIR) * 16 + g) * NCH + c) * 128))[lane];
  float hr = st.x, hi = st.y;
  __syncthreads();
  s5_stage_u(P, b, g, j, DIR, lane, us);
  __syncthreads();
#pragma unroll
  for (int sbi = 0; sbi < 8; ++sbi) {
    const int nsb = DIR == 0 ? sbi : 7 - sbi;
    for (int tii = 0; tii < 16; ++tii) {
      const int s = sbi * 16 + tii;
      const int tin = DIR == 0 ? tii : 15 - tii;
      float u[16];
      unpack8(*(const uint4*)(us + s * 16), u);
      unpack8(*(const uint4*)(us + s * 16 + 8), u + 8);
      float bur = 0.f, bui = 0.f;
#pragma unroll
      for (int h = 0; h < 16; ++h) { bur += q.bbr[h] * u[h]; bui += q.bbi[h] * u[h]; }
      float nr = q.lbr * hr - q.lbi * hi + bur;
      float ni = q.lbr * hi + q.lbi * hr + bui;
      hr = nr; hi = ni;
      *(unsigned*)(hs + tin * 136 + 2 * lane) = pack2(hr, hi);
    }
    __syncthreads();
#pragma unroll
    for (int ks = 0; ks < 4; ++ks) {
      bf16x8 a = *(const bf16x8*)(hs + fr * 136 + ks * 32 + fq * 8);
      acc[nsb] = __builtin_amdgcn_mfma_f32_16x16x32_bf16(a, cb[ks], acc[nsb], 0, 0, 0);
    }
    __syncthreads();
  }
}
__device__ void phase_s5_p3(const Params& P, int l, int bid, int nblk, char* smem) {
  const int wid = threadIdx.x >> 6, lane = threadIdx.x & 63, fr = lane & 15, fq = lane >> 4;
  ushort_t* us = (ushort_t*)smem + wid * 2048;
  ushort_t* hs = (ushort_t*)smem + 4 * 2048 + wid * (16 * 136);
  const int nitems = B_ * 16 * NCH;
  for (int base = bid * 4; base < nitems; base += nblk * 4) {
    int item = base + wid;
    int j = item % NCH, g = (item / NCH) % 16, b = item / (NCH * 16);
    f32x4 acc[8];
#pragma unroll
    for (int i = 0; i < 8; ++i) acc[i] = f32x4{0.f, 0.f, 0.f, 0.f};
    s5_p3_dir<0>(P, l, b, g, j, lane, us, hs, acc);
    s5_p3_dir<1>(P, l, b, g, j, lane, us, hs, acc);
    const int col = g * 16 + fr;
    const float dsk = P.s5_d[l * 256 + col];
#pragma unroll
    for (int nsb = 0; nsb < 8; ++nsb) {
#pragma unroll
      for (int jx = 0; jx < 4; ++jx) {
        int r = b * TOK + j * 128 + nsb * 16 + fq * 4 + jx;
        float uval = bf2f(P.z[(size_t)r * IND + ZC_S5U + col]);
        float y = acc[nsb][jx] + dsk * uval;
        float t3 = 0.7978845608028654f * (y + 0.044715f * y * y * y);
        float gl = 0.5f * y * (1.f + tanhf(t3));
        P.s5g[(size_t)r * 256 + col] = f2bf(gl);
      }
    }
  }
}

__device__ __forceinline__ void ml_stage(const Params& P, int l, int b, int h, int d, int j, int sb, int lane, float* ks, float* qs,
                                         float* vs, float* gs, bool need_q) {
  const int ti = lane >> 2, part = lane & 3;
  const int sl = sb * 16 + ti;
  const int nl = d == 0 ? sl : 127 - sl;
  const size_t r = (size_t)(b * TOK + j * 128 + nl);
  float f[16];
  {
    const uint4* src = (const uint4*)(P.mlqk + r * 512 + 256 + h * 64 + part * 16);
    unpack8(src[0], f); unpack8(src[1], f + 8);
    float4* dst = (float4*)(ks + ti * 64 + part * 16);
    dst[0] = make_float4(f[0], f[1], f[2], f[3]); dst[1] = make_float4(f[4], f[5], f[6], f[7]);
    dst[2] = make_float4(f[8], f[9], f[10], f[11]); dst[3] = make_float4(f[12], f[13], f[14], f[15]);
  }
  if (need_q) {
    const uint4* src = (const uint4*)(P.mlqk + r * 512 + h * 64 + part * 16);
    unpack8(src[0], f); unpack8(src[1], f + 8);
    float4* dst = (float4*)(qs + ti * 64 + part * 16);
    dst[0] = make_float4(f[0], f[1], f[2], f[3]); dst[1] = make_float4(f[4], f[5], f[6], f[7]);
    dst[2] = make_float4(f[8], f[9], f[10], f[11]); dst[3] = make_float4(f[12], f[13], f[14], f[15]);
  }
  {
    const uint4* src = (const uint4*)(P.z + r * IND + ZC_MLV + h * 64 + part * 16);
    unpack8(src[0], f); unpack8(src[1], f + 8);
    float4* dst = (float4*)(vs + ti * 64 + part * 16);
    dst[0] = make_float4(f[0], f[1], f[2], f[3]); dst[1] = make_float4(f[4], f[5], f[6], f[7]);
    dst[2] = make_float4(f[8], f[9], f[10], f[11]); dst[3] = make_float4(f[12], f[13], f[14], f[15]);
  }
  if (part == 0) {
    float ig = P.gates[r * 48 + (2 * d) * 4 + h] + P.ml_gate_b[l * 16 + (2 * d) * 4 + h];
    float fp = P.gates[r * 48 + (2 * d + 1) * 4 + h] + P.ml_gate_b[l * 16 + (2 * d + 1) * 4 + h];
    gs[ti * 2] = ig;
    gs[ti * 2 + 1] = logsigmoidf_(fp);
  }
}
#define ML_WAVE_LDS (3 * 1024 + 32)
__device__ void phase_ml_p1(const Params& P, int l, int bid, int nblk, char* smem) {
  const int wid = threadIdx.x >> 6, lane = threadIdx.x & 63;
  float* ks = (float*)smem + wid * ML_WAVE_LDS;
  float* qs = ks + 1024; float* vs = qs + 1024; float* gs = vs + 1024;
  const int nitems = B_ * 4 * 2 * NCH;
  for (int base = bid * 4; base < nitems; base += nblk * 4) {
    int item = base + wid;
    int c = item % NCH, d = (item / NCH) % 2, h = (item / (NCH * 2)) % 4, b = item / (NCH * 8);
    int j = dir_chunk(d, c);
    float C[64];
#pragma unroll
    for (int k = 0; k < 64; ++k) C[k] = 0.f;
    float n = 0.f, m = -INFINITY, bsum = 0.f;
    for (int sb = 0; sb < 8; ++sb) {
      __syncthreads();
      ml_stage(P, l, b, h, d, j, sb, lane, ks, qs, vs, gs, false);
      __syncthreads();
      for (int ti = 0; ti < 16; ++ti) {
        float ig = gs[ti * 2], lf = gs[ti * 2 + 1];
        float vv = vs[ti * 64 + lane];
        float mn = fmaxf(lf + m, ig);
        float a = __expf(lf + m - mn), sc = __expf(ig - mn);
        m = mn; bsum += lf;
        float sv = sc * vv;
        const float4* k4 = (const float4*)(ks + ti * 64);
#pragma unroll
        for (int k = 0; k < 16; ++k) {
          float4 kv = k4[k];
          C[4 * k + 0] = a * C[4 * k + 0] + sv * kv.x; C[4 * k + 1] = a * C[4 * k + 1] + sv * kv.y;
          C[4 * k + 2] = a * C[4 * k + 2] + sv * kv.z; C[4 * k + 3] = a * C[4 * k + 3] + sv * kv.w;
        }
        n = a * n + sc * ks[ti * 64 + lane];
      }
    }
    float* st = P.mlst + (size_t)item * MLST_SZ;
#pragma unroll
    for (int k = 0; k < 64; ++k) st[k * 64 + lane] = C[k];
    st[4096 + lane] = n;
    if (lane == 0) { st[4160] = m; st[4161] = bsum; }
  }
}
__device__ void phase_ml_p2(const Params& P, int bid, int nblk) {
  const int wid = threadIdx.x >> 6, lane = threadIdx.x & 63;
  for (int it = bid * 4 + wid; it < 16 * 65; it += nblk * 4) {
    int bhd = it / 65, slab = it % 65;
    int e = slab * 64 + lane;
    float st = 0.f, m = 0.f;
    float* base = P.mlst + (size_t)bhd * NCH * MLST_SZ;
    for (int c = 0; c < NCH; ++c) {
      float* pc = base + (size_t)c * MLST_SZ;
      float gt = pc[4160], bt = pc[4161];
      float mn = fmaxf(bt + m, gt);
      float a = __expf(bt + m - mn), s = __expf(gt - mn);
      float x = pc[e];
      pc[e] = st;
      st = a * st + s * x;
      if (slab == 0 && lane == 0) pc[4162] = m;
      m = mn;
    }
  }
}
__device__ void phase_ml_p3(const Params& P, int l, int bid, int nblk, char* smem) {
  const int wid = threadIdx.x >> 6, lane = threadIdx.x & 63;
  float* ks = (float*)smem + wid * ML_WAVE_LDS;
  float* qs = ks + 1024; float* vs = qs + 1024; float* gs = vs + 1024;
  const int nitems = B_ * 4 * 2 * NCH;
  for (int base = bid * 4; base < nitems; base += nblk * 4) {
    int item = base + wid;
    int c = item % NCH, d = (item / NCH) % 2, h = (item / (NCH * 2)) % 4, b = item / (NCH * 8);
    int j = dir_chunk(d, c);
    const float* st = P.mlst + (size_t)item * MLST_SZ;
    float C[64];
#pragma unroll
    for (int k = 0; k < 64; ++k) C[k] = st[k * 64 + lane];
    float n = st[4096 + lane], m = st[4162];
    ushort_t* outp = d == 0 ? (P.mix + 256 + h * 64 + lane) : (P.z + ZC_MLQ + h * 64 + lane);
    const size_t ostride = d == 0 ? DM : IND;
    for (int sb = 0; sb < 8; ++sb) {
      __syncthreads();
      ml_stage(P, l, b, h, d, j, sb, lane, ks, qs, vs, gs, true);
      __syncthreads();
      for (int ti = 0; ti < 16; ++ti) {
        float ig = gs[ti * 2], lf = gs[ti * 2 + 1];
        float vv = vs[ti * 64 + lane];
        float mn = fmaxf(lf + m, ig);
        float a = __expf(lf + m - mn), sc = __expf(ig - mn);
        m = mn;
        float sv = sc * vv;
        const float4* k4 = (const float4*)(ks + ti * 64);
        const float4* q4 = (const float4*)(qs + ti * 64);
        float num0 = 0.f, num1 = 0.f, num2 = 0.f, num3 = 0.f;
#pragma unroll
        for (int k = 0; k < 16; ++k) {
          float4 kv = k4[k], qv = q4[k];
          C[4 * k + 0] = a * C[4 * k + 0] + sv * kv.x; C[4 * k + 1] = a * C[4 * k + 1] + sv * kv.y;
          C[4 * k + 2] = a * C[4 * k + 2] + sv * kv.z; C[4 * k + 3] = a * C[4 * k + 3] + sv * kv.w;
          num0 += C[4 * k + 0] * qv.x; num1 += C[4 * k + 1] * qv.y; num2 += C[4 * k + 2] * qv.z; num3 += C[4 * k + 3] * qv.w;
        }
        n = a * n + sc * ks[ti * 64 + lane];
        float den = wave_sum(n * qs[ti * 64 + lane]);
        float hv = ((num0 + num1) + (num2 + num3)) / fmaxf(fabsf(den), __expf(-m));
        int sl = sb * 16 + ti;
        int nl = d == 0 ? sl : 127 - sl;
        size_t r = (size_t)(b * TOK + j * 128 + nl);
        outp[r * ostride] = f2bf(hv);
      }
    }
  }
}

#define GL_WAVE_LDS (512 * 3 + 1024)
__device__ __forceinline__ void gl_stage(const Params& P, int b, int h, int d, int j, int sb, int lane, float* ks, float* qs,
                                         float* as, float* vs, bool need_q) {
  const int ti = lane >> 2, part = lane & 3;
  const int sl = sb * 16 + ti;
  const int nl = d == 0 ? sl : 127 - sl;
  const size_t r = (size_t)(b * TOK + j * 128 + nl);
  float f[16];
  {
    unpack8(*(const uint4*)(P.z + r * IND + ZC_GLK + h * 32 + part * 8), f);
    float4* dst = (float4*)(ks + ti * 32 + part * 8);
    dst[0] = make_float4(f[0], f[1], f[2], f[3]); dst[1] = make_float4(f[4], f[5], f[6], f[7]);
  }
  if (need_q) {
    const float qs_ = 0.17677669529663687f;
    unpack8(*(const uint4*)(P.z + r * IND + ZC_GLQ + h * 32 + part * 8), f);
    float4* dst = (float4*)(qs + ti * 32 + part * 8);
    dst[0] = make_float4(f[0] * qs_, f[1] * qs_, f[2] * qs_, f[3] * qs_);
    dst[1] = make_float4(f[4] * qs_, f[5] * qs_, f[6] * qs_, f[7] * qs_);
  }
  {
    const float4* src = (const float4*)(P.alpha + r * 256 + d * 128 + h * 32 + part * 8);
    float4* dst = (float4*)(as + ti * 32 + part * 8);
    dst[0] = src[0]; dst[1] = src[1];
  }
  {
    const uint4* src = (const uint4*)(P.z + r * IND + ZC_GLV + h * 64 + part * 16);
    unpack8(src[0], f); unpack8(src[1], f + 8);
    float4* dst = (float4*)(vs + ti * 64 + part * 16);
    dst[0] = make_float4(f[0], f[1], f[2], f[3]); dst[1] = make_float4(f[4], f[5], f[6], f[7]);
    dst[2] = make_float4(f[8], f[9], f[10], f[11]); dst[3] = make_float4(f[12], f[13], f[14], f[15]);
  }
}
__device__ void phase_gl_p1(const Params& P, int bid, int nblk, char* smem) {
  const int wid = threadIdx.x >> 6, lane = threadIdx.x & 63;
  float* ks = (float*)smem + wid * GL_WAVE_LDS;
  float* qs = ks + 512; float* as = qs + 512; float* vs = as + 512;
  const int nitems = B_ * 4 * 2 * NCH;
  for (int base = bid * 4; base < nitems; base += nblk * 4) {
    int item = base + wid;
    int c = item % NCH, d = (item / NCH) % 2, h = (item / (NCH * 2)) % 4, b = item / (NCH * 8);
    int j = dir_chunk(d, c);
    float S[32];
#pragma unroll
    for (int k = 0; k < 32; ++k) S[k] = 0.f;
    float ap = 1.f;
    for (int sb = 0; sb < 8; ++sb) {
      __syncthreads();
      gl_stage(P, b, h, d, j, sb, lane, ks, qs, as, vs, false);
      __syncthreads();
      for (int ti = 0; ti < 16; ++ti) {
        float vv = vs[ti * 64 + lane];
        const float4* k4 = (const float4*)(ks + ti * 32);
        const float4* a4 = (const float4*)(as + ti * 32);
#pragma unroll
        for (int k = 0; k < 8; ++k) {
          float4 kv = k4[k], av = a4[k];
          S[4 * k + 0] = av.x * S[4 * k + 0] + kv.x * vv; S[4 * k + 1] = av.y * S[4 * k + 1] + kv.y * vv;
          S[4 * k + 2] = av.z * S[4 * k + 2] + kv.z * vv; S[4 * k + 3] = av.w * S[4 * k + 3] + kv.w * vv;
        }
        ap *= as[ti * 32 + (lane & 31)];
      }
    }
    float* st = P.glast + (size_t)item * GLST_SZ;
#pragma unroll
    for (int k = 0; k < 32; ++k) st[k * 64 + lane] = S[k];
    if (lane < 32) st[2048 + lane] = ap;
  }
}
__device__ void phase_gl_p2(const Params& P, int bid, int nblk) {
  const int wid = threadIdx.x >> 6, lane = threadIdx.x & 63;
  for (int it = bid * 4 + wid; it < 16 * 32; it += nblk * 4) {
    int bhd = it / 32, slab = it % 32;
    int e = slab * 64 + lane;
    float st = 0.f;
    float* base = P.glast + (size_t)bhd * NCH * GLST_SZ;
    for (int c = 0; c < NCH; ++c) {
      float* pc = base + (size_t)c * GLST_SZ;
      float A = pc[2048 + slab];
      float x = pc[e];
      pc[e] = st;
      st = A * st + x;
    }
  }
}
__device__ void phase_gl_p3(const Params& P, int bid, int nblk, char* smem) {
  const int wid = threadIdx.x >> 6, lane = threadIdx.x & 63;
  float* ks = (float*)smem + wid * GL_WAVE_LDS;
  float* qs = ks + 512; float* as = qs + 512; float* vs = as + 512;
  const int nitems = B_ * 4 * 2 * NCH;
  for (int base = bid * 4; base < nitems; base += nblk * 4) {
    int item = base + wid;
    int c = item % NCH, d = (item / NCH) % 2, h = (item / (NCH * 2)) % 4, b = item / (NCH * 8);
    int j = dir_chunk(d, c);
    const float* st = P.glast + (size_t)item * GLST_SZ;
    float S[32];
#pragma unroll
    for (int k = 0; k < 32; ++k) S[k] = st[k * 64 + lane];
    ushort_t* outp = d == 0 ? (P.mix + 768 + h * 64 + lane) : (P.z + ZC_MLK + h * 64 + lane);
    const size_t ostride = d == 0 ? DM : IND;
    for (int sb = 0; sb < 8; ++sb) {
      __syncthreads();
      gl_stage(P, b, h, d, j, sb, lane, ks, qs, as, vs, true);
      __syncthreads();
      for (int ti = 0; ti < 16; ++ti) {
        float vv = vs[ti * 64 + lane];
        const float4* k4 = (const float4*)(ks + ti * 32);
        const float4* a4 = (const float4*)(as + ti * 32);
        const float4* q4 = (const float4*)(qs + ti * 32);
        float o0 = 0.f, o1 = 0.f, o2 = 0.f, o3 = 0.f;
#pragma unroll
        for (int k = 0; k < 8; ++k) {
          float4 kv = k4[k], av = a4[k], qv = q4[k];
          S[4 * k + 0] = av.x * S[4 * k + 0] + kv.x * vv; S[4 * k + 1] = av.y * S[4 * k + 1] + kv.y * vv;
          S[4 * k + 2] = av.z * S[4 * k + 2] + kv.z * vv; S[4 * k + 3] = av.w * S[4 * k + 3] + kv.w * vv;
          o0 += qv.x * S[4 * k + 0]; o1 += qv.y * S[4 * k + 1]; o2 += qv.z * S[4 * k + 2]; o3 += qv.w * S[4 * k + 3];
        }
        int sl = sb * 16 + ti;
        int nl = d == 0 ? sl : 127 - sl;
        size_t r = (size_t)(b * TOK + j * 128 + nl);
        outp[r * ostride] = f2bf((o0 + o1) + (o2 + o3));
      }
    }
  }
}
__device__ void phase_finish(const Params& P, int l, int bid, int nblk) {
  const int wid = threadIdx.x >> 6, lane = threadIdx.x & 63;
  const float lam_init = 0.8f - 0.6f * expf(-0.3f * (float)l);
  for (int it = bid * 4 + wid; it < NTOK * 3; it += nblk * 4) {
    const int r = it / 3, which = it % 3;
    if (which == 2) {
      const int ch = lane * 4;
      ushort_t* mp = P.mix + (size_t)r * DM + 512 + ch;
      uint2 a = *(const uint2*)mp;
      float v[4] = {__uint_as_float(a.x << 16), __uint_as_float(a.x & 0xffff0000u), __uint_as_float(a.y << 16),
                    __uint_as_float(a.y & 0xffff0000u)};
      float ss = v[0] * v[0] + v[1] * v[1] + v[2] * v[2] + v[3] * v[3];
      ss += __shfl_xor(ss, 1); ss += __shfl_xor(ss, 2); ss += __shfl_xor(ss, 4); ss += __shfl_xor(ss, 8);
      float rstd = rsqrtf(ss * (1.f / 64.f) + 1e-6f) * (1.f - lam_init);
      const float* gn = P.da_norm_g + l * 64 + (ch & 63);
      uint2 ov; ov.x = pack2(v[0] * rstd * gn[0], v[1] * rstd * gn[1]); ov.y = pack2(v[2] * rstd * gn[2], v[3] * rstd * gn[3]);
      *(uint2*)mp = ov;
      continue;
    }
    const int ch = lane * 4;
    ushort_t* mp = P.mix + (size_t)r * DM + (which ? 768 : 256) + ch;
    const ushort_t* zp = P.z + (size_t)r * IND + (which ? ZC_MLK : ZC_MLQ) + ch;
    uint2 a = *(const uint2*)mp, bb = *(const uint2*)zp;
    float v[4];
    v[0] = __uint_as_float(a.x << 16) + __uint_as_float(bb.x << 16);
    v[1] = __uint_as_float(a.x & 0xffff0000u) + __uint_as_float(bb.x & 0xffff0000u);
    v[2] = __uint_as_float(a.y << 16) + __uint_as_float(bb.y << 16);
    v[3] = __uint_as_float(a.y & 0xffff0000u) + __uint_as_float(bb.y & 0xffff0000u);
    float ss = v[0] * v[0] + v[1] * v[1] + v[2] * v[2] + v[3] * v[3];
    ss += __shfl_xor(ss, 1); ss += __shfl_xor(ss, 2); ss += __shfl_xor(ss, 4); ss += __shfl_xor(ss, 8);
    float rstd = rsqrtf(ss * (1.f / 64.f) + 1e-6f);
    uint2 gz = *(const uint2*)(P.z + (size_t)r * IND + (which ? ZC_GLR : ZC_MLO) + ch);
    float gt[4] = {__uint_as_float(gz.x << 16), __uint_as_float(gz.x & 0xffff0000u), __uint_as_float(gz.y << 16),
                   __uint_as_float(gz.y & 0xffff0000u)};
    float o[4];
#pragma unroll
    for (int i = 0; i < 4; ++i) {
      if (which == 0) {
        float gain = P.ml_norm_g[l * 256 + ch + i];
        o[i] = sigmoidf_(gt[i]) * (v[i] * rstd * gain);
      } else {
        float gain = P.gla_norm_g[l * 64 + ((ch + i) & 63)];
        o[i] = (v[i] * rstd * gain) * (gt[i] * sigmoidf_(gt[i]));
      }
    }
    uint2 ov; ov.x = pack2(o[0], o[1]); ov.y = pack2(o[2], o[3]);
    *(uint2*)mp = ov;
  }
}

__device__ void phase_attn_naive(const Params& P, int l, int bid, int nblk, char* smem) {
  float* Ks = (float*)smem;
  float* Vs = Ks + 64 * 32;
  const int tid = threadIdx.x;
  const float lam_init = 0.8f - 0.6f * expf(-0.3f * (float)l);
  float lam;
  {
    const float* lp = P.da_lam + l * 128;
    float s01 = 0.f, s23 = 0.f;
    for (int i = 0; i < 32; ++i) { s01 += lp[i] * lp[32 + i]; s23 += lp[64 + i] * lp[96 + i]; }
    lam = expf(s01) - expf(s23) + lam_init;
  }
  const int nitems = B_ * 4 * 2 * 65;
  for (int item = bid; item < nitems; item += nblk) {
    const int qb = item % 65, vh = (item / 65) % 2, head = (item / 130) % 4, b = item / 520;
    const int t = (qb < 64) ? CTX + qb * 256 + tid : tid;
    const int nkeys = (qb < 64) ? TOK : CTX;
    const size_t r = (size_t)(b * TOK + t);
    float o1[32];
    for (int mp = 0; mp < 2; ++mp) {
      float q[32];
      {
        const uint4* src = (const uint4*)(P.z + r * IND + ZC_DAQ + head * 64 + mp * 32);
        unpack8(src[0], q); unpack8(src[1], q + 8); unpack8(src[2], q + 16); unpack8(src[3], q + 24);
      }
      float m = -INFINITY, lsum = 0.f;
      float acc[32];
#pragma unroll
      for (int v = 0; v < 32; ++v) acc[v] = 0.f;
      for (int kt = 0; kt < nkeys; kt += 64) {
        __syncthreads();
        {
          int key = tid >> 2, part = tid & 3;
          float f[8];
          unpack8(*(const uint4*)(P.z + (size_t)(b * TOK + kt + key) * IND + ZC_DAK + head * 64 + mp * 32 + part * 8), f);
          float4* dst = (float4*)(Ks + key * 32 + part * 8);
          dst[0] = make_float4(f[0], f[1], f[2], f[3]); dst[1] = make_float4(f[4], f[5], f[6], f[7]);
          unpack8(*(const uint4*)(P.z + (size_t)(b * TOK + kt + key) * IND + ZC_DAV + head * 64 + vh * 32 + part * 8), f);
          float4* d2 = (float4*)(Vs + key * 32 + part * 8);
          d2[0] = make_float4(f[0], f[1], f[2], f[3]); d2[1] = make_float4(f[4], f[5], f[6], f[7]);
        }
        __syncthreads();
#pragma unroll 1
        for (int sub = 0; sub < 16; ++sub) {
          float s[4];
          float mt = -INFINITY;
#pragma unroll
          for (int i = 0; i < 4; ++i) {
            const float4* k4 = (const float4*)(Ks + (sub * 4 + i) * 32);
            float a0 = 0.f, a1 = 0.f;
#pragma unroll
            for (int dd = 0; dd < 8; dd += 2) {
              float4 k0 = k4[dd], k1 = k4[dd + 1];
              a0 += q[4 * dd] * k0.x + q[4 * dd + 1] * k0.y + q[4 * dd + 2] * k0.z + q[4 * dd + 3] * k0.w;
              a1 += q[4 * dd + 4] * k1.x + q[4 * dd + 5] * k1.y + q[4 * dd + 6] * k1.z + q[4 * dd + 7] * k1.w;
            }
            s[i] = a0 + a1;
            mt = fmaxf(mt, s[i]);
          }
          float mn = fmaxf(m, mt);
          float al = __expf(m - mn);
          m = mn;
          lsum *= al;
#pragma unroll
          for (int v = 0; v < 32; ++v) acc[v] *= al;
#pragma unroll
          for (int i = 0; i < 4; ++i) {
            float p = __expf(s[i] - mn);
            lsum += p;
            const float4* v4 = (const float4*)(Vs + (sub * 4 + i) * 32);
#pragma unroll
            for (int v = 0; v < 8; ++v) {
              float4 vv = v4[v];
              acc[4 * v] += p * vv.x; acc[4 * v + 1] += p * vv.y; acc[4 * v + 2] += p * vv.z; acc[4 * v + 3] += p * vv.w;
            }
          }
        }
      }
      float inv = 1.f / lsum;
      if (mp == 0) {
#pragma unroll
        for (int v = 0; v < 32; ++v) o1[v] = acc[v] * inv;
      } else {
#pragma unroll
        for (int v = 0; v < 32; ++v) o1[v] = o1[v] - lam * acc[v] * inv;
      }
    }
    ushort_t* mp_ = P.mix + r * DM + 512 + head * 64 + vh * 32;
#pragma unroll
    for (int v = 0; v < 32; v += 8) {
      uint4 o;
      o.x = pack2(o1[v], o1[v + 1]); o.y = pack2(o1[v + 2], o1[v + 3]);
      o.z = pack2(o1[v + 4], o1[v + 5]); o.w = pack2(o1[v + 6], o1[v + 7]);
      *(uint4*)(mp_ + v) = o;
    }
  }
}

__device__ void phase_final(const Params& P, int bid, int nblk) {
  const int wid = threadIdx.x >> 6, lane = threadIdx.x & 63;
  for (int q = bid * 4 + wid; q < B_ * SEQ; q += nblk * 4) {
    int b = q / SEQ, tl = q % SEQ;
    const float4* xr = (const float4*)(P.xres + (size_t)(b * TOK + CTX + tl) * DM);
    float4 v[4];
    float ss = 0;
#pragma unroll
    for (int i = 0; i < 4; ++i) {
      v[i] = xr[lane + 64 * i];
      ss += v[i].x * v[i].x + v[i].y * v[i].y + v[i].z * v[i].z + v[i].w * v[i].w;
    }
    ss = wave_sum(ss);
    float rstd = rsqrtf(ss * (1.f / DM) + 1e-6f);
    float4* o = (float4*)(P.out + (size_t)q * DM);
#pragma unroll
    for (int i = 0; i < 4; ++i) {
      float4 gg = ((const float4*)P.final_norm_g)[lane + 64 * i];
      o[lane + 64 * i] = make_float4(v[i].x * rstd * gg.x, v[i].y * rstd * gg.y, v[i].z * rstd * gg.z, v[i].w * rstd * gg.w);
    }
  }
}

constexpr int NPH = 11;
__device__ __forceinline__ void run_phase(const Params& P, int l, int ph, int bid, int nblk, char* smem) {
  switch (ph) {
    case 0: phase_convw(P, l, bid, nblk, smem); phase_norm(P, l, 0, bid, nblk); break;
    case 1: gemm_phase<G_ZIN>(P, l, P.h, P.wt_in, DM, INDP / 128, bid, nblk, smem); break;
    case 2: phase_prep(P, l, bid, nblk); break;
    case 3: phase_s5_p1(P, l, bid, nblk, smem); __syncthreads(); phase_ml_p1(P, l, bid, nblk, smem); __syncthreads();
            phase_gl_p1(P, bid, nblk, smem); break;
    case 4: phase_s5_p2(P, l, bid, nblk); phase_ml_p2(P, bid, nblk); phase_gl_p2(P, bid, nblk); __syncthreads();
            phase_attn_naive(P, l, bid, nblk, smem); break;
    case 5: phase_s5_p3(P, l, bid, nblk, smem); __syncthreads(); phase_ml_p3(P, l, bid, nblk, smem); __syncthreads();
            phase_gl_p3(P, bid, nblk, smem); break;
    case 6: phase_finish(P, l, bid, nblk); __syncthreads(); gemm_phase<G_GLU>(P, l, P.s5g, P.glut, 256, 2, bid, nblk, smem); break;
    case 7: gemm_phase<G_WOUT>(P, l, P.mix, P.wt_out, DM, 8, bid, nblk, smem); break;
    case 8: phase_norm(P, l, 1, bid, nblk); break;
    case 9: gemm_phase<G_W1>(P, l, P.h, P.w1t, DM, 32, bid, nblk, smem); break;
    case 10: gemm_phase<G_W2>(P, l, P.hidden, P.w2t, DFF, 8, bid, nblk, smem); break;
  }
}

#if MEGA
__global__ void __launch_bounds__(NT) k_mega(Params P) {
  __shared__ __attribute__((aligned(16))) char smem[SMEM_BYTES];
  cg::grid_group grid = cg::this_grid();
  const int bid = blockIdx.x, nblk = gridDim.x;
  phase_init(P, bid, nblk, smem);
  grid.sync();
  for (int l = 0; l < DEPTH; ++l) {
    for (int ph = 0; ph < NPH; ++ph) {
      run_phase(P, l, ph, bid, nblk, smem);
      grid.sync();
    }
  }
  phase_final(P, bid, nblk);
}
#else
__global__ void __launch_bounds__(NT, 2) k_init(Params P) {
  __shared__ __attribute__((aligned(16))) char smem[SMEM_BYTES];
  phase_init(P, blockIdx.x, gridDim.x, smem);
}
template <int PH>
__global__ void __launch_bounds__(NT, 2) k_phase(Params P, int l) {
  __shared__ __attribute__((aligned(16))) char smem[SMEM_BYTES];
  run_phase(P, l, PH, blockIdx.x, gridDim.x, smem);
}
__global__ void __launch_bounds__(NT, 2) k_final(Params P) { phase_final(P, blockIdx.x, gridDim.x); }
#endif

extern "C" void kernel_launch(void* const* d_in, const int* in_sizes, int n_in, void* d_out, int out_size, void* d_ws,
                              size_t ws_size, hipStream_t stream) {
  Params P{};
  const float** pp = (const float**)&P;
  for (int i = 0; i < 32; ++i) pp[i] = (const float*)d_in[i];
  P.out = (float*)d_out;
  char* w = (char*)d_ws;
  size_t off = 0;
  auto take = [&](size_t bytes) { char* p = w + off; off += (bytes + 255) & ~(size_t)255; return p; };
  P.xres = (float*)take((size_t)NTOK * DM * 4);
  char* R = take((size_t)NTOK * DFF * 2);
  P.z = (ushort_t*)R;
  P.mix = (ushort_t*)(R + (size_t)NTOK * IND * 2);
  P.hidden = (ushort_t*)R;
  P.wt_in = (ushort_t*)take((size_t)INDP * DM * 2);
  P.wt_out = (ushort_t*)take((size_t)DM * DM * 2);
  P.w1t = (ushort_t*)take((size_t)DFF * DM * 2);
  P.w2t = (ushort_t*)take((size_t)DM * DFF * 2);
  P.glut = (ushort_t*)take((size_t)256 * 256 * 2);
  P.mlqk = (ushort_t*)take((size_t)NTOK * 512 * 2);
  P.s5g = (ushort_t*)take((size_t)NTOK * 256 * 2);
  P.mlst = (float*)take((size_t)B_ * 4 * 2 * NCH * MLST_SZ * 4);
  P.mod = (float*)take((size_t)DEPTH * 3 * 6144 * 4);
  if (off > ws_size) { fprintf(stderr, "ws too small: need %zu have %zu\n", off, ws_size); return; }
  char* o = (char*)d_out;
  size_t ooff = 0;
  auto otake = [&](size_t bytes) { char* p = o + ooff; ooff += (bytes + 255) & ~(size_t)255; return p; };
  P.h = (ushort_t*)otake((size_t)NTOK * DM * 2);
  P.alpha = (float*)otake((size_t)NTOK * 256 * 4);
  P.gates = (float*)otake((size_t)NTOK * 48 * 4);
  P.s5st = (float*)otake((size_t)B_ * 2 * 16 * NCH * 128 * 4);
  P.glast = (float*)otake((size_t)B_ * 4 * 2 * NCH * GLST_SZ * 4);
  if (ooff > (size_t)out_size * 4) { fprintf(stderr, "out scratch too small\n"); return; }

#if MEGA
  static int grid_blocks = 0;
  if (!grid_blocks) {
    int dev = 0, cus = 0, per_cu = 0;
    hipGetDevice(&dev);
    hipDeviceGetAttribute(&cus, hipDeviceAttributeMultiprocessorCount, dev);
    hipOccupancyMaxActiveBlocksPerMultiprocessor(&per_cu, k_mega, NT, 0);
    if (per_cu > 2) per_cu = 2;
    grid_blocks = cus * per_cu;
  }
  void* args[] = {&P};
  hipError_t e = hipLaunchCooperativeKernel((void*)k_mega, dim3(grid_blocks), dim3(NT), args, 0, stream);
  if (e != hipSuccess) fprintf(stderr, "cooperative launch failed: %s (grid %d)\n", hipGetErrorString(e), grid_blocks);
#else
  const int G = 512;
  k_init<<<G, NT, 0, stream>>>(P);
  for (int l = 0; l < DEPTH; ++l) {
    k_phase<0><<<G, NT, 0, stream>>>(P, l);
    k_phase<1><<<G, NT, 0, stream>>>(P, l);
    k_phase<2><<<G, NT, 0, stream>>>(P, l);
    k_phase<3><<<G, NT, 0, stream>>>(P, l);
    k_phase<4><<<G, NT, 0, stream>>>(P, l);
    k_phase<5><<<G, NT, 0, stream>>>(P, l);
    k_phase<6><<<G, NT, 0, stream>>>(P, l);
    k_phase<7><<<G, NT, 0, stream>>>(P, l);
    k_phase<8><<<G, NT, 0, stream>>>(P, l);
    k_phase<9><<<G, NT, 0, stream>>>(P, l);
    k_phase<10><<<G, NT, 0, stream>>>(P, l);
  }
  k_final<<<G, NT, 0, stream>>>(P);
#endif
}
```

```cpp
#include <hip/hip_runtime.h>
#include <hip/hip_cooperative_groups.h>
#include <stdint.h>
#include <stdio.h>
namespace cg = cooperative_groups;

#ifndef MEGA
#define MEGA 1
#endif

#define NT 256
typedef unsigned short ushort_t;
using bf16x8 = __attribute__((ext_vector_type(8))) short;
using f32x4 = __attribute__((ext_vector_type(4))) float;
using f32x16 = __attribute__((ext_vector_type(16))) float;

constexpr int B_ = 2, SEQ = 16384, CTX = 256, TOK = SEQ + CTX, NTOK = B_ * TOK, DM = 1024, DEPTH = 4;
constexpr int IND = 2864, INDP = 2944, DFF = 4096, NCH = 130;
constexpr int MLST_SZ = 4224;
constexpr int GLST_SZ = 2112;
constexpr int SMEM_BYTES = 66 * 1024;

constexpr int ZC_S5U = 0, ZC_MLQ = 256, ZC_MLK = 512, ZC_MLV = 768, ZC_MLO = 1024, ZC_MLG = 1280;
constexpr int ZC_DAQ = 1296, ZC_DAK = 1552, ZC_DAV = 1808;
constexpr int ZC_GLQ = 2064, ZC_GLK = 2192, ZC_GLV = 2320, ZC_GLR = 2576, ZC_GLA = 2832;

struct Params {
  const float *x, *c, *ctx, *c_ctx, *ada_w, *ada_b, *norm1_g, *norm2_g, *w_in, *s5_lam_re, *s5_lam_im, *s5_log_step,
      *s5_b_re, *s5_b_im, *s5_c_re, *s5_c_im, *s5_d, *s5_glu_w, *s5_glu_b, *ml_conv_w, *ml_conv_b, *ml_gate_b,
      *ml_norm_g, *da_lam, *da_norm_g, *gla_alpha_w, *gla_alpha_b, *gla_norm_g, *w_out, *mlp_w1, *mlp_w2, *final_norm_g;
  float* out;
  float* xres;
  ushort_t* z;
  ushort_t* mix;
  ushort_t* hidden;
  ushort_t *wt_in, *wt_out, *w1t, *w2t, *glut;
  ushort_t* mlqk;
  ushort_t* s5g;
  float* mlst;
  float* mod;
  ushort_t* h;
  float* alpha;
  float* gates;
  float* s5st;
  float* glast;
  ushort_t* vt;
};

__device__ __forceinline__ int ltid() { int t = threadIdx.x; asm volatile("" : "+v"(t)); return t; }
__device__ __forceinline__ int launder_s(int x) { asm volatile("" : "+s"(x)); return x; }
__device__ __forceinline__ float bf2f(ushort_t u) { return __uint_as_float(((unsigned)u) << 16); }
__device__ __forceinline__ ushort_t f2bf(float f) {
  unsigned u = __float_as_uint(f);
  u += 0x7fffu + ((u >> 16) & 1u);
  return (ushort_t)(u >> 16);
}
__device__ __forceinline__ unsigned pack2(float a, float b) {
  typedef __bf16 bf2_t __attribute__((ext_vector_type(2)));
  typedef float f2_t __attribute__((ext_vector_type(2)));
  f2_t v = {a, b};
  return __builtin_bit_cast(unsigned, __builtin_convertvector(v, bf2_t));
}
__device__ __forceinline__ float wave_sum(float v) {
#pragma unroll
  for (int o = 32; o; o >>= 1) v += __shfl_xor(v, o);
  return v;
}
__device__ __forceinline__ float sigmoidf_(float x) { return 1.f / (1.f + __expf(-x)); }
__device__ __forceinline__ float logsigmoidf_(float x) { return fminf(x, 0.f) - log1pf(__expf(-fabsf(x))); }
__device__ __forceinline__ void unpack8(uint4 v, float* f) {
  f[0] = __uint_as_float(v.x << 16); f[1] = __uint_as_float(v.x & 0xffff0000u);
  f[2] = __uint_as_float(v.y << 16); f[3] = __uint_as_float(v.y & 0xffff0000u);
  f[4] = __uint_as_float(v.z << 16); f[5] = __uint_as_float(v.z & 0xffff0000u);
  f[6] = __uint_as_float(v.w << 16); f[7] = __uint_as_float(v.w & 0xffff0000u);
}
__device__ __forceinline__ int dir_chunk(int d, int c) { return d == 0 ? c : (c < 2 ? 1 - c : 131 - c); }

__device__ void phase_init(const Params& P, int bid, int nblk, char* smem) {
  const int tid = ltid();
  size_t total4 = (size_t)NTOK * 256;
  for (size_t i = (size_t)bid * NT + tid; i < total4; i += (size_t)nblk * NT) {
    int r = (int)(i >> 8), c4 = (int)(i & 255);
    int b = r / TOK, t = r % TOK;
    const float4* src = (t < CTX) ? (const float4*)(P.ctx + ((size_t)(b * CTX + t)) * DM)
                                  : (const float4*)(P.x + ((size_t)(b * SEQ + t - CTX)) * DM);
    ((float4*)P.xres)[i] = src[c4];
  }
  float* sv = (float*)smem;
  float* red = sv + 3072;
  for (int i = tid; i < 3072; i += NT) {
    int row = i >> 10, k = i & 1023;
    float v = (row < 2) ? P.c[row * DM + k] : P.c_ctx[k];
    sv[i] = v / (1.f + expf(-v));
  }
  __syncthreads();
  for (int item = bid; item < 4 * 96; item += nblk) {
    int l = item / 96, cgp = item % 96;
    int jj = tid & 63, kq = tid >> 6;
    int col = cgp * 64 + jj;
    const float* w = P.ada_w + (size_t)l * DM * 6144 + col;
    float a0 = 0, a1 = 0, a2 = 0;
    for (int k = kq * 256; k < kq * 256 + 256; ++k) {
      float wv = w[(size_t)k * 6144];
      a0 += sv[k] * wv; a1 += sv[1024 + k] * wv; a2 += sv[2048 + k] * wv;
    }
    red[(kq * 3 + 0) * 64 + jj] = a0; red[(kq * 3 + 1) * 64 + jj] = a1; red[(kq * 3 + 2) * 64 + jj] = a2;
    __syncthreads();
    if (tid < 192) {
      int row = tid >> 6;
      float s = red[(0 * 3 + row) * 64 + jj] + red[(1 * 3 + row) * 64 + jj] + red[(2 * 3 + row) * 64 + jj] +
                red[(3 * 3 + row) * 64 + jj] + P.ada_b[l * 6144 + col];
      P.mod[(l * 3 + row) * 6144 + col] = s;
    }
    __syncthreads();
  }
}

__device__ void conv_tile(const float* __restrict__ W, int Nsrc, int K, ushort_t* Wt, int kt, int nt, int Nvalid, float* tile) {
  const int tid = ltid();
#pragma unroll
  for (int p = 0; p < 4; ++p) {
    int kk = p * 16 + (tid >> 4), nn = (tid & 15) * 4;
    int n = nt * 64 + nn;
    float4 v = make_float4(0, 0, 0, 0);
    if (n < Nvalid) v = *(const float4*)(W + (size_t)(kt * 64 + kk) * Nsrc + n);
    tile[kk * 65 + nn + 0] = v.x; tile[kk * 65 + nn + 1] = v.y; tile[kk * 65 + nn + 2] = v.z; tile[kk * 65 + nn + 3] = v.w;
  }
  __syncthreads();
#pragma unroll
  for (int p = 0; p < 4; ++p) {
    int nn = p * 16 + (tid >> 4), kk = (tid & 15) * 4;
    uint2 o;
    o.x = pack2(tile[(kk + 0) * 65 + nn], tile[(kk + 1) * 65 + nn]);
    o.y = pack2(tile[(kk + 2) * 65 + nn], tile[(kk + 3) * 65 + nn]);
    *(uint2*)(Wt + (size_t)(nt * 64 + nn) * K + kt * 64 + kk) = o;
  }
  __syncthreads();
}
__device__ void phase_convw(const Params& P, int l, int bid, int nblk, char* smem) {
  float* tile = (float*)smem;
  const int n0 = 16 * 46, n1 = n0 + 256, n2 = n1 + 1024, n3 = n2 + 1024, n4 = n3 + 16;
  for (int it = bid; it < n4; it += nblk) {
    if (it < n0) conv_tile(P.w_in + (size_t)l * DM * IND, IND, DM, P.wt_in, it / 46, it % 46, IND, tile);
    else if (it < n1) { int i = it - n0; conv_tile(P.w_out + (size_t)l * DM * DM, DM, DM, P.wt_out, i / 16, i % 16, DM, tile); }
    else if (it < n2) { int i = it - n1; conv_tile(P.mlp_w1 + (size_t)l * DM * DFF, DFF, DM, P.w1t, i / 64, i % 64, DFF, tile); }
    else if (it < n3) { int i = it - n2; conv_tile(P.mlp_w2 + (size_t)l * DFF * DM, DM, DFF, P.w2t, i / 16, i % 16, DM, tile); }
    else { int i = it - n3; conv_tile(P.s5_glu_w + (size_t)l * 256 * 256, 256, 256, P.glut, i / 4, i % 4, 256, tile); }
  }
}

__device__ void phase_norm(const Params& P, int l, int which, int bid, int nblk) {
  const int wid = ltid() >> 6, lane = ltid() & 63;
  const float* g = (which == 0 ? P.norm1_g : P.norm2_g) + l * DM;
  const int shoff = which == 0 ? 0 : 3072, scoff = shoff + 1024;
  for (int r = bid * 4 + wid; r < NTOK; r += nblk * 4) {
    int b = r / TOK, t = r % TOK;
    int mrow = (t < CTX) ? 2 : b;
    const float* md = P.mod + (l * 3 + mrow) * 6144;
    const float4* xr = (const float4*)(P.xres + (size_t)r * DM);
    float4 v[4];
    float ss = 0;
#pragma unroll
    for (int i = 0; i < 4; ++i) {
      v[i] = xr[lane + 64 * i];
      ss += v[i].x * v[i].x + v[i].y * v[i].y + v[i].z * v[i].z + v[i].w * v[i].w;
    }
    ss = wave_sum(ss);
    float rstd = rsqrtf(ss * (1.f / DM) + 1e-6f);
#pragma unroll
    for (int i = 0; i < 4; ++i) {
      int col = (lane + 64 * i) * 4;
      float4 gg = *(const float4*)(g + col);
      float4 sc = *(const float4*)(md + scoff + col);
      float4 sh = *(const float4*)(md + shoff + col);
      float y0 = v[i].x * rstd * gg.x * (1.f + sc.x) + sh.x;
      float y1 = v[i].y * rstd * gg.y * (1.f + sc.y) + sh.y;
      float y2 = v[i].z * rstd * gg.z * (1.f + sc.z) + sh.z;
      float y3 = v[i].w * rstd * gg.w * (1.f + sc.w) + sh.w;
      uint2 o; o.x = pack2(y0, y1); o.y = pack2(y2, y3);
      *(uint2*)(P.h + (size_t)r * DM + col) = o;
    }
  }
}

enum { G_ZIN = 0, G_GLU = 1, G_WOUT = 2, G_W1 = 3, G_W2 = 4 };
template <int MODE>
__device__ void gemm_phase(const Params& P, int l, const ushort_t* A, const ushort_t* Bt, int K, int ntn, int bid, int nblk, char* smem) {
  ushort_t* As = (ushort_t*)smem;
  ushort_t* Bs = As + 128 * 72;
  const int tid = ltid(), wid = tid >> 6, lane = tid & 63, fr = lane & 15, fq = lane >> 4, wr = wid >> 1, wc = wid & 1;
  const int ntiles = (NTOK / 128) * ntn;
  const int nk = K / 64;
  for (int tile = bid; tile < ntiles; tile += nblk) {
    const int mt = tile / ntn, nt = tile % ntn;
    const int row0 = mt * 128, col0 = nt * 128;
    f32x4 acc[4][4];
#pragma unroll
    for (int m = 0; m < 4; ++m)
#pragma unroll
      for (int n = 0; n < 4; ++n) acc[m][n] = f32x4{0.f, 0.f, 0.f, 0.f};
    const ushort_t* Ag = A + (size_t)row0 * K;
    const ushort_t* Bg = Bt + (size_t)col0 * K;
    const int lrr = tid >> 3, lck = tid & 7;
    const ushort_t* Ap = Ag + (size_t)lrr * K + lck * 8;
    const ushort_t* Bp = Bg + (size_t)lrr * K + lck * 8;
    const size_t rs32 = (size_t)32 * K;
    uint4 ra0 = *(const uint4*)(Ap), ra1 = *(const uint4*)(Ap + rs32), ra2 = *(const uint4*)(Ap + 2 * rs32), ra3 = *(const uint4*)(Ap + 3 * rs32);
    uint4 rb0 = *(const uint4*)(Bp), rb1 = *(const uint4*)(Bp + rs32), rb2 = *(const uint4*)(Bp + 2 * rs32), rb3 = *(const uint4*)(Bp + 3 * rs32);
    ushort_t* Asw = As + lrr * 72 + lck * 8;
    ushort_t* Bsw = Bs + lrr * 72 + lck * 8;
    for (int kt = 0; kt < nk; ++kt) {
      *(uint4*)(Asw) = ra0; *(uint4*)(Asw + 32 * 72) = ra1; *(uint4*)(Asw + 64 * 72) = ra2; *(uint4*)(Asw + 96 * 72) = ra3;
      *(uint4*)(Bsw) = rb0; *(uint4*)(Bsw + 32 * 72) = rb1; *(uint4*)(Bsw + 64 * 72) = rb2; *(uint4*)(Bsw + 96 * 72) = rb3;
      __syncthreads();
      if (kt + 1 < nk) {
        const int ko = (kt + 1) * 64;
        ra0 = *(const uint4*)(Ap + ko); ra1 = *(const uint4*)(Ap + rs32 + ko); ra2 = *(const uint4*)(Ap + 2 * rs32 + ko); ra3 = *(const uint4*)(Ap + 3 * rs32 + ko);
        rb0 = *(const uint4*)(Bp + ko); rb1 = *(const uint4*)(Bp + rs32 + ko); rb2 = *(const uint4*)(Bp + 2 * rs32 + ko); rb3 = *(const uint4*)(Bp + 3 * rs32 + ko);
      }
#pragma unroll
      for (int ks = 0; ks < 2; ++ks) {
        bf16x8 a[4], b[4];
#pragma unroll
        for (int m = 0; m < 4; ++m) a[m] = *(const bf16x8*)(As + (wr * 64 + m * 16 + fr) * 72 + ks * 32 + fq * 8);
#pragma unroll
        for (int n = 0; n < 4; ++n) b[n] = *(const bf16x8*)(Bs + (wc * 64 + n * 16 + fr) * 72 + ks * 32 + fq * 8);
#pragma unroll
        for (int m = 0; m < 4; ++m)
#pragma unroll
          for (int n = 0; n < 4; ++n) acc[m][n] = __builtin_amdgcn_mfma_f32_16x16x32_bf16(a[m], b[n], acc[m][n], 0, 0, 0);
      }
      __syncthreads();
    }
#pragma unroll
    for (int m = 0; m < 4; ++m) {
#pragma unroll
      for (int j = 0; j < 4; ++j) {
        const int row = row0 + wr * 64 + m * 16 + fq * 4 + j;
        int mrow = 0;
        if (MODE == G_WOUT || MODE == G_W2) { int b = row / TOK, t = row % TOK; mrow = (t < CTX) ? 2 : b; }
#pragma unroll
        for (int n = 0; n < 4; ++n) {
          const int col = col0 + wc * 64 + n * 16 + fr;
          const float v = acc[m][n][j];
          if (MODE == G_ZIN) {
            if (col < IND) {
              P.z[(size_t)row * IND + col] = f2bf(v);
              if (col >= ZC_MLG && col < ZC_MLG + 16) P.gates[(size_t)row * 48 + col - ZC_MLG] = v;
              else if (col >= ZC_GLA) P.gates[(size_t)row * 48 + 16 + col - ZC_GLA] = v;
            }
          } else if (MODE == G_GLU) {
            float g = bf2f(P.s5g[(size_t)row * 256 + col]);
            float val = v + P.s5_glu_b[l * 256 + col];
            P.mix[(size_t)row * DM + col] = f2bf(g * sigmoidf_(val));
          } else if (MODE == G_WOUT) {
            float gate = P.mod[(l * 3 + mrow) * 6144 + 2048 + col];
            P.xres[(size_t)row * DM + col] += gate * v;
          } else if (MODE == G_W1) {
            float rl = fmaxf(v, 0.f);
            P.hidden[(size_t)row * DFF + col] = f2bf(rl * rl);
          } else {
            float gate = P.mod[(l * 3 + mrow) * 6144 + 5120 + col];
            P.xres[(size_t)row * DM + col] += gate * v;
          }
        }
      }
    }
  }
}

__device__ void phase_prep(const Params& P, int l, int bid, int nblk) {
  const size_t gtid = (size_t)bid * NT + ltid(), gstride = (size_t)nblk * NT;
  for (size_t idx = gtid; idx < (size_t)NTOK * 512; idx += gstride) {
    int r = (int)(idx >> 9), c = (int)(idx & 511);
    int t = r % TOK;
    const float* cw = P.ml_conv_w + (size_t)l * 3 * 512;
    float x0 = bf2f(P.z[(size_t)r * IND + ZC_MLQ + c]);
    float y = cw[512 + c] * x0 + P.ml_conv_b[l * 512 + c];
    if (t != 0 && t != CTX) y += cw[c] * bf2f(P.z[(size_t)(r - 1) * IND + ZC_MLQ + c]);
    if (t != CTX - 1 && t != TOK - 1) y += cw[1024 + c] * bf2f(P.z[(size_t)(r + 1) * IND + ZC_MLQ + c]);
    float s = y * sigmoidf_(y);
    if (c >= 256) s *= 0.125f;
    P.mlqk[(size_t)r * 512 + c] = f2bf(s);
  }
  for (size_t idx = gtid; idx < (size_t)NTOK * 256; idx += gstride) {
    int r = (int)(idx >> 8), dk = (int)(idx & 255);
    int d = dk >> 7, kk = dk & 127;
    const float* W = P.gla_alpha_w + ((size_t)(l * 2 + d) * 16) * 128 + kk;
    const float* a = P.gates + (size_t)r * 48 + 16 + d * 16;
    float v = P.gla_alpha_b[(l * 2 + d) * 128 + kk];
#pragma unroll
    for (int rr = 0; rr < 16; ++rr) v += a[rr] * W[rr * 128];
    float la = logsigmoidf_(v) * (1.f / 16.f);
    P.alpha[(size_t)r * 256 + dk] = __expf(la);
  }
  const float qscale = 0.17677669529663687f;
  for (size_t idx = gtid; idx < (size_t)NTOK * 256; idx += gstride) {
    int r = (int)(idx >> 8), rem = (int)(idx & 255);
    int which = rem >> 7, hm = (rem >> 4) & 7, i = rem & 15;
    int t = r % TOK;
    unsigned* p = (unsigned*)(P.z + (size_t)r * IND + (which ? ZC_DAK : ZC_DAQ) + hm * 32 + 2 * i);
    unsigned u = *p;
    float x1 = __uint_as_float(u << 16), x2 = __uint_as_float(u & 0xffff0000u);
    float o1 = x1, o2 = x2;
    if (t >= CTX) {
      int tl = t - CTX;
      float posv = (i < 8) ? (float)(tl >> 6) : (float)(tl & 63);
      float inv = powf(10000.f, -(float)(i & 7) * 0.125f);
      float ang = posv * inv;
      float cs = cosf(ang), sn = sinf(ang);
      o1 = x1 * cs - x2 * sn;
      o2 = x1 * sn + x2 * cs;
    }
    if (!which) { o1 *= qscale; o2 *= qscale; }
    *p = pack2(o1, o2);
  }
}

struct S5Par { float lbr, lbi; float bbr[16], bbi[16]; };
__device__ __forceinline__ void s5_params(const Params& P, int l, int d, int g, int p, S5Par& q) {
  int gi = (l * 2 + d) * 16 + g, idx = gi * 64 + p;
  float lre = P.s5_lam_re[idx], lim = P.s5_lam_im[idx];
  float dt = expf(P.s5_log_step[gi]);
  float mag = expf(lre * dt);
  q.lbr = mag * cosf(lim * dt); q.lbi = mag * sinf(lim * dt);
  float den = lre * lre + lim * lim;
  float fr_ = ((q.lbr - 1.f) * lre + q.lbi * lim) / den;
  float fi_ = (q.lbi * lre - (q.lbr - 1.f) * lim) / den;
#pragma unroll
  for (int h = 0; h < 16; ++h) {
    float br = P.s5_b_re[(size_t)idx * 16 + h], bi = P.s5_b_im[(size_t)idx * 16 + h];
    q.bbr[h] = fr_ * br - fi_ * bi;
    q.bbi[h] = fr_ * bi + fi_ * br;
  }
}
__device__ __forceinline__ void s5_stage_u(const Params& P, int b, int g, int j, int d, int lane, ushort_t* us) {
#pragma unroll
  for (int q = 0; q < 2; ++q) {
    int s = lane * 2 + q;
    int nl = d == 0 ? s : 127 - s;
    const uint4* src = (const uint4*)(P.z + (size_t)(b * TOK + j * 128 + nl) * IND + ZC_S5U + g * 16);
    uint4 v0 = src[0], v1 = src[1];
    *(uint4*)(us + s * 16) = v0;
    *(uint4*)(us + s * 16 + 8) = v1;
  }
}
__device__ void phase_s5_p1(const Params& P, int l, int bid, int nblk, char* smem) {
  const int wid = ltid() >> 6, lane = ltid() & 63;
  ushort_t* us = (ushort_t*)smem + wid * 2048;
  const int nitems = B_ * 2 * 16 * NCH;
  for (int base = bid * 4; base < nitems; base += nblk * 4) {
    int item = base + wid;
    int c = item % NCH, g = (item / NCH) % 16, d = (item / (NCH * 16)) % 2, b = item / (NCH * 32);
    int j = dir_chunk(d, c);
    S5Par q;
    s5_params(P, l, d, g, lane, q);
    __syncthreads();
    s5_stage_u(P, b, g, j, d, lane, us);
    __syncthreads();
    float hr = 0.f, hi = 0.f;
    for (int s = 0; s < 128; ++s) {
      float u[16];
      unpack8(*(const uint4*)(us + s * 16), u);
      unpack8(*(const uint4*)(us + s * 16 + 8), u + 8);
      float bur = 0.f, bui = 0.f;
#pragma unroll
      for (int h = 0; h < 16; ++h) { bur += q.bbr[h] * u[h]; bui += q.bbi[h] * u[h]; }
      float nr = q.lbr * hr - q.lbi * hi + bur;
      float ni = q.lbr * hi + q.lbi * hr + bui;
      hr = nr; hi = ni;
    }
    float2* st = (float2*)(P.s5st + (size_t)item * 128);
    st[lane] = make_float2(hr, hi);
  }
}
__device__ void phase_s5_p2(const Params& P, int l, int bid, int nblk) {
  const int wid = ltid() >> 6, lane = ltid() & 63;
  for (int it = bid * 4 + wid; it < B_ * 2 * 16; it += nblk * 4) {
    int g = it % 16, d = (it / 16) % 2;
    int gi = (l * 2 + d) * 16 + g, idx = gi * 64 + lane;
    float lre = P.s5_lam_re[idx], lim = P.s5_lam_im[idx];
    float dt = expf(P.s5_log_step[gi]);
    float mag = expf(lre * dt);
    float ar = mag * cosf(lim * dt), ai = mag * sinf(lim * dt);
#pragma unroll
    for (int i = 0; i < 7; ++i) { float nr = ar * ar - ai * ai, ni = 2.f * ar * ai; ar = nr; ai = ni; }
    float cr = 0.f, ci = 0.f;
    float2* st = (float2*)(P.s5st + (size_t)it * NCH * 128);
    for (int c0 = 0; c0 < NCH; c0 += 10) {
      float2 x[10];
#pragma unroll
      for (int i = 0; i < 10; ++i) x[i] = st[(c0 + i) * 64 + lane];
#pragma unroll
      for (int i = 0; i < 10; ++i) {
        st[(c0 + i) * 64 + lane] = make_float2(cr, ci);
        float nr = ar * cr - ai * ci + x[i].x;
        float ni = ar * ci + ai * cr + x[i].y;
        cr = nr; ci = ni;
      }
    }
  }
}
template <int DIR>
__device__ __forceinline__ void s5_p3_dir(const Params& P, int l, int b, int g, int j, int lane, ushort_t* us, ushort_t* hs, float* ys) {
  const int fr = lane & 15, fq = lane >> 4;
  const int c = dir_chunk(DIR, j);
  S5Par q;
  s5_params(P, l, DIR, g, lane, q);
  bf16x8 cb[4];
  {
    const float* cre = P.s5_c_re + ((size_t)((l * 2 + DIR) * 16 + g) * 16 + fr) * 64;
    const float* cim = P.s5_c_im + ((size_t)((l * 2 + DIR) * 16 + g) * 16 + fr) * 64;
#pragma unroll
    for (int ks = 0; ks < 4; ++ks) {
#pragma unroll
      for (int e = 0; e < 8; ++e) {
        int k = ks * 32 + fq * 8 + e, p = k >> 1;
        float v = (e & 1) ? -cim[p] : cre[p];
        cb[ks][e] = (short)f2bf(v);
      }
    }
  }
  float2 st = ((const float2*)(P.s5st + (size_t)(((b * 2 + DIR) * 16 + g) * NCH + c) * 128))[lane];
  float hr = st.x, hi = st.y;
  __syncthreads();
  s5_stage_u(P, b, g, j, DIR, lane, us);
  __syncthreads();
  const int col = g * 16 + fr;
  const float dsk = P.s5_d[l * 256 + col];
#pragma unroll 1
  for (int sbi = 0; sbi < 8; ++sbi) {
    const int nsb = DIR == 0 ? sbi : 7 - sbi;
    for (int tii = 0; tii < 16; ++tii) {
      const int s = sbi * 16 + tii;
      const int tin = DIR == 0 ? tii : 15 - tii;
      float u[16];
      unpack8(*(const uint4*)(us + s * 16), u);
      unpack8(*(const uint4*)(us + s * 16 + 8), u + 8);
      float bur = 0.f, bui = 0.f;
#pragma unroll
      for (int h = 0; h < 16; ++h) { bur += q.bbr[h] * u[h]; bui += q.bbi[h] * u[h]; }
      float nr = q.lbr * hr - q.lbi * hi + bur;
      float ni = q.lbr * hi + q.lbi * hr + bui;
      hr = nr; hi = ni;
      *(unsigned*)(hs + tin * 136 + 2 * lane) = pack2(hr, hi);
    }
    __syncthreads();
    f32x4 acc = f32x4{0.f, 0.f, 0.f, 0.f};
#pragma unroll
    for (int ks = 0; ks < 4; ++ks) {
      bf16x8 a = *(const bf16x8*)(hs + fr * 136 + ks * 32 + fq * 8);
      acc = __builtin_amdgcn_mfma_f32_16x16x32_bf16(a, cb[ks], acc, 0, 0, 0);
    }
    if (DIR == 0) {
#pragma unroll
      for (int jx = 0; jx < 4; ++jx) ys[(nsb * 16 + fq * 4 + jx) * 16 + fr] = acc[jx];
    } else {
#pragma unroll
      for (int jx = 0; jx < 4; ++jx) {
        const int tl = nsb * 16 + fq * 4 + jx;
        const size_t r = (size_t)(b * TOK + j * 128 + tl);
        float uval = bf2f(P.z[r * IND + ZC_S5U + col]);
        float y = acc[jx] + ys[tl * 16 + fr] + dsk * uval;
        float t3 = 0.7978845608028654f * (y + 0.044715f * y * y * y);
        float gl = 0.5f * y * (1.f + tanhf(t3));
        P.s5g[r * 256 + col] = f2bf(gl);
      }
    }
    __syncthreads();
  }
}
__device__ void phase_s5_p3(const Params& P, int l, int bid, int nblk, char* smem) {
  const int wid = ltid() >> 6, lane = ltid() & 63;
  ushort_t* us = (ushort_t*)smem + wid * 2048;
  ushort_t* hs = (ushort_t*)smem + 4 * 2048 + wid * (16 * 136);
  float* ys = (float*)(smem + 16384 + 17408) + wid * 2048;
  const int nitems = B_ * 16 * NCH;
  for (int base = bid * 4; base < nitems; base += nblk * 4) {
    int item = base + wid;
    int j = item % NCH, g = (item / NCH) % 16, b = item / (NCH * 16);
    s5_p3_dir<0>(P, l, b, g, j, lane, us, hs, ys);
    s5_p3_dir<1>(P, l, b, g, j, lane, us, hs, ys);
  }
}

__device__ __forceinline__ void ml_stage(const Params& P, int l, int b, int h, int d, int j, int sb, int lane, float* ks, float* qs,
                                         float* vs, float* gs, bool need_q) {
  const int ti = lane >> 2, part = lane & 3;
  const int sl = sb * 16 + ti;
  const int nl = d == 0 ? sl : 127 - sl;
  const size_t r = (size_t)(b * TOK + j * 128 + nl);
  float f[16];
  {
    const uint4* src = (const uint4*)(P.mlqk + r * 512 + 256 + h * 64 + part * 16);
    unpack8(src[0], f); unpack8(src[1], f + 8);
    float4* dst = (float4*)(ks + ti * 64 + part * 16);
    dst[0] = make_float4(f[0], f[1], f[2], f[3]); dst[1] = make_float4(f[4], f[5], f[6], f[7]);
    dst[2] = make_float4(f[8], f[9], f[10], f[11]); dst[3] = make_float4(f[12], f[13], f[14], f[15]);
  }
  if (need_q) {
    const uint4* src = (const uint4*)(P.mlqk + r * 512 + h * 64 + part * 16);
    unpack8(src[0], f); unpack8(src[1], f + 8);
    float4* dst = (float4*)(qs + ti * 64 + part * 16);
    dst[0] = make_float4(f[0], f[1], f[2], f[3]); dst[1] = make_float4(f[4], f[5], f[6], f[7]);
    dst[2] = make_float4(f[8], f[9], f[10], f[11]); dst[3] = make_float4(f[12], f[13], f[14], f[15]);
  }
  {
    const uint4* src = (const uint4*)(P.z + r * IND + ZC_MLV + h * 64 + part * 16);
    unpack8(src[0], f); unpack8(src[1], f + 8);
    float4* dst = (float4*)(vs + ti * 64 + part * 16);
    dst[0] = make_float4(f[0], f[1], f[2], f[3]); dst[1] = make_float4(f[4], f[5], f[6], f[7]);
    dst[2] = make_float4(f[8], f[9], f[10], f[11]); dst[3] = make_float4(f[12], f[13], f[14], f[15]);
  }
  if (part == 0) {
    float ig = P.gates[r * 48 + (2 * d) * 4 + h] + P.ml_gate_b[l * 16 + (2 * d) * 4 + h];
    float fp = P.gates[r * 48 + (2 * d + 1) * 4 + h] + P.ml_gate_b[l * 16 + (2 * d + 1) * 4 + h];
    gs[ti * 2] = ig;
    gs[ti * 2 + 1] = logsigmoidf_(fp);
  }
}
#define ML_WAVE_LDS (3 * 1024 + 32)
__device__ void phase_ml_p1(const Params& P, int l, int bid, int nblk, char* smem) {
  const int wid = ltid() >> 6, lane = ltid() & 63;
  float* ks = (float*)smem + wid * ML_WAVE_LDS;
  float* qs = ks + 1024; float* vs = qs + 1024; float* gs = vs + 1024;
  const int nitems = B_ * 4 * 2 * NCH;
  for (int base = bid * 4; base < nitems; base += nblk * 4) {
    int item = base + wid;
    int c = item % NCH, d = (item / NCH) % 2, h = (item / (NCH * 2)) % 4, b = item / (NCH * 8);
    int j = dir_chunk(d, c);
    float C[64];
#pragma unroll
    for (int k = 0; k < 64; ++k) C[k] = 0.f;
    float n = 0.f, m = -INFINITY, bsum = 0.f;
    for (int sb = 0; sb < 8; ++sb) {
      __syncthreads();
      ml_stage(P, l, b, h, d, j, sb, lane, ks, qs, vs, gs, false);
      __syncthreads();
      for (int ti = 0; ti < 16; ++ti) {
        float ig = gs[ti * 2], lf = gs[ti * 2 + 1];
        float vv = vs[ti * 64 + lane];
        float mn = fmaxf(lf + m, ig);
        float a = __expf(lf + m - mn), sc = __expf(ig - mn);
        m = mn; bsum += lf;
        float sv = sc * vv;
        const float4* k4 = (const float4*)(ks + ti * 64);
#pragma unroll
        for (int k = 0; k < 16; ++k) {
          float4 kv = k4[k];
          C[4 * k + 0] = a * C[4 * k + 0] + sv * kv.x; C[4 * k + 1] = a * C[4 * k + 1] + sv * kv.y;
          C[4 * k + 2] = a * C[4 * k + 2] + sv * kv.z; C[4 * k + 3] = a * C[4 * k + 3] + sv * kv.w;
        }
        n = a * n + sc * ks[ti * 64 + lane];
      }
    }
    float* st = P.mlst + (size_t)item * MLST_SZ;
#pragma unroll
    for (int k = 0; k < 64; ++k) st[k * 64 + lane] = C[k];
    st[4096 + lane] = n;
    if (lane == 0) { st[4160] = m; st[4161] = bsum; }
  }
}
__device__ void phase_ml_p2(const Params& P, int bid, int nblk) {
  const int wid = ltid() >> 6, lane = ltid() & 63;
  for (int it = bid * 4 + wid; it < 16 * 65; it += nblk * 4) {
    int bhd = it / 65, slab = it % 65;
    int e = slab * 64 + lane;
    float st = 0.f, m = 0.f;
    float* base = P.mlst + (size_t)bhd * NCH * MLST_SZ;
    for (int c0 = 0; c0 < NCH; c0 += 10) {
      float x[10], gt[10], bt[10];
#pragma unroll
      for (int i = 0; i < 10; ++i) {
        const float* pc = base + (size_t)(c0 + i) * MLST_SZ;
        x[i] = pc[e]; gt[i] = pc[4160]; bt[i] = pc[4161];
      }
#pragma unroll
      for (int i = 0; i < 10; ++i) {
        float* pc = base + (size_t)(c0 + i) * MLST_SZ;
        float mn = fmaxf(bt[i] + m, gt[i]);
        float a = __expf(bt[i] + m - mn), s = __expf(gt[i] - mn);
        pc[e] = st;
        st = a * st + s * x[i];
        if (slab == 0 && lane == 0) pc[4162] = m;
        m = mn;
      }
    }
  }
}
__device__ void phase_ml_p3(const Params& P, int l, int bid, int nblk, char* smem) {
  const int wid = ltid() >> 6, lane = ltid() & 63;
  float* ks = (float*)smem + wid * ML_WAVE_LDS;
  float* qs = ks + 1024; float* vs = qs + 1024; float* gs = vs + 1024;
  const int nitems = B_ * 4 * 2 * NCH;
  for (int base = bid * 4; base < nitems; base += nblk * 4) {
    int item = base + wid;
    int c = item % NCH, d = (item / NCH) % 2, h = (item / (NCH * 2)) % 4, b = item / (NCH * 8);
    int j = dir_chunk(d, c);
    const float* st = P.mlst + (size_t)item * MLST_SZ;
    float C[64];
#pragma unroll
    for (int k = 0; k < 64; ++k) C[k] = st[k * 64 + lane];
    float n = st[4096 + lane], m = st[4162];
    ushort_t* outp = d == 0 ? (P.mix + 256 + h * 64 + lane) : (P.z + ZC_MLQ + h * 64 + lane);
    const size_t ostride = d == 0 ? DM : IND;
    for (int sb = 0; sb < 8; ++sb) {
      __syncthreads();
      ml_stage(P, l, b, h, d, j, sb, lane, ks, qs, vs, gs, true);
      __syncthreads();
      for (int ti = 0; ti < 16; ++ti) {
        float ig = gs[ti * 2], lf = gs[ti * 2 + 1];
        float vv = vs[ti * 64 + lane];
        float mn = fmaxf(lf + m, ig);
        float a = __expf(lf + m - mn), sc = __expf(ig - mn);
        m = mn;
        float sv = sc * vv;
        const float4* k4 = (const float4*)(ks + ti * 64);
        const float4* q4 = (const float4*)(qs + ti * 64);
        float num0 = 0.f, num1 = 0.f, num2 = 0.f, num3 = 0.f;
#pragma unroll
        for (int k = 0; k < 16; ++k) {
          float4 kv = k4[k], qv = q4[k];
          C[4 * k + 0] = a * C[4 * k + 0] + sv * kv.x; C[4 * k + 1] = a * C[4 * k + 1] + sv * kv.y;
          C[4 * k + 2] = a * C[4 * k + 2] + sv * kv.z; C[4 * k + 3] = a * C[4 * k + 3] + sv * kv.w;
          num0 += C[4 * k + 0] * qv.x; num1 += C[4 * k + 1] * qv.y; num2 += C[4 * k + 2] * qv.z; num3 += C[4 * k + 3] * qv.w;
        }
        n = a * n + sc * ks[ti * 64 + lane];
        float den = wave_sum(n * qs[ti * 64 + lane]);
        float hv = ((num0 + num1) + (num2 + num3)) / fmaxf(fabsf(den), __expf(-m));
        int sl = sb * 16 + ti;
        int nl = d == 0 ? sl : 127 - sl;
        size_t r = (size_t)(b * TOK + j * 128 + nl);
        outp[r * ostride] = f2bf(hv);
      }
    }
  }
}

#define GL_WAVE_LDS (512 * 3 + 1024)
__device__ __forceinline__ void gl_stage(const Params& P, int b, int h, int d, int j, int sb, int lane, float* ks, float* qs,
                                         float* as, float* vs, bool need_q) {
  const int ti = lane >> 2, part = lane & 3;
  const int sl = sb * 16 + ti;
  const int nl = d == 0 ? sl : 127 - sl;
  const size_t r = (size_t)(b * TOK + j * 128 + nl);
  float f[16];
  {
    unpack8(*(const uint4*)(P.z + r * IND + ZC_GLK + h * 32 + part * 8), f);
    float4* dst = (float4*)(ks + ti * 32 + part * 8);
    dst[0] = make_float4(f[0], f[1], f[2], f[3]); dst[1] = make_float4(f[4], f[5], f[6], f[7]);
  }
  if (need_q) {
    const float qs_ = 0.17677669529663687f;
    unpack8(*(const uint4*)(P.z + r * IND + ZC_GLQ + h * 32 + part * 8), f);
    float4* dst = (float4*)(qs + ti * 32 + part * 8);
    dst[0] = make_float4(f[0] * qs_, f[1] * qs_, f[2] * qs_, f[3] * qs_);
    dst[1] = make_float4(f[4] * qs_, f[5] * qs_, f[6] * qs_, f[7] * qs_);
  }
  {
    const float4* src = (const float4*)(P.alpha + r * 256 + d * 128 + h * 32 + part * 8);
    float4* dst = (float4*)(as + ti * 32 + part * 8);
    dst[0] = src[0]; dst[1] = src[1];
  }
  {
    const uint4* src = (const uint4*)(P.z + r * IND + ZC_GLV + h * 64 + part * 16);
    unpack8(src[0], f); unpack8(src[1], f + 8);
    float4* dst = (float4*)(vs + ti * 64 + part * 16);
    dst[0] = make_float4(f[0], f[1], f[2], f[3]); dst[1] = make_float4(f[4], f[5], f[6], f[7]);
    dst[2] = make_float4(f[8], f[9], f[10], f[11]); dst[3] = make_float4(f[12], f[13], f[14], f[15]);
  }
}
__device__ void phase_gl_p1(const Params& P, int bid, int nblk, char* smem) {
  const int wid = ltid() >> 6, lane = ltid() & 63;
  float* ks = (float*)smem + wid * GL_WAVE_LDS;
  float* qs = ks + 512; float* as = qs + 512; float* vs = as + 512;
  const int nitems = B_ * 4 * 2 * NCH;
  for (int base = bid * 4; base < nitems; base += nblk * 4) {
    int item = base + wid;
    int c = item % NCH, d = (item / NCH) % 2, h = (item / (NCH * 2)) % 4, b = item / (NCH * 8);
    int j = dir_chunk(d, c);
    float S[32];
#pragma unroll
    for (int k = 0; k < 32; ++k) S[k] = 0.f;
    float ap = 1.f;
    for (int sb = 0; sb < 8; ++sb) {
      __syncthreads();
      gl_stage(P, b, h, d, j, sb, lane, ks, qs, as, vs, false);
      __syncthreads();
      for (int ti = 0; ti < 16; ++ti) {
        float vv = vs[ti * 64 + lane];
        const float4* k4 = (const float4*)(ks + ti * 32);
        const float4* a4 = (const float4*)(as + ti * 32);
#pragma unroll
        for (int k = 0; k < 8; ++k) {
          float4 kv = k4[k], av = a4[k];
          S[4 * k + 0] = av.x * S[4 * k + 0] + kv.x * vv; S[4 * k + 1] = av.y * S[4 * k + 1] + kv.y * vv;
          S[4 * k + 2] = av.z * S[4 * k + 2] + kv.z * vv; S[4 * k + 3] = av.w * S[4 * k + 3] + kv.w * vv;
        }
        ap *= as[ti * 32 + (lane & 31)];
      }
    }
    float* st = P.glast + (size_t)item * GLST_SZ;
#pragma unroll
    for (int k = 0; k < 32; ++k) st[k * 64 + lane] = S[k];
    if (lane < 32) st[2048 + lane] = ap;
  }
}
__device__ void phase_gl_p2(const Params& P, int bid, int nblk) {
  const int wid = ltid() >> 6, lane = ltid() & 63;
  for (int it = bid * 4 + wid; it < 16 * 32; it += nblk * 4) {
    int bhd = it / 32, slab = it % 32;
    int e = slab * 64 + lane;
    float st = 0.f;
    float* base = P.glast + (size_t)bhd * NCH * GLST_SZ;
    for (int c0 = 0; c0 < NCH; c0 += 10) {
      float x[10], A[10];
#pragma unroll
      for (int i = 0; i < 10; ++i) {
        const float* pc = base + (size_t)(c0 + i) * GLST_SZ;
        x[i] = pc[e]; A[i] = pc[2048 + slab];
      }
#pragma unroll
      for (int i = 0; i < 10; ++i) {
        float* pc = base + (size_t)(c0 + i) * GLST_SZ;
        pc[e] = st;
        st = A[i] * st + x[i];
      }
    }
  }
}
__device__ void phase_gl_p3(const Params& P, int bid, int nblk, char* smem) {
  const int wid = ltid() >> 6, lane = ltid() & 63;
  float* ks = (float*)smem + wid * GL_WAVE_LDS;
  float* qs = ks + 512; float* as = qs + 512; float* vs = as + 512;
  const int nitems = B_ * 4 * 2 * NCH;
  for (int base = bid * 4; base < nitems; base += nblk * 4) {
    int item = base + wid;
    int c = item % NCH, d = (item / NCH) % 2, h = (item / (NCH * 2)) % 4, b = item / (NCH * 8);
    int j = dir_chunk(d, c);
    const float* st = P.glast + (size_t)item * GLST_SZ;
    float S[32];
#pragma unroll
    for (int k = 0; k < 32; ++k) S[k] = st[k * 64 + lane];
    ushort_t* outp = d == 0 ? (P.mix + 768 + h * 64 + lane) : (P.z + ZC_MLK + h * 64 + lane);
    const size_t ostride = d == 0 ? DM : IND;
    for (int sb = 0; sb < 8; ++sb) {
      __syncthreads();
      gl_stage(P, b, h, d, j, sb, lane, ks, qs, as, vs, true);
      __syncthreads();
      for (int ti = 0; ti < 16; ++ti) {
        float vv = vs[ti * 64 + lane];
        const float4* k4 = (const float4*)(ks + ti * 32);
        const float4* a4 = (const float4*)(as + ti * 32);
        const float4* q4 = (const float4*)(qs + ti * 32);
        float o0 = 0.f, o1 = 0.f, o2 = 0.f, o3 = 0.f;
#pragma unroll
        for (int k = 0; k < 8; ++k) {
          float4 kv = k4[k], av = a4[k], qv = q4[k];
          S[4 * k + 0] = av.x * S[4 * k + 0] + kv.x * vv; S[4 * k + 1] = av.y * S[4 * k + 1] + kv.y * vv;
          S[4 * k + 2] = av.z * S[4 * k + 2] + kv.z * vv; S[4 * k + 3] = av.w * S[4 * k + 3] + kv.w * vv;
          o0 += qv.x * S[4 * k + 0]; o1 += qv.y * S[4 * k + 1]; o2 += qv.z * S[4 * k + 2]; o3 += qv.w * S[4 * k + 3];
        }
        int sl = sb * 16 + ti;
        int nl = d == 0 ? sl : 127 - sl;
        size_t r = (size_t)(b * TOK + j * 128 + nl);
        outp[r * ostride] = f2bf((o0 + o1) + (o2 + o3));
      }
    }
  }
}
__device__ void phase_finish(const Params& P, int l, int bid, int nblk) {
  const int wid = ltid() >> 6, lane = ltid() & 63;
  for (int it = bid * 4 + wid; it < NTOK * 2; it += nblk * 4) {
    const int r = it >> 1, which = it & 1;
    const int ch = lane * 4;
    ushort_t* mp = P.mix + (size_t)r * DM + (which ? 768 : 256) + ch;
    const ushort_t* zp = P.z + (size_t)r * IND + (which ? ZC_MLK : ZC_MLQ) + ch;
    uint2 a = *(const uint2*)mp, bb = *(const uint2*)zp;
    float v[4];
    v[0] = __uint_as_float(a.x << 16) + __uint_as_float(bb.x << 16);
    v[1] = __uint_as_float(a.x & 0xffff0000u) + __uint_as_float(bb.x & 0xffff0000u);
    v[2] = __uint_as_float(a.y << 16) + __uint_as_float(bb.y << 16);
    v[3] = __uint_as_float(a.y & 0xffff0000u) + __uint_as_float(bb.y & 0xffff0000u);
    float ss = v[0] * v[0] + v[1] * v[1] + v[2] * v[2] + v[3] * v[3];
    ss += __shfl_xor(ss, 1); ss += __shfl_xor(ss, 2); ss += __shfl_xor(ss, 4); ss += __shfl_xor(ss, 8);
    float rstd = rsqrtf(ss * (1.f / 64.f) + 1e-6f);
    uint2 gz = *(const uint2*)(P.z + (size_t)r * IND + (which ? ZC_GLR : ZC_MLO) + ch);
    float gt[4] = {__uint_as_float(gz.x << 16), __uint_as_float(gz.x & 0xffff0000u), __uint_as_float(gz.y << 16),
                   __uint_as_float(gz.y & 0xffff0000u)};
    float o[4];
#pragma unroll
    for (int i = 0; i < 4; ++i) {
      if (which == 0) {
        float gain = P.ml_norm_g[l * 256 + ch + i];
        o[i] = sigmoidf_(gt[i]) * (v[i] * rstd * gain);
      } else {
        float gain = P.gla_norm_g[l * 64 + ((ch + i) & 63)];
        o[i] = (v[i] * rstd * gain) * (gt[i] * sigmoidf_(gt[i]));
      }
    }
    uint2 ov; ov.x = pack2(o[0], o[1]); ov.y = pack2(o[2], o[3]);
    *(uint2*)mp = ov;
  }
}

__device__ void phase_vt(const Params& P, int bid, int nblk, char* smem) {
  ushort_t* tile = (ushort_t*)smem;
  const int tid = ltid();
  const int nitems = B_ * 4 * (TOK / 64);
  for (int it = bid; it < nitems; it += nblk) {
    const int tb = it % 260, head = (it / 260) % 4, b = it / 1040;
    __syncthreads();
#pragma unroll
    for (int i = 0; i < 2; ++i) {
      int id = tid + 256 * i, tok = id >> 3, vc = id & 7;
      uint4 v = *(const uint4*)(P.z + (size_t)(b * TOK + tb * 64 + tok) * IND + ZC_DAV + head * 64 + vc * 8);
      unsigned* d = (unsigned*)(tile + tok * 66 + vc * 8);
      d[0] = v.x; d[1] = v.y; d[2] = v.z; d[3] = v.w;
    }
    __syncthreads();
#pragma unroll
    for (int i = 0; i < 2; ++i) {
      int id = tid + 256 * i, v = id >> 3, tc = id & 7;
      unsigned w[4];
#pragma unroll
      for (int e = 0; e < 4; ++e)
        w[e] = (unsigned)tile[(tc * 8 + 2 * e) * 66 + v] | ((unsigned)tile[(tc * 8 + 2 * e + 1) * 66 + v] << 16);
      *(uint4*)(P.vt + (size_t)((b * 4 + head) * 64 + v) * TOK + tb * 64 + tc * 8) = make_uint4(w[0], w[1], w[2], w[3]);
    }
  }
}

__device__ void phase_attn(const Params& P, int l, int bid, int nblk, char* smem) {
  ushort_t* Ks = (ushort_t*)smem;
  ushort_t* Vt = Ks + 64 * 72;
  const int tid = ltid(), wid = tid >> 6, lane = tid & 63, r = lane & 31, h = lane >> 5;
  const float lam_init = 0.8f - 0.6f * expf(-0.3f * (float)l);
  float lam;
  {
    const float* lp = P.da_lam + l * 128;
    float s01 = 0.f, s23 = 0.f;
    for (int i = 0; i < 32; ++i) { s01 += lp[i] * lp[32 + i]; s23 += lp[64 + i] * lp[96 + i]; }
    lam = expf(s01) - expf(s23) + lam_init;
  }
  const float LOG2E = 1.4426950408889634f;
  const int nitems = 1024 + 16;
  const int srow = tid >> 3, sck = tid & 7;
  for (int item = bid; item < nitems; item += nblk) {
    int b, head, q0, nkeys;
    if (item < 1024) { int qb = item % 128; head = (item / 128) % 4; b = item / 512; q0 = CTX + qb * 128; nkeys = TOK; }
    else { int i2 = item - 1024; int qb = i2 % 2; head = (i2 / 2) % 4; b = i2 / 8; q0 = qb * 128; nkeys = CTX; }
    const size_t qrow = (size_t)(b * TOK + q0 + wid * 32 + r);
    bf16x8 Qf[2][2];
#pragma unroll
    for (int mp = 0; mp < 2; ++mp)
#pragma unroll
      for (int s = 0; s < 2; ++s) Qf[mp][s] = *(const bf16x8*)(P.z + qrow * IND + ZC_DAQ + head * 64 + mp * 32 + 16 * s + 8 * h);
    f32x16 O[2][2];
#pragma unroll
    for (int mp = 0; mp < 2; ++mp)
#pragma unroll
      for (int mt = 0; mt < 2; ++mt)
#pragma unroll
        for (int i = 0; i < 16; ++i) O[mp][mt][i] = 0.f;
    float m[2] = {-INFINITY, -INFINITY}, lsum[2] = {0.f, 0.f};
    const ushort_t* kbase = P.z + (size_t)(b * TOK) * IND + ZC_DAK + head * 64 + (size_t)srow * IND + sck * 8;
    const ushort_t* vbase = P.vt + (size_t)((b * 4 + head) * 64 + srow) * TOK + sck * 8;
    uint4 rk0 = *(const uint4*)(kbase), rk1 = *(const uint4*)(kbase + (size_t)32 * IND);
    uint4 rv0 = *(const uint4*)(vbase), rv1 = *(const uint4*)(vbase + (size_t)32 * TOK);
    const int ntile = nkeys / 64;
    for (int kt = 0; kt < ntile; ++kt) {
      __syncthreads();
      *(uint4*)(Ks + srow * 72 + sck * 8) = rk0; *(uint4*)(Ks + (srow + 32) * 72 + sck * 8) = rk1;
      *(uint4*)(Vt + srow * 72 + sck * 8) = rv0; *(uint4*)(Vt + (srow + 32) * 72 + sck * 8) = rv1;
      __syncthreads();
      if (kt + 1 < ntile) {
        const ushort_t* kp = kbase + (size_t)((kt + 1) * 64) * IND;
        const ushort_t* vp = vbase + (kt + 1) * 64;
        rk0 = *(const uint4*)(kp); rk1 = *(const uint4*)(kp + (size_t)32 * IND);
        rv0 = *(const uint4*)(vp); rv1 = *(const uint4*)(vp + (size_t)32 * TOK);
      }
#pragma unroll
      for (int kb = 0; kb < 2; ++kb) {
        bf16x8 Pf[2][2];
#pragma unroll
        for (int mp = 0; mp < 2; ++mp) {
          f32x16 S;
#pragma unroll
          for (int i = 0; i < 16; ++i) S[i] = 0.f;
#pragma unroll
          for (int s = 0; s < 2; ++s) {
            bf16x8 a = *(const bf16x8*)(Ks + (kb * 32 + r) * 72 + mp * 32 + 16 * s + 8 * h);
            S = __builtin_amdgcn_mfma_f32_32x32x16_bf16(a, Qf[mp][s], S, 0, 0, 0);
          }
          float mx = S[0];
#pragma unroll
          for (int i = 1; i < 16; ++i) mx = fmaxf(mx, S[i]);
          mx = fmaxf(mx, __shfl_xor(mx, 32)) * LOG2E;
          if (__any(mx > m[mp])) {
            float mn = fmaxf(m[mp], mx);
            float al = __builtin_amdgcn_exp2f(m[mp] - mn);
            m[mp] = mn;
            lsum[mp] *= al;
#pragma unroll
            for (int i = 0; i < 16; ++i) { O[mp][0][i] *= al; O[mp][1][i] *= al; }
          }
          float p[16];
          float ps = 0.f;
#pragma unroll
          for (int i = 0; i < 16; ++i) { p[i] = __builtin_amdgcn_exp2f(fmaf(S[i], LOG2E, -m[mp])); ps += p[i]; }
          lsum[mp] += ps;
#pragma unroll
          for (int s = 0; s < 2; ++s) {
            uint4 w;
            w.x = pack2(p[8 * s + 0], p[8 * s + 1]); w.y = pack2(p[8 * s + 2], p[8 * s + 3]);
            w.z = pack2(p[8 * s + 4], p[8 * s + 5]); w.w = pack2(p[8 * s + 6], p[8 * s + 7]);
            Pf[mp][s] = __builtin_bit_cast(bf16x8, w);
          }
        }
#pragma unroll
        for (int mt = 0; mt < 2; ++mt) {
#pragma unroll
          for (int s = 0; s < 2; ++s) {
            const ushort_t* vp = Vt + (mt * 32 + r) * 72 + kb * 32 + 16 * s + 4 * h;
            uint2 lo = *(const uint2*)(vp), hi = *(const uint2*)(vp + 8);
            bf16x8 a = __builtin_bit_cast(bf16x8, make_uint4(lo.x, lo.y, hi.x, hi.y));
            O[0][mt] = __builtin_amdgcn_mfma_f32_32x32x16_bf16(a, Pf[0][s], O[0][mt], 0, 0, 0);
            O[1][mt] = __builtin_amdgcn_mfma_f32_32x32x16_bf16(a, Pf[1][s], O[1][mt], 0, 0, 0);
          }
        }
      }
    }
    const float l0 = lsum[0] + __shfl_xor(lsum[0], 32), l1 = lsum[1] + __shfl_xor(lsum[1], 32);
    const float i0 = 1.f / l0, i1 = lam / l1;
    float ss = 0.f;
#pragma unroll
    for (int mt = 0; mt < 2; ++mt)
#pragma unroll
      for (int i = 0; i < 16; ++i) {
        float v = O[0][mt][i] * i0 - O[1][mt][i] * i1;
        O[0][mt][i] = v;
        ss += v * v;
      }
    ss += __shfl_xor(ss, 32);
    const float rstd = rsqrtf(ss * (1.f / 64.f) + 1e-6f) * (1.f - lam_init);
    ushort_t* op = P.mix + qrow * DM + 512 + head * 64;
#pragma unroll
    for (int mt = 0; mt < 2; ++mt)
#pragma unroll
      for (int g = 0; g < 4; ++g) {
        const int v0 = mt * 32 + 8 * g + 4 * h;
        const float4 gn = *(const float4*)(P.da_norm_g + l * 64 + v0);
        uint2 o;
        o.x = pack2(O[0][mt][4 * g + 0] * rstd * gn.x, O[0][mt][4 * g + 1] * rstd * gn.y);
        o.y = pack2(O[0][mt][4 * g + 2] * rstd * gn.z, O[0][mt][4 * g + 3] * rstd * gn.w);
        *(uint2*)(op + v0) = o;
      }
  }
}

__device__ void phase_final(const Params& P, int bid, int nblk) {
  const int wid = ltid() >> 6, lane = ltid() & 63;
  for (int q = bid * 4 + wid; q < B_ * SEQ; q += nblk * 4) {
    int b = q / SEQ, tl = q % SEQ;
    const float4* xr = (const float4*)(P.xres + (size_t)(b * TOK + CTX + tl) * DM);
    float4 v[4];
    float ss = 0;
#pragma unroll
    for (int i = 0; i < 4; ++i) {
      v[i] = xr[lane + 64 * i];
      ss += v[i].x * v[i].x + v[i].y * v[i].y + v[i].z * v[i].z + v[i].w * v[i].w;
    }
    ss = wave_sum(ss);
    float rstd = rsqrtf(ss * (1.f / DM) + 1e-6f);
    float4* o = (float4*)(P.out + (size_t)q * DM);
#pragma unroll
    for (int i = 0; i < 4; ++i) {
      float4 gg = ((const float4*)P.final_norm_g)[lane + 64 * i];
      o[lane + 64 * i] = make_float4(v[i].x * rstd * gg.x, v[i].y * rstd * gg.y, v[i].z * rstd * gg.z, v[i].w * rstd * gg.w);
    }
  }
}

constexpr int NPH = 11;
__device__ __forceinline__ void run_phase(const Params& P, int l, int ph, int bid, int nblk, char* smem) {
  bid = launder_s(bid); nblk = launder_s(nblk); l = launder_s(l);
  switch (ph) {
    case 0: phase_convw(P, l, bid, nblk, smem); phase_norm(P, l, 0, bid, nblk); break;
    case 1: gemm_phase<G_ZIN>(P, l, P.h, P.wt_in, DM, INDP / 128, bid, nblk, smem); break;
    case 2: phase_vt(P, bid, nblk, smem); phase_prep(P, l, bid, nblk); break;
    case 3: phase_s5_p1(P, l, bid, nblk, smem); __syncthreads(); phase_ml_p1(P, l, bid, nblk, smem); __syncthreads();
            phase_gl_p1(P, bid, nblk, smem); break;
    case 4: phase_s5_p2(P, l, bid, nblk); phase_ml_p2(P, bid, nblk); phase_gl_p2(P, bid, nblk); __syncthreads();
            phase_attn(P, l, bid, nblk, smem); break;
    case 5: phase_s5_p3(P, l, bid, nblk, smem); __syncthreads(); phase_ml_p3(P, l, bid, nblk, smem); __syncthreads();
            phase_gl_p3(P, bid, nblk, smem); break;
    case 6: phase_finish(P, l, bid, nblk); __syncthreads(); gemm_phase<G_GLU>(P, l, P.s5g, P.glut, 256, 2, bid, nblk, smem); break;
    case 7: gemm_phase<G_WOUT>(P, l, P.mix, P.wt_out, DM, 8, bid, nblk, smem); break;
    case 8: phase_norm(P, l, 1, bid, nblk); break;
    case 9: gemm_phase<G_W1>(P, l, P.h, P.w1t, DM, 32, bid, nblk, smem); break;
    case 10: gemm_phase<G_W2>(P, l, P.hidden, P.w2t, DFF, 8, bid, nblk, smem); break;
  }
}

#if MEGA
__global__ void __launch_bounds__(NT, 2) k_mega(Params P) {
  __shared__ __attribute__((aligned(16))) char smem[SMEM_BYTES];
  cg::grid_group grid = cg::this_grid();
  const int bid = blockIdx.x, nblk = gridDim.x;
  phase_init(P, bid, nblk, smem);
  grid.sync();
  for (int l = 0; l < DEPTH; ++l) {
    for (int ph = 0; ph < NPH; ++ph) {
      run_phase(P, l, ph, bid, nblk, smem);
      grid.sync();
    }
  }
  phase_final(P, bid, nblk);
}
#else
__global__ void __launch_bounds__(NT, 2) k_init(Params P) {
  __shared__ __attribute__((aligned(16))) char smem[SMEM_BYTES];
  phase_init(P, blockIdx.x, gridDim.x, smem);
}
template <int PH>
__global__ void __launch_bounds__(NT, 2) k_phase(Params P, int l) {
  __shared__ __attribute__((aligned(16))) char smem[SMEM_BYTES];
  run_phase(P, l, PH, blockIdx.x, gridDim.x, smem);
}
__global__ void __launch_bounds__(NT, 2) k_final(Params P) { phase_final(P, blockIdx.x, gridDim.x); }
#endif

extern "C" void kernel_launch(void* const* d_in, const int* in_sizes, int n_in, void* d_out, int out_size, void* d_ws,
                              size_t ws_size, hipStream_t stream) {
  Params P{};
  const float** pp = (const float**)&P;
  for (int i = 0; i < 32; ++i) pp[i] = (const float*)d_in[i];
  P.out = (float*)d_out;
  char* w = (char*)d_ws;
  size_t off = 0;
  auto take = [&](size_t bytes) { char* p = w + off; off += (bytes + 255) & ~(size_t)255; return p; };
  P.xres = (float*)take((size_t)NTOK * DM * 4);
  char* R = take((size_t)NTOK * DFF * 2);
  P.z = (ushort_t*)R;
  P.mix = (ushort_t*)(R + (size_t)NTOK * IND * 2);
  P.hidden = (ushort_t*)R;
  P.wt_in = (ushort_t*)take((size_t)INDP * DM * 2);
  P.wt_out = (ushort_t*)take((size_t)DM * DM * 2);
  P.w1t = (ushort_t*)take((size_t)DFF * DM * 2);
  P.w2t = (ushort_t*)take((size_t)DM * DFF * 2);
  P.glut = (ushort_t*)take((size_t)256 * 256 * 2);
  P.mlqk = (ushort_t*)take((size_t)NTOK * 512 * 2);
  P.s5g = (ushort_t*)take((size_t)NTOK * 256 * 2);
  P.mlst = (float*)take((size_t)B_ * 4 * 2 * NCH * MLST_SZ * 4);
  P.mod = (float*)take((size_t)DEPTH * 3 * 6144 * 4);
  if (off > ws_size) { fprintf(stderr, "ws too small: need %zu have %zu\n", off, ws_size); return; }
  char* o = (char*)d_out;
  size_t ooff = 0;
  auto otake = [&](size_t bytes) { char* p = o + ooff; ooff += (bytes + 255) & ~(size_t)255; return p; };
  P.h = (ushort_t*)otake((size_t)NTOK * DM * 2);
  {
    char* hb = (char*)P.h;
    size_t ho = 0;
    auto htake = [&](size_t bytes) { char* p = hb + ho; ho += (bytes + 255) & ~(size_t)255; return p; };
    P.alpha = (float*)htake((size_t)NTOK * 256 * 4);
    P.s5st = (float*)htake((size_t)B_ * 2 * 16 * NCH * 128 * 4);
    P.glast = (float*)htake((size_t)B_ * 4 * 2 * NCH * GLST_SZ * 4);
    if (ho > (size_t)NTOK * DM * 2) { fprintf(stderr, "alias overflow\n"); return; }
  }
  P.gates = (float*)otake((size_t)NTOK * 48 * 4);
  P.vt = (ushort_t*)otake((size_t)B_ * 4 * 64 * TOK * 2);
  if (ooff > (size_t)out_size * 4) { fprintf(stderr, "out scratch too small\n"); return; }

#if MEGA
  static int grid_blocks = 0;
  if (!grid_blocks) {
    int dev = 0, cus = 0, per_cu = 0;
    hipGetDevice(&dev);
    hipDeviceGetAttribute(&cus, hipDeviceAttributeMultiprocessorCount, dev);
    hipOccupancyMaxActiveBlocksPerMultiprocessor(&per_cu, k_mega, NT, 0);
    if (per_cu > 2) per_cu = 2;
    grid_blocks = cus * per_cu;
  }
  void* args[] = {&P};
  hipError_t e = hipLaunchCooperativeKernel((void*)k_mega, dim3(grid_blocks), dim3(NT), args, 0, stream);
  if (e != hipSuccess) fprintf(stderr, "cooperative launch failed: %s (grid %d)\n", hipGetErrorString(e), grid_blocks);
#else
  const int G = 512;
  k_init<<<G, NT, 0, stream>>>(P);
  for (int l = 0; l < DEPTH; ++l) {
    k_phase<0><<<G, NT, 0, stream>>>(P, l);
    k_phase<1><<<G, NT, 0, stream>>>(P, l);
    k_phase<2><<<G, NT, 0, stream>>>(P, l);
    k_phase<3><<<G, NT, 0, stream>>>(P, l);
    k_phase<4><<<G, NT, 0, stream>>>(P, l);
    k_phase<5><<<G, NT, 0, stream>>>(P, l);
    k_phase<6><<<G, NT, 0, stream>>>(P, l);
    k_phase<7><<<G, NT, 0, stream>>>(P, l);
    k_phase<8><<<G, NT, 0, stream>>>(P, l);
    k_phase<9><<<G, NT, 0, stream>>>(P, l);
    k_phase<10><<<G, NT, 0, stream>>>(P, l);
  }
  k_final<<<G, NT, 0, stream>>>(P);
#endif
}
```

```cpp
#include <hip/hip_runtime.h>
#include <hip/hip_cooperative_groups.h>
#include <stdint.h>
#include <stdio.h>
namespace cg = cooperative_groups;

#ifndef MEGA
#define MEGA 1
#endif
#define PROBE 0

#define NT 256
typedef unsigned short ushort_t;
using bf16x8 = __attribute__((ext_vector_type(8))) short;
using f32x4 = __attribute__((ext_vector_type(4))) float;
using f32x16 = __attribute__((ext_vector_type(16))) float;
typedef float f2 __attribute__((ext_vector_type(2)));

constexpr int B_ = 2, SEQ = 16384, CTX = 256, TOK = SEQ + CTX, NTOK = B_ * TOK, DM = 1024, DEPTH = 4;
constexpr int IND = 2864, INDP = 2944, DFF = 4096, NCH = 130;
constexpr int MLST_SZ = 4224;
constexpr int GLST_SZ = 2112;
constexpr int SMEM_BYTES = 66 * 1024 + 16;

constexpr int ZC_S5U = 0, ZC_MLQ = 256, ZC_MLK = 512, ZC_MLV = 768, ZC_MLO = 1024, ZC_MLG = 1280;
constexpr int ZC_DAQ = 1296, ZC_DAK = 1552, ZC_DAV = 1808;
constexpr int ZC_GLQ = 2064, ZC_GLK = 2192, ZC_GLV = 2320, ZC_GLR = 2576, ZC_GLA = 2832;

struct Params {
  const float *x, *c, *ctx, *c_ctx, *ada_w, *ada_b, *norm1_g, *norm2_g, *w_in, *s5_lam_re, *s5_lam_im, *s5_log_step,
      *s5_b_re, *s5_b_im, *s5_c_re, *s5_c_im, *s5_d, *s5_glu_w, *s5_glu_b, *ml_conv_w, *ml_conv_b, *ml_gate_b,
      *ml_norm_g, *da_lam, *da_norm_g, *gla_alpha_w, *gla_alpha_b, *gla_norm_g, *w_out, *mlp_w1, *mlp_w2, *final_norm_g;
  float* out;
  float* xres;
  ushort_t* z;
  ushort_t* mix;
  ushort_t* hidden;
  ushort_t *wt_in, *wt_out, *w1t, *w2t, *glut;
  ushort_t* mlqk;
  ushort_t* s5g;
  float* mlst;
  float* mod;
  ushort_t* h;
  float* alpha;
  float* gates;
  float* s5st;
  float* glast;
  ushort_t* vt;
  unsigned* qctr;
};

__device__ __forceinline__ int ltid() { int t = threadIdx.x; asm volatile("" : "+v"(t)); return t; }
__device__ __forceinline__ int launder_s(int x) { asm volatile("" : "+s"(x)); return x; }
__device__ __forceinline__ float bf2f(ushort_t u) { return __uint_as_float(((unsigned)u) << 16); }
__device__ __forceinline__ ushort_t f2bf(float f) {
  unsigned u = __float_as_uint(f);
  u += 0x7fffu + ((u >> 16) & 1u);
  return (ushort_t)(u >> 16);
}
__device__ __forceinline__ unsigned pack2(float a, float b) {
  typedef __bf16 bf2_t __attribute__((ext_vector_type(2)));
  typedef float f2_t __attribute__((ext_vector_type(2)));
  f2_t v = {a, b};
  return __builtin_bit_cast(unsigned, __builtin_convertvector(v, bf2_t));
}
__device__ __forceinline__ float wave_sum(float v) {
#pragma unroll
  for (int o = 32; o; o >>= 1) v += __shfl_xor(v, o);
  return v;
}
__device__ __forceinline__ float sigmoidf_(float x) { return 1.f / (1.f + __expf(-x)); }
__device__ __forceinline__ float logsigmoidf_(float x) { return fminf(x, 0.f) - log1pf(__expf(-fabsf(x))); }
__device__ __forceinline__ void unpack8(uint4 v, float* f) {
  f[0] = __uint_as_float(v.x << 16); f[1] = __uint_as_float(v.x & 0xffff0000u);
  f[2] = __uint_as_float(v.y << 16); f[3] = __uint_as_float(v.y & 0xffff0000u);
  f[4] = __uint_as_float(v.z << 16); f[5] = __uint_as_float(v.z & 0xffff0000u);
  f[6] = __uint_as_float(v.w << 16); f[7] = __uint_as_float(v.w & 0xffff0000u);
}
__device__ __forceinline__ int dir_chunk(int d, int c) { return d == 0 ? c : (c < 2 ? 1 - c : 131 - c); }

__device__ void phase_init(const Params& P, int bid, int nblk, char* smem) {
  const int tid = ltid();
  if (bid == 0 && tid < 2 * DEPTH) P.qctr[tid] = 0u;
  size_t total4 = (size_t)NTOK * 256;
  for (size_t i = (size_t)bid * NT + tid; i < total4; i += (size_t)nblk * NT) {
    int r = (int)(i >> 8), c4 = (int)(i & 255);
    int b = r / TOK, t = r % TOK;
    const float4* src = (t < CTX) ? (const float4*)(P.ctx + ((size_t)(b * CTX + t)) * DM)
                                  : (const float4*)(P.x + ((size_t)(b * SEQ + t - CTX)) * DM);
    ((float4*)P.xres)[i] = src[c4];
  }
  float* sv = (float*)smem;
  float* red = sv + 3072;
  for (int i = tid; i < 3072; i += NT) {
    int row = i >> 10, k = i & 1023;
    float v = (row < 2) ? P.c[row * DM + k] : P.c_ctx[k];
    sv[i] = v / (1.f + expf(-v));
  }
  __syncthreads();
  for (int item = bid; item < 4 * 96; item += nblk) {
    int l = item / 96, cgp = item % 96;
    int jj = tid & 63, kq = tid >> 6;
    int col = cgp * 64 + jj;
    const float* w = P.ada_w + (size_t)l * DM * 6144 + col;
    float a0 = 0, a1 = 0, a2 = 0;
    for (int k = kq * 256; k < kq * 256 + 256; ++k) {
      float wv = w[(size_t)k * 6144];
      a0 += sv[k] * wv; a1 += sv[1024 + k] * wv; a2 += sv[2048 + k] * wv;
    }
    red[(kq * 3 + 0) * 64 + jj] = a0; red[(kq * 3 + 1) * 64 + jj] = a1; red[(kq * 3 + 2) * 64 + jj] = a2;
    __syncthreads();
    if (tid < 192) {
      int row = tid >> 6;
      float s = red[(0 * 3 + row) * 64 + jj] + red[(1 * 3 + row) * 64 + jj] + red[(2 * 3 + row) * 64 + jj] +
                red[(3 * 3 + row) * 64 + jj] + P.ada_b[l * 6144 + col];
      P.mod[(l * 3 + row) * 6144 + col] = s;
    }
    __syncthreads();
  }
}

__device__ void conv_tile(const float* __restrict__ W, int Nsrc, int K, ushort_t* Wt, int kt, int nt, int Nvalid, float* tile) {
  const int tid = ltid();
#pragma unroll
  for (int p = 0; p < 4; ++p) {
    int kk = p * 16 + (tid >> 4), nn = (tid & 15) * 4;
    int n = nt * 64 + nn;
    float4 v = make_float4(0, 0, 0, 0);
    if (n < Nvalid) v = *(const float4*)(W + (size_t)(kt * 64 + kk) * Nsrc + n);
    tile[kk * 65 + nn + 0] = v.x; tile[kk * 65 + nn + 1] = v.y; tile[kk * 65 + nn + 2] = v.z; tile[kk * 65 + nn + 3] = v.w;
  }
  __syncthreads();
#pragma unroll
  for (int p = 0; p < 4; ++p) {
    int nn = p * 16 + (tid >> 4), kk = (tid & 15) * 4;
    uint2 o;
    o.x = pack2(tile[(kk + 0) * 65 + nn], tile[(kk + 1) * 65 + nn]);
    o.y = pack2(tile[(kk + 2) * 65 + nn], tile[(kk + 3) * 65 + nn]);
    *(uint2*)(Wt + (size_t)(nt * 64 + nn) * K + kt * 64 + kk) = o;
  }
  __syncthreads();
}
__device__ void phase_convw(const Params& P, int l, int bid, int nblk, char* smem) {
  float* tile = (float*)smem;
  const int n0 = 16 * 46, n1 = n0 + 256, n2 = n1 + 1024, n3 = n2 + 1024, n4 = n3 + 16;
  for (int it = bid; it < n4; it += nblk) {
    if (it < n0) conv_tile(P.w_in + (size_t)l * DM * IND, IND, DM, P.wt_in, it / 46, it % 46, IND, tile);
    else if (it < n1) { int i = it - n0; conv_tile(P.w_out + (size_t)l * DM * DM, DM, DM, P.wt_out, i / 16, i % 16, DM, tile); }
    else if (it < n2) { int i = it - n1; conv_tile(P.mlp_w1 + (size_t)l * DM * DFF, DFF, DM, P.w1t, i / 64, i % 64, DFF, tile); }
    else if (it < n3) { int i = it - n2; conv_tile(P.mlp_w2 + (size_t)l * DFF * DM, DM, DFF, P.w2t, i / 16, i % 16, DM, tile); }
    else { int i = it - n3; conv_tile(P.s5_glu_w + (size_t)l * 256 * 256, 256, 256, P.glut, i / 4, i % 4, 256, tile); }
  }
}

__device__ void phase_norm(const Params& P, int l, int which, int bid, int nblk) {
  const int wid = ltid() >> 6, lane = ltid() & 63;
  const float* g = (which == 0 ? P.norm1_g : P.norm2_g) + l * DM;
  const int shoff = which == 0 ? 0 : 3072, scoff = shoff + 1024;
  for (int r = bid * 4 + wid; r < NTOK; r += nblk * 4) {
    int b = r / TOK, t = r % TOK;
    int mrow = (t < CTX) ? 2 : b;
    const float* md = P.mod + (l * 3 + mrow) * 6144;
    const float4* xr = (const float4*)(P.xres + (size_t)r * DM);
    float4 v[4];
    float ss = 0;
#pragma unroll
    for (int i = 0; i < 4; ++i) {
      v[i] = xr[lane + 64 * i];
      ss += v[i].x * v[i].x + v[i].y * v[i].y + v[i].z * v[i].z + v[i].w * v[i].w;
    }
    ss = wave_sum(ss);
    float rstd = rsqrtf(ss * (1.f / DM) + 1e-6f);
#pragma unroll
    for (int i = 0; i < 4; ++i) {
      int col = (lane + 64 * i) * 4;
      float4 gg = *(const float4*)(g + col);
      float4 sc = *(const float4*)(md + scoff + col);
      float4 sh = *(const float4*)(md + shoff + col);
      float y0 = v[i].x * rstd * gg.x * (1.f + sc.x) + sh.x;
      float y1 = v[i].y * rstd * gg.y * (1.f + sc.y) + sh.y;
      float y2 = v[i].z * rstd * gg.z * (1.f + sc.z) + sh.z;
      float y3 = v[i].w * rstd * gg.w * (1.f + sc.w) + sh.w;
      uint2 o; o.x = pack2(y0, y1); o.y = pack2(y2, y3);
      *(uint2*)(P.h + (size_t)r * DM + col) = o;
    }
  }
}

enum { G_ZIN = 0, G_GLU = 1, G_WOUT = 2, G_W1 = 3, G_W2 = 4 };
template <int MODE>
__device__ void gemm_phase(const Params& P, int l, const ushort_t* A, const ushort_t* Bt, int K, int ntn, int bid, int nblk, char* smem) {
  ushort_t* As = (ushort_t*)smem;
  ushort_t* Bs = As + 128 * 72;
  const int tid = ltid(), wid = tid >> 6, lane = tid & 63, fr = lane & 15, fq = lane >> 4, wr = wid >> 1, wc = wid & 1;
  const int ntiles = (NTOK / 128) * ntn;
  const int nk = K / 64;
  for (int tile = bid; tile < ntiles; tile += nblk) {
    const int mt = tile / ntn, nt = tile % ntn;
    const int row0 = mt * 128, col0 = nt * 128;
    f32x4 acc[4][4];
#pragma unroll
    for (int m = 0; m < 4; ++m)
#pragma unroll
      for (int n = 0; n < 4; ++n) acc[m][n] = f32x4{0.f, 0.f, 0.f, 0.f};
    const ushort_t* Ag = A + (size_t)row0 * K;
    const ushort_t* Bg = Bt + (size_t)col0 * K;
    const int lrr = tid >> 3, lck = tid & 7;
    const ushort_t* Ap = Ag + (size_t)lrr * K + lck * 8;
    const ushort_t* Bp = Bg + (size_t)lrr * K + lck * 8;
    const size_t rs32 = (size_t)32 * K;
    uint4 ra0 = *(const uint4*)(Ap), ra1 = *(const uint4*)(Ap + rs32), ra2 = *(const uint4*)(Ap + 2 * rs32), ra3 = *(const uint4*)(Ap + 3 * rs32);
    uint4 rb0 = *(const uint4*)(Bp), rb1 = *(const uint4*)(Bp + rs32), rb2 = *(const uint4*)(Bp + 2 * rs32), rb3 = *(const uint4*)(Bp + 3 * rs32);
    ushort_t* Asw = As + lrr * 72 + lck * 8;
    ushort_t* Bsw = Bs + lrr * 72 + lck * 8;
    for (int kt = 0; kt < nk; ++kt) {
      *(uint4*)(Asw) = ra0; *(uint4*)(Asw + 32 * 72) = ra1; *(uint4*)(Asw + 64 * 72) = ra2; *(uint4*)(Asw + 96 * 72) = ra3;
      *(uint4*)(Bsw) = rb0; *(uint4*)(Bsw + 32 * 72) = rb1; *(uint4*)(Bsw + 64 * 72) = rb2; *(uint4*)(Bsw + 96 * 72) = rb3;
      __syncthreads();
      if (kt + 1 < nk) {
        const int ko = (kt + 1) * 64;
        ra0 = *(const uint4*)(Ap + ko); ra1 = *(const uint4*)(Ap + rs32 + ko); ra2 = *(const uint4*)(Ap + 2 * rs32 + ko); ra3 = *(const uint4*)(Ap + 3 * rs32 + ko);
        rb0 = *(const uint4*)(Bp + ko); rb1 = *(const uint4*)(Bp + rs32 + ko); rb2 = *(const uint4*)(Bp + 2 * rs32 + ko); rb3 = *(const uint4*)(Bp + 3 * rs32 + ko);
      }
#pragma unroll
      for (int ks = 0; ks < 2; ++ks) {
        bf16x8 a[4], b[4];
#pragma unroll
        for (int m = 0; m < 4; ++m) a[m] = *(const bf16x8*)(As + (wr * 64 + m * 16 + fr) * 72 + ks * 32 + fq * 8);
#pragma unroll
        for (int n = 0; n < 4; ++n) b[n] = *(const bf16x8*)(Bs + (wc * 64 + n * 16 + fr) * 72 + ks * 32 + fq * 8);
#pragma unroll
        for (int m = 0; m < 4; ++m)
#pragma unroll
          for (int n = 0; n < 4; ++n) acc[m][n] = __builtin_amdgcn_mfma_f32_16x16x32_bf16(a[m], b[n], acc[m][n], 0, 0, 0);
      }
      __syncthreads();
    }
#pragma unroll
    for (int m = 0; m < 4; ++m) {
#pragma unroll
      for (int j = 0; j < 4; ++j) {
        const int row = row0 + wr * 64 + m * 16 + fq * 4 + j;
        int mrow = 0;
        if (MODE == G_WOUT || MODE == G_W2) { int b = row / TOK, t = row % TOK; mrow = (t < CTX) ? 2 : b; }
#pragma unroll
        for (int n = 0; n < 4; ++n) {
          const int col = col0 + wc * 64 + n * 16 + fr;
          const float v = acc[m][n][j];
          if (MODE == G_ZIN) {
            if (col < IND) {
              P.z[(size_t)row * IND + col] = f2bf(v);
              if (col >= ZC_MLG && col < ZC_MLG + 16) P.gates[(size_t)row * 48 + col - ZC_MLG] = v;
              else if (col >= ZC_GLA) P.gates[(size_t)row * 48 + 16 + col - ZC_GLA] = v;
            }
          } else if (MODE == G_GLU) {
            float g = bf2f(P.s5g[(size_t)row * 256 + col]);
            float val = v + P.s5_glu_b[l * 256 + col];
            P.mix[(size_t)row * DM + col] = f2bf(g * sigmoidf_(val));
          } else if (MODE == G_WOUT) {
            float gate = P.mod[(l * 3 + mrow) * 6144 + 2048 + col];
            P.xres[(size_t)row * DM + col] += gate * v;
          } else if (MODE == G_W1) {
            float rl = fmaxf(v, 0.f);
            P.hidden[(size_t)row * DFF + col] = f2bf(rl * rl);
          } else {
            float gate = P.mod[(l * 3 + mrow) * 6144 + 5120 + col];
            P.xres[(size_t)row * DM + col] += gate * v;
          }
        }
      }
    }
  }
}

__device__ void phase_prep(const Params& P, int l, int bid, int nblk) {
  const size_t gtid = (size_t)bid * NT + ltid(), gstride = (size_t)nblk * NT;
  for (size_t idx = gtid; idx < (size_t)NTOK * 64; idx += gstride) {
    const int r = (int)(idx >> 6), c = (int)(idx & 63) * 8;
    const int t = r % TOK;
    const float* cw = P.ml_conv_w + (size_t)l * 3 * 512 + c;
    const float* cb = P.ml_conv_b + l * 512 + c;
    float x0[8], xm[8], xp[8];
    unpack8(*(const uint4*)(P.z + (size_t)r * IND + ZC_MLQ + c), x0);
    const bool hp = (t != 0 && t != CTX), hn = (t != CTX - 1 && t != TOK - 1);
    if (hp) unpack8(*(const uint4*)(P.z + (size_t)(r - 1) * IND + ZC_MLQ + c), xm);
    if (hn) unpack8(*(const uint4*)(P.z + (size_t)(r + 1) * IND + ZC_MLQ + c), xp);
    float o[8];
    const float sc = (c >= 256) ? 0.125f : 1.f;
#pragma unroll
    for (int e = 0; e < 8; ++e) {
      float y = cw[512 + e] * x0[e] + cb[e];
      if (hp) y += cw[e] * xm[e];
      if (hn) y += cw[1024 + e] * xp[e];
      o[e] = y * sigmoidf_(y) * sc;
    }
    *(uint4*)(P.mlqk + (size_t)r * 512 + c) = make_uint4(pack2(o[0], o[1]), pack2(o[2], o[3]), pack2(o[4], o[5]), pack2(o[6], o[7]));
  }
  for (size_t idx = gtid; idx < (size_t)NTOK * 64; idx += gstride) {
    const int r = (int)(idx >> 6), dk = (int)(idx & 63) * 4;
    const int d = dk >> 7, kk = dk & 127;
    const float* W = P.gla_alpha_w + ((size_t)(l * 2 + d) * 16) * 128 + kk;
    const float4* a4 = (const float4*)(P.gates + (size_t)r * 48 + 16 + d * 16);
    float4 v = *(const float4*)(P.gla_alpha_b + (l * 2 + d) * 128 + kk);
#pragma unroll
    for (int q = 0; q < 4; ++q) {
      const float4 a = a4[q];
      const float av[4] = {a.x, a.y, a.z, a.w};
#pragma unroll
      for (int e = 0; e < 4; ++e) {
        const float4 w = *(const float4*)(W + (q * 4 + e) * 128);
        v.x += av[e] * w.x; v.y += av[e] * w.y; v.z += av[e] * w.z; v.w += av[e] * w.w;
      }
    }
    float4 o;
    o.x = __expf(logsigmoidf_(v.x) * (1.f / 16.f)); o.y = __expf(logsigmoidf_(v.y) * (1.f / 16.f));
    o.z = __expf(logsigmoidf_(v.z) * (1.f / 16.f)); o.w = __expf(logsigmoidf_(v.w) * (1.f / 16.f));
    *(float4*)(P.alpha + (size_t)r * 256 + dk) = o;
  }
  const float qscale = 0.17677669529663687f;
  for (size_t idx = gtid; idx < (size_t)NTOK * 64; idx += gstride) {
    const int r = (int)(idx >> 6), rem = (int)(idx & 63);
    const int which = rem >> 5, hm = (rem >> 2) & 7, quad = rem & 3;
    const int t = r % TOK;
    uint4* p = (uint4*)(P.z + (size_t)r * IND + (which ? ZC_DAK : ZC_DAQ) + hm * 32 + quad * 8);
    float x[8];
    unpack8(*p, x);
    if (t >= CTX) {
      const int tl = t - CTX;
      const float posv = (quad < 2) ? (float)(tl >> 6) : (float)(tl & 63);
      const int f0 = (quad & 1) * 4;
#pragma unroll
      for (int e = 0; e < 4; ++e) {
        const int f = f0 + e;
        const float inv = f == 0 ? 1.f : f == 1 ? 0.31622776601683794f : f == 2 ? 0.1f : f == 3 ? 0.031622776601683794f
                        : f == 4 ? 0.01f : f == 5 ? 0.0031622776601683794f : f == 6 ? 0.001f : 0.00031622776601683794f;
        const float ang = posv * inv;
        const float cs = cosf(ang), sn = sinf(ang);
        const float x1 = x[2 * e], x2 = x[2 * e + 1];
        x[2 * e] = x1 * cs - x2 * sn;
        x[2 * e + 1] = x1 * sn + x2 * cs;
      }
    }
    if (!which) {
#pragma unroll
      for (int e = 0; e < 8; ++e) x[e] *= qscale;
    }
    *p = make_uint4(pack2(x[0], x[1]), pack2(x[2], x[3]), pack2(x[4], x[5]), pack2(x[6], x[7]));
  }
}

struct S5Par { float lbr, lbi; f2 bb[16]; };
__device__ __forceinline__ void s5_params(const Params& P, int l, int d, int g, int p, S5Par& q) {
  int gi = (l * 2 + d) * 16 + g, idx = gi * 64 + p;
  float lre = P.s5_lam_re[idx], lim = P.s5_lam_im[idx];
  float dt = expf(P.s5_log_step[gi]);
  float mag = expf(lre * dt);
  q.lbr = mag * cosf(lim * dt); q.lbi = mag * sinf(lim * dt);
  float den = lre * lre + lim * lim;
  float fr_ = ((q.lbr - 1.f) * lre + q.lbi * lim) / den;
  float fi_ = (q.lbi * lre - (q.lbr - 1.f) * lim) / den;
#pragma unroll
  for (int h = 0; h < 16; ++h) {
    float br = P.s5_b_re[(size_t)idx * 16 + h], bi = P.s5_b_im[(size_t)idx * 16 + h];
    q.bb[h] = f2{fr_ * br - fi_ * bi, fr_ * bi + fi_ * br};
  }
}
__device__ __forceinline__ void s5_stage_u(const Params& P, int b, int g, int j, int d, int hf, int lane, float* us) {
  const int s = hf * 64 + lane;
  const int nl = d == 0 ? s : 127 - s;
  const uint4* src = (const uint4*)(P.z + (size_t)(b * TOK + j * 128 + nl) * IND + ZC_S5U + g * 16);
  float f[16];
  unpack8(src[0], f); unpack8(src[1], f + 8);
  float4* dst = (float4*)(us + lane * 16);
  dst[0] = make_float4(f[0], f[1], f[2], f[3]); dst[1] = make_float4(f[4], f[5], f[6], f[7]);
  dst[2] = make_float4(f[8], f[9], f[10], f[11]); dst[3] = make_float4(f[12], f[13], f[14], f[15]);
}
__device__ __forceinline__ void s5_step(const S5Par& q, const float* up, float& hr, float& hi) {
  const float4* u4 = (const float4*)up;
  f2 bu = {0.f, 0.f};
#pragma unroll
  for (int k = 0; k < 4; ++k) {
    float4 u = u4[k];
    bu += q.bb[4 * k + 0] * f2{u.x, u.x}; bu += q.bb[4 * k + 1] * f2{u.y, u.y};
    bu += q.bb[4 * k + 2] * f2{u.z, u.z}; bu += q.bb[4 * k + 3] * f2{u.w, u.w};
  }
  float nr = q.lbr * hr - q.lbi * hi + bu.x;
  float ni = q.lbr * hi + q.lbi * hr + bu.y;
  hr = nr; hi = ni;
}
__device__ void unit_s5_p1(const Params& P, int l, int unit, char* smem) {
  const int wid = ltid() >> 6, lane = ltid() & 63;
  float* us = (float*)smem + wid * 1024;
  {
    int item = unit * 4 + wid;
    int c = item % NCH, g = (item / NCH) % 16, d = (item / (NCH * 16)) % 2, b = item / (NCH * 32);
    int j = dir_chunk(d, c);
    S5Par q;
    s5_params(P, l, d, g, lane, q);
    float hr = 0.f, hi = 0.f;
    for (int hf = 0; hf < 2; ++hf) {
      __syncthreads();
      s5_stage_u(P, b, g, j, d, hf, lane, us);
      __syncthreads();
      for (int s = 0; s < 64; ++s) s5_step(q, us + s * 16, hr, hi);
    }
    float2* st = (float2*)(P.s5st + (size_t)item * 128);
    st[lane] = make_float2(hr, hi);
  }
}
__device__ void phase_s5_p2(const Params& P, int l, int bid, int nblk) {
  const int wid = ltid() >> 6, lane = ltid() & 63;
  for (int it = ((bid + nblk - 388 % nblk) % nblk) * 4 + wid; it < B_ * 2 * 16; it += nblk * 4) {
    int g = it % 16, d = (it / 16) % 2;
    int gi = (l * 2 + d) * 16 + g, idx = gi * 64 + lane;
    float lre = P.s5_lam_re[idx], lim = P.s5_lam_im[idx];
    float dt = expf(P.s5_log_step[gi]);
    float mag = expf(lre * dt);
    float ar = mag * cosf(lim * dt), ai = mag * sinf(lim * dt);
#pragma unroll
    for (int i = 0; i < 7; ++i) { float nr = ar * ar - ai * ai, ni = 2.f * ar * ai; ar = nr; ai = ni; }
    float cr = 0.f, ci = 0.f;
    float2* st = (float2*)(P.s5st + (size_t)it * NCH * 128);
    for (int c0 = 0; c0 < NCH; c0 += 10) {
      float2 x[10];
#pragma unroll
      for (int i = 0; i < 10; ++i) x[i] = st[(c0 + i) * 64 + lane];
#pragma unroll
      for (int i = 0; i < 10; ++i) {
        st[(c0 + i) * 64 + lane] = make_float2(cr, ci);
        float nr = ar * cr - ai * ci + x[i].x;
        float ni = ar * ci + ai * cr + x[i].y;
        cr = nr; ci = ni;
      }
    }
  }
}
template <int DIR>
__device__ __forceinline__ void s5_p3_dir(const Params& P, int l, int b, int g, int j, int lane, float* us, ushort_t* hs, float* ys) {
  const int fr = lane & 15, fq = lane >> 4;
  const int c = dir_chunk(DIR, j);
  S5Par q;
  s5_params(P, l, DIR, g, lane, q);
  bf16x8 cb[4];
  {
    const float* cre = P.s5_c_re + ((size_t)((l * 2 + DIR) * 16 + g) * 16 + fr) * 64;
    const float* cim = P.s5_c_im + ((size_t)((l * 2 + DIR) * 16 + g) * 16 + fr) * 64;
#pragma unroll
    for (int ks = 0; ks < 4; ++ks) {
#pragma unroll
      for (int e = 0; e < 8; ++e) {
        int k = ks * 32 + fq * 8 + e, p = k >> 1;
        float v = (e & 1) ? -cim[p] : cre[p];
        cb[ks][e] = (short)f2bf(v);
      }
    }
  }
  float2 st = ((const float2*)(P.s5st + (size_t)(((b * 2 + DIR) * 16 + g) * NCH + c) * 128))[lane];
  float hr = st.x, hi = st.y;
  const int col = g * 16 + fr;
  const float dsk = P.s5_d[l * 256 + col];
#pragma unroll 1
  for (int sbi = 0; sbi < 8; ++sbi) {
    const int nsb = DIR == 0 ? sbi : 7 - sbi;
    if ((sbi & 3) == 0) {
      __syncthreads();
      s5_stage_u(P, b, g, j, DIR, sbi >> 2, lane, us);
      __syncthreads();
    }
    for (int tii = 0; tii < 16; ++tii) {
      const int s = (sbi & 3) * 16 + tii;
      const int tin = DIR == 0 ? tii : 15 - tii;
      s5_step(q, us + s * 16, hr, hi);
      *(unsigned*)(hs + tin * 136 + 2 * lane) = pack2(hr, hi);
    }
    __syncthreads();
    f32x4 acc = f32x4{0.f, 0.f, 0.f, 0.f};
#pragma unroll
    for (int ks = 0; ks < 4; ++ks) {
      bf16x8 a = *(const bf16x8*)(hs + fr * 136 + ks * 32 + fq * 8);
      acc = __builtin_amdgcn_mfma_f32_16x16x32_bf16(a, cb[ks], acc, 0, 0, 0);
    }
    if (DIR == 0) {
#pragma unroll
      for (int jx = 0; jx < 4; ++jx) ys[(nsb * 16 + fq * 4 + jx) * 16 + fr] = acc[jx];
    } else {
#pragma unroll
      for (int jx = 0; jx < 4; ++jx) {
        const int tl = nsb * 16 + fq * 4 + jx;
        const size_t r = (size_t)(b * TOK + j * 128 + tl);
        float uval = bf2f(P.z[r * IND + ZC_S5U + col]);
        float y = acc[jx] + ys[tl * 16 + fr] + dsk * uval;
        float t3 = 0.7978845608028654f * (y + 0.044715f * y * y * y);
        float gl = 0.5f * y * (1.f + tanhf(t3));
        P.s5g[r * 256 + col] = f2bf(gl);
      }
    }
    __syncthreads();
  }
}
__device__ void unit_s5_p3(const Params& P, int l, int unit, char* smem) {
  const int wid = ltid() >> 6, lane = ltid() & 63;
  float* us = (float*)smem + wid * 1024;
  ushort_t* hs = (ushort_t*)smem + 4 * 2048 + wid * (16 * 136);
  float* ys = (float*)(smem + 16384 + 17408) + wid * 2048;
  {
    int item = unit * 4 + wid;
    int j = item % NCH, g = (item / NCH) % 16, b = item / (NCH * 16);
    s5_p3_dir<0>(P, l, b, g, j, lane, us, hs, ys);
    s5_p3_dir<1>(P, l, b, g, j, lane, us, hs, ys);
  }
}

__device__ __forceinline__ void ml_stage(const Params& P, int l, int b, int h, int d, int j, int sb, int lane, float* ks, float* qs,
                                         float* vs, float* gs, bool need_q) {
  const int ti = lane >> 2, part = lane & 3;
  const int sl = sb * 16 + ti;
  const int nl = d == 0 ? sl : 127 - sl;
  const size_t r = (size_t)(b * TOK + j * 128 + nl);
  float f[16];
  {
    const uint4* src = (const uint4*)(P.mlqk + r * 512 + 256 + h * 64 + part * 16);
    unpack8(src[0], f); unpack8(src[1], f + 8);
    float4* dst = (float4*)(ks + ti * 64 + part * 16);
    dst[0] = make_float4(f[0], f[1], f[2], f[3]); dst[1] = make_float4(f[4], f[5], f[6], f[7]);
    dst[2] = make_float4(f[8], f[9], f[10], f[11]); dst[3] = make_float4(f[12], f[13], f[14], f[15]);
  }
  if (need_q) {
    const uint4* src = (const uint4*)(P.mlqk + r * 512 + h * 64 + part * 16);
    unpack8(src[0], f); unpack8(src[1], f + 8);
    float4* dst = (float4*)(qs + ti * 64 + part * 16);
    dst[0] = make_float4(f[0], f[1], f[2], f[3]); dst[1] = make_float4(f[4], f[5], f[6], f[7]);
    dst[2] = make_float4(f[8], f[9], f[10], f[11]); dst[3] = make_float4(f[12], f[13], f[14], f[15]);
  }
  {
    const uint4* src = (const uint4*)(P.z + r * IND + ZC_MLV + h * 64 + part * 16);
    unpack8(src[0], f); unpack8(src[1], f + 8);
    float4* dst = (float4*)(vs + ti * 64 + part * 16);
    dst[0] = make_float4(f[0], f[1], f[2], f[3]); dst[1] = make_float4(f[4], f[5], f[6], f[7]);
    dst[2] = make_float4(f[8], f[9], f[10], f[11]); dst[3] = make_float4(f[12], f[13], f[14], f[15]);
  }
  if (part == 0) {
    float ig = P.gates[r * 48 + (2 * d) * 4 + h] + P.ml_gate_b[l * 16 + (2 * d) * 4 + h];
    float fp = P.gates[r * 48 + (2 * d + 1) * 4 + h] + P.ml_gate_b[l * 16 + (2 * d + 1) * 4 + h];
    gs[ti * 2] = ig;
    gs[ti * 2 + 1] = logsigmoidf_(fp);
  }
}
#define ML_WAVE_LDS (3 * 1024 + 32)
__device__ void unit_ml_p1(const Params& P, int l, int unit, char* smem) {
  const int wid = ltid() >> 6, lane = ltid() & 63;
  float* ks = (float*)smem + wid * ML_WAVE_LDS;
  float* qs = ks + 1024; float* vs = qs + 1024; float* gs = vs + 1024;
  {
    int item = unit * 4 + wid;
    int c = item % NCH, d = (item / NCH) % 2, h = (item / (NCH * 2)) % 4, b = item / (NCH * 8);
    int j = dir_chunk(d, c);
    f2 C[32];
#pragma unroll
    for (int k = 0; k < 32; ++k) C[k] = f2{0.f, 0.f};
    float n = 0.f, m = -INFINITY, bsum = 0.f;
    for (int sb = 0; sb < 8; ++sb) {
      __syncthreads();
      ml_stage(P, l, b, h, d, j, sb, lane, ks, qs, vs, gs, false);
      __syncthreads();
      for (int ti = 0; ti < 16; ++ti) {
        float ig = gs[ti * 2], lf = gs[ti * 2 + 1];
        float vv = vs[ti * 64 + lane];
        float mn = fmaxf(lf + m, ig);
        float a = __expf(lf + m - mn), sc = __expf(ig - mn);
        m = mn; bsum += lf;
        const float sv = sc * vv;
        const f2 a2 = {a, a}, s2 = {sv, sv};
        const float4* k4 = (const float4*)(ks + ti * 64);
#pragma unroll
        for (int k = 0; k < 16; ++k) {
          float4 kv = k4[k];
          C[2 * k] = a2 * C[2 * k] + s2 * f2{kv.x, kv.y};
          C[2 * k + 1] = a2 * C[2 * k + 1] + s2 * f2{kv.z, kv.w};
        }
        n = a * n + sc * ks[ti * 64 + lane];
      }
    }
    float* st = P.mlst + (size_t)item * MLST_SZ;
#pragma unroll
    for (int k = 0; k < 32; ++k) { st[(2 * k) * 64 + lane] = C[k].x; st[(2 * k + 1) * 64 + lane] = C[k].y; }
    st[4096 + lane] = n;
    if (lane == 0) { st[4160] = m; st[4161] = bsum; }
  }
}
__device__ void phase_ml_p2(const Params& P, int bid, int nblk) {
  const int wid = ltid() >> 6, lane = ltid() & 63;
  for (int it = bid * 4 + wid; it < 16 * 65; it += nblk * 4) {
    int bhd = it / 65, slab = it % 65;
    int e = slab * 64 + lane;
    float st = 0.f, m = 0.f;
    float* base = P.mlst + (size_t)bhd * NCH * MLST_SZ;
    for (int c0 = 0; c0 < NCH; c0 += 10) {
      float x[10], gt[10], bt[10];
#pragma unroll
      for (int i = 0; i < 10; ++i) {
        const float* pc = base + (size_t)(c0 + i) * MLST_SZ;
        x[i] = pc[e]; gt[i] = pc[4160]; bt[i] = pc[4161];
      }
#pragma unroll
      for (int i = 0; i < 10; ++i) {
        float* pc = base + (size_t)(c0 + i) * MLST_SZ;
        float mn = fmaxf(bt[i] + m, gt[i]);
        float a = __expf(bt[i] + m - mn), s = __expf(gt[i] - mn);
        pc[e] = st;
        st = a * st + s * x[i];
        if (slab == 0 && lane == 0) pc[4162] = m;
        m = mn;
      }
    }
  }
}
__device__ void unit_ml_p3(const Params& P, int l, int unit, char* smem) {
  const int wid = ltid() >> 6, lane = ltid() & 63;
  float* ks = (float*)smem + wid * ML_WAVE_LDS;
  float* qs = ks + 1024; float* vs = qs + 1024; float* gs = vs + 1024;
  {
    int item = unit * 4 + wid;
    int c = item % NCH, d = (item / NCH) % 2, h = (item / (NCH * 2)) % 4, b = item / (NCH * 8);
    int j = dir_chunk(d, c);
    const float* st = P.mlst + (size_t)item * MLST_SZ;
    f2 C[32];
#pragma unroll
    for (int k = 0; k < 32; ++k) C[k] = f2{st[(2 * k) * 64 + lane], st[(2 * k + 1) * 64 + lane]};
    float n = st[4096 + lane], m = st[4162];
    ushort_t* outp = d == 0 ? (P.mix + 256 + h * 64 + lane) : (P.z + ZC_MLQ + h * 64 + lane);
    const size_t ostride = d == 0 ? DM : IND;
    for (int sb = 0; sb < 8; ++sb) {
      __syncthreads();
      ml_stage(P, l, b, h, d, j, sb, lane, ks, qs, vs, gs, true);
      __syncthreads();
      for (int ti = 0; ti < 16; ++ti) {
        float ig = gs[ti * 2], lf = gs[ti * 2 + 1];
        float vv = vs[ti * 64 + lane];
        float mn = fmaxf(lf + m, ig);
        float a = __expf(lf + m - mn), sc = __expf(ig - mn);
        m = mn;
        const float sv = sc * vv;
        const f2 a2 = {a, a}, s2 = {sv, sv};
        const float4* k4 = (const float4*)(ks + ti * 64);
        const float4* q4 = (const float4*)(qs + ti * 64);
        f2 numa = {0.f, 0.f}, numb = {0.f, 0.f};
#pragma unroll
        for (int k = 0; k < 16; ++k) {
          float4 kv = k4[k], qv = q4[k];
          C[2 * k] = a2 * C[2 * k] + s2 * f2{kv.x, kv.y};
          C[2 * k + 1] = a2 * C[2 * k + 1] + s2 * f2{kv.z, kv.w};
          numa += C[2 * k] * f2{qv.x, qv.y};
          numb += C[2 * k + 1] * f2{qv.z, qv.w};
        }
        n = a * n + sc * ks[ti * 64 + lane];
        float den = wave_sum(n * qs[ti * 64 + lane]);
        float hv = ((numa.x + numa.y) + (numb.x + numb.y)) / fmaxf(fabsf(den), __expf(-m));
        int sl = sb * 16 + ti;
        int nl = d == 0 ? sl : 127 - sl;
        size_t r = (size_t)(b * TOK + j * 128 + nl);
        outp[r * ostride] = f2bf(hv);
      }
    }
  }
}

#define GL_WAVE_LDS (512 * 3 + 1024)
__device__ __forceinline__ void gl_stage(const Params& P, int b, int h, int d, int j, int sb, int lane, float* ks, float* qs,
                                         float* as, float* vs, bool need_q) {
  const int ti = lane >> 2, part = lane & 3;
  const int sl = sb * 16 + ti;
  const int nl = d == 0 ? sl : 127 - sl;
  const size_t r = (size_t)(b * TOK + j * 128 + nl);
  float f[16];
  {
    unpack8(*(const uint4*)(P.z + r * IND + ZC_GLK + h * 32 + part * 8), f);
    float4* dst = (float4*)(ks + ti * 32 + part * 8);
    dst[0] = make_float4(f[0], f[1], f[2], f[3]); dst[1] = make_float4(f[4], f[5], f[6], f[7]);
  }
  if (need_q) {
    const float qs_ = 0.17677669529663687f;
    unpack8(*(const uint4*)(P.z + r * IND + ZC_GLQ + h * 32 + part * 8), f);
    float4* dst = (float4*)(qs + ti * 32 + part * 8);
    dst[0] = make_float4(f[0] * qs_, f[1] * qs_, f[2] * qs_, f[3] * qs_);
    dst[1] = make_float4(f[4] * qs_, f[5] * qs_, f[6] * qs_, f[7] * qs_);
  }
  {
    const float4* src = (const float4*)(P.alpha + r * 256 + d * 128 + h * 32 + part * 8);
    float4* dst = (float4*)(as + ti * 32 + part * 8);
    dst[0] = src[0]; dst[1] = src[1];
  }
  {
    const uint4* src = (const uint4*)(P.z + r * IND + ZC_GLV + h * 64 + part * 16);
    unpack8(src[0], f); unpack8(src[1], f + 8);
    float4* dst = (float4*)(vs + ti * 64 + part * 16);
    dst[0] = make_float4(f[0], f[1], f[2], f[3]); dst[1] = make_float4(f[4], f[5], f[6], f[7]);
    dst[2] = make_float4(f[8], f[9], f[10], f[11]); dst[3] = make_float4(f[12], f[13], f[14], f[15]);
  }
}
__device__ void unit_gl_p1(const Params& P, int unit, char* smem) {
  const int wid = ltid() >> 6, lane = ltid() & 63;
  float* ks = (float*)smem + wid * GL_WAVE_LDS;
  float* qs = ks + 512; float* as = qs + 512; float* vs = as + 512;
  {
    int item = unit * 4 + wid;
    int c = item % NCH, d = (item / NCH) % 2, h = (item / (NCH * 2)) % 4, b = item / (NCH * 8);
    int j = dir_chunk(d, c);
    f2 S[16];
#pragma unroll
    for (int k = 0; k < 16; ++k) S[k] = f2{0.f, 0.f};
    float ap = 1.f;
    for (int sb = 0; sb < 8; ++sb) {
      __syncthreads();
      gl_stage(P, b, h, d, j, sb, lane, ks, qs, as, vs, false);
      __syncthreads();
      for (int ti = 0; ti < 16; ++ti) {
        const float vv = vs[ti * 64 + lane];
        const f2 v2 = {vv, vv};
        const float4* k4 = (const float4*)(ks + ti * 32);
        const float4* a4 = (const float4*)(as + ti * 32);
#pragma unroll
        for (int k = 0; k < 8; ++k) {
          float4 kv = k4[k], av = a4[k];
          S[2 * k] = f2{av.x, av.y} * S[2 * k] + f2{kv.x, kv.y} * v2;
          S[2 * k + 1] = f2{av.z, av.w} * S[2 * k + 1] + f2{kv.z, kv.w} * v2;
        }
        ap *= as[ti * 32 + (lane & 31)];
      }
    }
    float* st = P.glast + (size_t)item * GLST_SZ;
#pragma unroll
    for (int k = 0; k < 16; ++k) { st[(2 * k) * 64 + lane] = S[k].x; st[(2 * k + 1) * 64 + lane] = S[k].y; }
    if (lane < 32) st[2048 + lane] = ap;
  }
}
__device__ void phase_gl_p2(const Params& P, int bid, int nblk) {
  const int wid = ltid() >> 6, lane = ltid() & 63;
  for (int it = ((bid + nblk - 260 % nblk) % nblk) * 4 + wid; it < 16 * 32; it += nblk * 4) {
    int bhd = it / 32, slab = it % 32;
    int e = slab * 64 + lane;
    float st = 0.f;
    float* base = P.glast + (size_t)bhd * NCH * GLST_SZ;
    for (int c0 = 0; c0 < NCH; c0 += 10) {
      float x[10], A[10];
#pragma unroll
      for (int i = 0; i < 10; ++i) {
        const float* pc = base + (size_t)(c0 + i) * GLST_SZ;
        x[i] = pc[e]; A[i] = pc[2048 + slab];
      }
#pragma unroll
      for (int i = 0; i < 10; ++i) {
        float* pc = base + (size_t)(c0 + i) * GLST_SZ;
        pc[e] = st;
        st = A[i] * st + x[i];
      }
    }
  }
}
__device__ void unit_gl_p3(const Params& P, int unit, char* smem) {
  const int wid = ltid() >> 6, lane = ltid() & 63;
  float* ks = (float*)smem + wid * GL_WAVE_LDS;
  float* qs = ks + 512; float* as = qs + 512; float* vs = as + 512;
  {
    int item = unit * 4 + wid;
    int c = item % NCH, d = (item / NCH) % 2, h = (item / (NCH * 2)) % 4, b = item / (NCH * 8);
    int j = dir_chunk(d, c);
    const float* st = P.glast + (size_t)item * GLST_SZ;
    f2 S[16];
#pragma unroll
    for (int k = 0; k < 16; ++k) S[k] = f2{st[(2 * k) * 64 + lane], st[(2 * k + 1) * 64 + lane]};
    ushort_t* outp = d == 0 ? (P.mix + 768 + h * 64 + lane) : (P.z + ZC_MLK + h * 64 + lane);
    const size_t ostride = d == 0 ? DM : IND;
    for (int sb = 0; sb < 8; ++sb) {
      __syncthreads();
      gl_stage(P, b, h, d, j, sb, lane, ks, qs, as, vs, true);
      __syncthreads();
      for (int ti = 0; ti < 16; ++ti) {
        const float vv = vs[ti * 64 + lane];
        const f2 v2 = {vv, vv};
        const float4* k4 = (const float4*)(ks + ti * 32);
        const float4* a4 = (const float4*)(as + ti * 32);
        const float4* q4 = (const float4*)(qs + ti * 32);
        f2 oa = {0.f, 0.f}, ob = {0.f, 0.f};
#pragma unroll
        for (int k = 0; k < 8; ++k) {
          float4 kv = k4[k], av = a4[k], qv = q4[k];
          S[2 * k] = f2{av.x, av.y} * S[2 * k] + f2{kv.x, kv.y} * v2;
          S[2 * k + 1] = f2{av.z, av.w} * S[2 * k + 1] + f2{kv.z, kv.w} * v2;
          oa += f2{qv.x, qv.y} * S[2 * k];
          ob += f2{qv.z, qv.w} * S[2 * k + 1];
        }
        int sl = sb * 16 + ti;
        int nl = d == 0 ? sl : 127 - sl;
        size_t r = (size_t)(b * TOK + j * 128 + nl);
        outp[r * ostride] = f2bf((oa.x + oa.y) + (ob.x + ob.y));
      }
    }
  }
}
__device__ void phase_finish(const Params& P, int l, int bid, int nblk) {
  const int wid = ltid() >> 6, lane = ltid() & 63;
  for (int it = bid * 4 + wid; it < NTOK * 2; it += nblk * 4) {
    const int r = it >> 1, which = it & 1;
    const int ch = lane * 4;
    ushort_t* mp = P.mix + (size_t)r * DM + (which ? 768 : 256) + ch;
    const ushort_t* zp = P.z + (size_t)r * IND + (which ? ZC_MLK : ZC_MLQ) + ch;
    uint2 a = *(const uint2*)mp, bb = *(const uint2*)zp;
    float v[4];
    v[0] = __uint_as_float(a.x << 16) + __uint_as_float(bb.x << 16);
    v[1] = __uint_as_float(a.x & 0xffff0000u) + __uint_as_float(bb.x & 0xffff0000u);
    v[2] = __uint_as_float(a.y << 16) + __uint_as_float(bb.y << 16);
    v[3] = __uint_as_float(a.y & 0xffff0000u) + __uint_as_float(bb.y & 0xffff0000u);
    float ss = v[0] * v[0] + v[1] * v[1] + v[2] * v[2] + v[3] * v[3];
    ss += __shfl_xor(ss, 1); ss += __shfl_xor(ss, 2); ss += __shfl_xor(ss, 4); ss += __shfl_xor(ss, 8);
    float rstd = rsqrtf(ss * (1.f / 64.f) + 1e-6f);
    uint2 gz = *(const uint2*)(P.z + (size_t)r * IND + (which ? ZC_GLR : ZC_MLO) + ch);
    float gt[4] = {__uint_as_float(gz.x << 16), __uint_as_float(gz.x & 0xffff0000u), __uint_as_float(gz.y << 16),
                   __uint_as_float(gz.y & 0xffff0000u)};
    float o[4];
#pragma unroll
    for (int i = 0; i < 4; ++i) {
      if (which == 0) {
        float gain = P.ml_norm_g[l * 256 + ch + i];
        o[i] = sigmoidf_(gt[i]) * (v[i] * rstd * gain);
      } else {
        float gain = P.gla_norm_g[l * 64 + ((ch + i) & 63)];
        o[i] = (v[i] * rstd * gain) * (gt[i] * sigmoidf_(gt[i]));
      }
    }
    uint2 ov; ov.x = pack2(o[0], o[1]); ov.y = pack2(o[2], o[3]);
    *(uint2*)mp = ov;
  }
}

__device__ void phase_vt(const Params& P, int bid, int nblk, char* smem) {
  ushort_t* tile = (ushort_t*)smem;
  const int tid = ltid();
  const int nitems = B_ * 4 * (TOK / 64);
  for (int it = bid; it < nitems; it += nblk) {
    const int tb = it % 260, head = (it / 260) % 4, b = it / 1040;
    __syncthreads();
#pragma unroll
    for (int i = 0; i < 2; ++i) {
      int id = tid + 256 * i, tok = id >> 3, vc = id & 7;
      uint4 v = *(const uint4*)(P.z + (size_t)(b * TOK + tb * 64 + tok) * IND + ZC_DAV + head * 64 + vc * 8);
      unsigned* d = (unsigned*)(tile + tok * 66 + vc * 8);
      d[0] = v.x; d[1] = v.y; d[2] = v.z; d[3] = v.w;
    }
    __syncthreads();
#pragma unroll
    for (int i = 0; i < 2; ++i) {
      int id = tid + 256 * i, v = id >> 3, tc = id & 7;
      unsigned w[4];
#pragma unroll
      for (int e = 0; e < 4; ++e)
        w[e] = (unsigned)tile[(tc * 8 + 2 * e) * 66 + v] | ((unsigned)tile[(tc * 8 + 2 * e + 1) * 66 + v] << 16);
      *(uint4*)(P.vt + (size_t)((b * 4 + head) * 64 + v) * TOK + tb * 64 + tc * 8) = make_uint4(w[0], w[1], w[2], w[3]);
    }
  }
}

__device__ void phase_attn(const Params& P, int l, int bid, int nblk, char* smem) {
  ushort_t* Ks = (ushort_t*)smem;
  ushort_t* Vt = Ks + 64 * 72;
  const int tid = ltid(), wid = tid >> 6, lane = tid & 63, r = lane & 31, h = lane >> 5;
  const float lam_init = 0.8f - 0.6f * expf(-0.3f * (float)l);
  float lam;
  {
    const float* lp = P.da_lam + l * 128;
    float s01 = 0.f, s23 = 0.f;
    for (int i = 0; i < 32; ++i) { s01 += lp[i] * lp[32 + i]; s23 += lp[64 + i] * lp[96 + i]; }
    lam = expf(s01) - expf(s23) + lam_init;
  }
  const float LOG2E = 1.4426950408889634f;
  const int nitems = 1024 + 16;
  const int srow = tid >> 3, sck = tid & 7;
  for (int item = bid; item < nitems; item += nblk) {
    int b, head, q0, nkeys;
    if (item < 1024) { int qb = item % 128; head = (item / 128) % 4; b = item / 512; q0 = CTX + qb * 128; nkeys = TOK; }
    else { int i2 = item - 1024; int qb = i2 % 2; head = (i2 / 2) % 4; b = i2 / 8; q0 = qb * 128; nkeys = CTX; }
    const size_t qrow = (size_t)(b * TOK + q0 + wid * 32 + r);
    bf16x8 Qf[2][2];
#pragma unroll
    for (int mp = 0; mp < 2; ++mp)
#pragma unroll
      for (int s = 0; s < 2; ++s) Qf[mp][s] = *(const bf16x8*)(P.z + qrow * IND + ZC_DAQ + head * 64 + mp * 32 + 16 * s + 8 * h);
    f32x16 O[2][2];
#pragma unroll
    for (int mp = 0; mp < 2; ++mp)
#pragma unroll
      for (int mt = 0; mt < 2; ++mt)
#pragma unroll
        for (int i = 0; i < 16; ++i) O[mp][mt][i] = 0.f;
    float m[2] = {-INFINITY, -INFINITY}, lsum[2] = {0.f, 0.f};
    const ushort_t* kbase = P.z + (size_t)(b * TOK) * IND + ZC_DAK + head * 64 + (size_t)srow * IND + sck * 8;
    const ushort_t* vbase = P.vt + (size_t)((b * 4 + head) * 64 + srow) * TOK + sck * 8;
    uint4 rk0 = *(const uint4*)(kbase), rk1 = *(const uint4*)(kbase + (size_t)32 * IND);
    uint4 rv0 = *(const uint4*)(vbase), rv1 = *(const uint4*)(vbase + (size_t)32 * TOK);
    const int ntile = nkeys / 64;
    for (int kt = 0; kt < ntile; ++kt) {
      __syncthreads();
      *(uint4*)(Ks + srow * 72 + sck * 8) = rk0; *(uint4*)(Ks + (srow + 32) * 72 + sck * 8) = rk1;
      *(uint4*)(Vt + srow * 72 + sck * 8) = rv0; *(uint4*)(Vt + (srow + 32) * 72 + sck * 8) = rv1;
      __syncthreads();
      if (kt + 1 < ntile) {
        const ushort_t* kp = kbase + (size_t)((kt + 1) * 64) * IND;
        const ushort_t* vp = vbase + (kt + 1) * 64;
        rk0 = *(const uint4*)(kp); rk1 = *(const uint4*)(kp + (size_t)32 * IND);
        rv0 = *(const uint4*)(vp); rv1 = *(const uint4*)(vp + (size_t)32 * TOK);
      }
#pragma unroll
      for (int kb = 0; kb < 2; ++kb) {
        bf16x8 Pf[2][2];
#pragma unroll
        for (int mp = 0; mp < 2; ++mp) {
          f32x16 S;
#pragma unroll
          for (int i = 0; i < 16; ++i) S[i] = 0.f;
#pragma unroll
          for (int s = 0; s < 2; ++s) {
            bf16x8 a = *(const bf16x8*)(Ks + (kb * 32 + r) * 72 + mp * 32 + 16 * s + 8 * h);
            S = __builtin_amdgcn_mfma_f32_32x32x16_bf16(a, Qf[mp][s], S, 0, 0, 0);
          }
          float mx = S[0];
#pragma unroll
          for (int i = 1; i < 16; ++i) mx = fmaxf(mx, S[i]);
          mx = fmaxf(mx, __shfl_xor(mx, 32)) * LOG2E;
          if (__any(mx > m[mp])) {
            float mn = fmaxf(m[mp], mx);
            float al = __builtin_amdgcn_exp2f(m[mp] - mn);
            m[mp] = mn;
            lsum[mp] *= al;
#pragma unroll
            for (int i = 0; i < 16; ++i) { O[mp][0][i] *= al; O[mp][1][i] *= al; }
          }
          float p[16];
          float ps = 0.f;
#pragma unroll
          for (int i = 0; i < 16; ++i) { p[i] = __builtin_amdgcn_exp2f(fmaf(S[i], LOG2E, -m[mp])); ps += p[i]; }
          lsum[mp] += ps;
#pragma unroll
          for (int s = 0; s < 2; ++s) {
            uint4 w;
            w.x = pack2(p[8 * s + 0], p[8 * s + 1]); w.y = pack2(p[8 * s + 2], p[8 * s + 3]);
            w.z = pack2(p[8 * s + 4], p[8 * s + 5]); w.w = pack2(p[8 * s + 6], p[8 * s + 7]);
            Pf[mp][s] = __builtin_bit_cast(bf16x8, w);
          }
        }
#pragma unroll
        for (int mt = 0; mt < 2; ++mt) {
#pragma unroll
          for (int s = 0; s < 2; ++s) {
            const ushort_t* vp = Vt + (mt * 32 + r) * 72 + kb * 32 + 16 * s + 4 * h;
            uint2 lo = *(const uint2*)(vp), hi = *(const uint2*)(vp + 8);
            bf16x8 a = __builtin_bit_cast(bf16x8, make_uint4(lo.x, lo.y, hi.x, hi.y));
            O[0][mt] = __builtin_amdgcn_mfma_f32_32x32x16_bf16(a, Pf[0][s], O[0][mt], 0, 0, 0);
            O[1][mt] = __builtin_amdgcn_mfma_f32_32x32x16_bf16(a, Pf[1][s], O[1][mt], 0, 0, 0);
          }
        }
      }
    }
    const float l0 = lsum[0] + __shfl_xor(lsum[0], 32), l1 = lsum[1] + __shfl_xor(lsum[1], 32);
    const float i0 = 1.f / l0, i1 = lam / l1;
    float ss = 0.f;
#pragma unroll
    for (int mt = 0; mt < 2; ++mt)
#pragma unroll
      for (int i = 0; i < 16; ++i) {
        float v = O[0][mt][i] * i0 - O[1][mt][i] * i1;
        O[0][mt][i] = v;
        ss += v * v;
      }
    ss += __shfl_xor(ss, 32);
    const float rstd = rsqrtf(ss * (1.f / 64.f) + 1e-6f) * (1.f - lam_init);
    ushort_t* op = P.mix + qrow * DM + 512 + head * 64;
#pragma unroll
    for (int mt = 0; mt < 2; ++mt)
#pragma unroll
      for (int g = 0; g < 4; ++g) {
        const int v0 = mt * 32 + 8 * g + 4 * h;
        const float4 gn = *(const float4*)(P.da_norm_g + l * 64 + v0);
        uint2 o;
        o.x = pack2(O[0][mt][4 * g + 0] * rstd * gn.x, O[0][mt][4 * g + 1] * rstd * gn.y);
        o.y = pack2(O[0][mt][4 * g + 2] * rstd * gn.z, O[0][mt][4 * g + 3] * rstd * gn.w);
        *(uint2*)(op + v0) = o;
      }
  }
}

__device__ void phase_final(const Params& P, int bid, int nblk) {
  const int wid = ltid() >> 6, lane = ltid() & 63;
  for (int q = bid * 4 + wid; q < B_ * SEQ; q += nblk * 4) {
    int b = q / SEQ, tl = q % SEQ;
    const float4* xr = (const float4*)(P.xres + (size_t)(b * TOK + CTX + tl) * DM);
    float4 v[4];
    float ss = 0;
#pragma unroll
    for (int i = 0; i < 4; ++i) {
      v[i] = xr[lane + 64 * i];
      ss += v[i].x * v[i].x + v[i].y * v[i].y + v[i].z * v[i].z + v[i].w * v[i].w;
    }
    ss = wave_sum(ss);
    float rstd = rsqrtf(ss * (1.f / DM) + 1e-6f);
    float4* o = (float4*)(P.out + (size_t)q * DM);
#pragma unroll
    for (int i = 0; i < 4; ++i) {
      float4 gg = ((const float4*)P.final_norm_g)[lane + 64 * i];
      o[lane + 64 * i] = make_float4(v[i].x * rstd * gg.x, v[i].y * rstd * gg.y, v[i].z * rstd * gg.z, v[i].w * rstd * gg.w);
    }
  }
}

constexpr int NPH = 11;
__device__ __forceinline__ int next_unit(unsigned* ctr, char* smem) {
  int* sh = (int*)(smem + SMEM_BYTES - 16);
  __syncthreads();
  if (ltid() == 0) *sh = (int)atomicAdd(ctr, 1u);
  __syncthreads();
  return *sh;
}
__device__ __forceinline__ void run_phase(const Params& P, int l, int ph, int bid, int nblk, char* smem) {
  bid = launder_s(bid); nblk = launder_s(nblk); l = launder_s(l);
  switch (ph) {
    case 0: phase_convw(P, l, bid, nblk, smem); phase_norm(P, l, 0, bid, nblk); break;
    case 1: gemm_phase<G_ZIN>(P, l, P.h, P.wt_in, DM, INDP / 128, bid, nblk, smem); break;
    case 2: phase_vt(P, bid, nblk, smem); phase_prep(P, l, bid, nblk); break;
    case 3:
      for (;;) {
        const int u = next_unit(P.qctr + l * 2, smem);
        if (u >= 520 + 520 + 2080) break;
        if (u < 520) unit_ml_p1(P, l, u, smem);
        else if (u < 1040) unit_gl_p1(P, u - 520, smem);
        else unit_s5_p1(P, l, u - 1040, smem);
      }
      break;
    case 4: phase_s5_p2(P, l, bid, nblk); phase_ml_p2(P, bid, nblk); phase_gl_p2(P, bid, nblk); __syncthreads();
            phase_attn(P, l, bid, nblk, smem); break;
    case 5:
      for (;;) {
        const int u = next_unit(P.qctr + l * 2 + 1, smem);
        if (u >= 520 + 520 + 1040) break;
        if (u < 520) unit_ml_p3(P, l, u, smem);
        else if (u < 1040) unit_gl_p3(P, u - 520, smem);
        else unit_s5_p3(P, l, u - 1040, smem);
      }
      break;
    case 6: phase_finish(P, l, bid, nblk); __syncthreads(); gemm_phase<G_GLU>(P, l, P.s5g, P.glut, 256, 2, bid, nblk, smem); break;
    case 7: gemm_phase<G_WOUT>(P, l, P.mix, P.wt_out, DM, 8, bid, nblk, smem); break;
    case 8: phase_norm(P, l, 1, bid, nblk); break;
    case 9: gemm_phase<G_W1>(P, l, P.h, P.w1t, DM, 32, bid, nblk, smem); break;
    case 10: gemm_phase<G_W2>(P, l, P.hidden, P.w2t, DFF, 8, bid, nblk, smem); break;
  }
}

#if MEGA
__global__ void __launch_bounds__(NT, 2) k_mega(Params P) {
  __shared__ __attribute__((aligned(16))) char smem[SMEM_BYTES];
  cg::grid_group grid = cg::this_grid();
  const int bid = blockIdx.x, nblk = gridDim.x;
  phase_init(P, bid, nblk, smem);
  grid.sync();
  for (int l = 0; l < DEPTH; ++l) {
    for (int ph = 0; ph < NPH; ++ph) {
      run_phase(P, l, ph, bid, nblk, smem);
      grid.sync();
#if PROBE == 1
      if (ph == 4) { phase_attn(P, l, bid, nblk, smem); grid.sync(); }
#elif PROBE == 2
      if (ph == 1 || ph == 9) { run_phase(P, l, ph, bid, nblk, smem); grid.sync(); }
#elif PROBE == 3
      if (ph == 3 || ph == 5) { run_phase(P, l, ph, bid, nblk, smem); grid.sync(); }
#endif
    }
  }
  phase_final(P, bid, nblk);
}
#else
__global__ void __launch_bounds__(NT, 2) k_init(Params P) {
  __shared__ __attribute__((aligned(16))) char smem[SMEM_BYTES];
  phase_init(P, blockIdx.x, gridDim.x, smem);
}
template <int PH>
__global__ void __launch_bounds__(NT, 2) k_phase(Params P, int l) {
  __shared__ __attribute__((aligned(16))) char smem[SMEM_BYTES];
  run_phase(P, l, PH, blockIdx.x, gridDim.x, smem);
}
__global__ void __launch_bounds__(NT, 2) k_final(Params P) { phase_final(P, blockIdx.x, gridDim.x); }
#endif

extern "C" void kernel_launch(void* const* d_in, const int* in_sizes, int n_in, void* d_out, int out_size, void* d_ws,
                              size_t ws_size, hipStream_t stream) {
  Params P{};
  const float** pp = (const float**)&P;
  for (int i = 0; i < 32; ++i) pp[i] = (const float*)d_in[i];
  P.out = (float*)d_out;
  char* w = (char*)d_ws;
  size_t off = 0;
  auto take = [&](size_t bytes) { char* p = w + off; off += (bytes + 255) & ~(size_t)255; return p; };
  P.xres = (float*)take((size_t)NTOK * DM * 4);
  char* R = take((size_t)NTOK * DFF * 2);
  P.z = (ushort_t*)R;
  P.mix = (ushort_t*)(R + (size_t)NTOK * IND * 2);
  P.hidden = (ushort_t*)R;
  P.wt_in = (ushort_t*)take((size_t)INDP * DM * 2);
  P.wt_out = (ushort_t*)take((size_t)DM * DM * 2);
  P.w1t = (ushort_t*)take((size_t)DFF * DM * 2);
  P.w2t = (ushort_t*)take((size_t)DM * DFF * 2);
  P.glut = (ushort_t*)take((size_t)256 * 256 * 2);
  P.mlqk = (ushort_t*)take((size_t)NTOK * 512 * 2);
  P.s5g = (ushort_t*)take((size_t)NTOK * 256 * 2);
  P.mlst = (float*)take((size_t)B_ * 4 * 2 * NCH * MLST_SZ * 4);
  P.mod = (float*)take((size_t)DEPTH * 3 * 6144 * 4);
  P.qctr = (unsigned*)take(256);
  if (off > ws_size) { fprintf(stderr, "ws too small: need %zu have %zu\n", off, ws_size); return; }
  char* o = (char*)d_out;
  size_t ooff = 0;
  auto otake = [&](size_t bytes) { char* p = o + ooff; ooff += (bytes + 255) & ~(size_t)255; return p; };
  P.h = (ushort_t*)otake((size_t)NTOK * DM * 2);
  {
    char* hb = (char*)P.h;
    size_t ho = 0;
    auto htake = [&](size_t bytes) { char* p = hb + ho; ho += (bytes + 255) & ~(size_t)255; return p; };
    P.alpha = (float*)htake((size_t)NTOK * 256 * 4);
    P.s5st = (float*)htake((size_t)B_ * 2 * 16 * NCH * 128 * 4);
    P.glast = (float*)htake((size_t)B_ * 4 * 2 * NCH * GLST_SZ * 4);
    if (ho > (size_t)NTOK * DM * 2) { fprintf(stderr, "alias overflow\n"); return; }
  }
  P.gates = (float*)otake((size_t)NTOK * 48 * 4);
  P.vt = (ushort_t*)otake((size_t)B_ * 4 * 64 * TOK * 2);
  if (ooff > (size_t)out_size * 4) { fprintf(stderr, "out scratch too small\n"); return; }

#if MEGA
  static int grid_blocks = 0;
  if (!grid_blocks) {
    int dev = 0, cus = 0, per_cu = 0;
    hipGetDevice(&dev);
    hipDeviceGetAttribute(&cus, hipDeviceAttributeMultiprocessorCount, dev);
    hipOccupancyMaxActiveBlocksPerMultiprocessor(&per_cu, k_mega, NT, 0);
    if (per_cu > 2) per_cu = 2;
    grid_blocks = cus * per_cu;
  }
  void* args[] = {&P};
  hipError_t e = hipLaunchCooperativeKernel((void*)k_mega, dim3(grid_blocks), dim3(NT), args, 0, stream);
  if (e != hipSuccess) fprintf(stderr, "cooperative launch failed: %s (grid %d)\n", hipGetErrorString(e), grid_blocks);
#else
  const int G = 512;
  k_init<<<G, NT, 0, stream>>>(P);
  for (int l = 0; l < DEPTH; ++l) {
    k_phase<0><<<G, NT, 0, stream>>>(P, l);
    k_phase<1><<<G, NT, 0, stream>>>(P, l);
    k_phase<2><<<G, NT, 0, stream>>>(P, l);
    k_phase<3><<<G, NT, 0, stream>>>(P, l);
    k_phase<4><<<G, NT, 0, stream>>>(P, l);
    k_phase<5><<<G, NT, 0, stream>>>(P, l);
    k_phase<6><<<G, NT, 0, stream>>>(P, l);
    k_phase<7><<<G, NT, 0, stream>>>(P, l);
    k_phase<8><<<G, NT, 0, stream>>>(P, l);
    k_phase<9><<<G, NT, 0, stream>>>(P, l);
    k_phase<10><<<G, NT, 0, stream>>>(P, l);
  }
  k_final<<<G, NT, 0, stream>>>(P);
#endif
}
```

```cpp
#include <hip/hip_runtime.h>
#include <hip/hip_cooperative_groups.h>
#include <stdint.h>
#include <stdio.h>
namespace cg = cooperative_groups;

#ifndef MEGA
#define MEGA 1
#endif
#define PROBE 0

#define NT 256
typedef unsigned short ushort_t;
using bf16x8 = __attribute__((ext_vector_type(8))) short;
using f32x4 = __attribute__((ext_vector_type(4))) float;
using f32x16 = __attribute__((ext_vector_type(16))) float;
typedef float f2 __attribute__((ext_vector_type(2)));

constexpr int B_ = 2, SEQ = 16384, CTX = 256, TOK = SEQ + CTX, NTOK = B_ * TOK, DM = 1024, DEPTH = 4;
constexpr int IND = 2864, INDP = 2944, DFF = 4096, NCH = 130;
constexpr int MLST_SZ = 4224;
constexpr int GLST_SZ = 2112;
constexpr int SMEM_BYTES = 66 * 1024 + 32;

constexpr int ZC_S5U = 0, ZC_MLQ = 256, ZC_MLK = 512, ZC_MLV = 768, ZC_MLO = 1024, ZC_MLG = 1280;
constexpr int ZC_DAQ = 1296, ZC_DAK = 1552, ZC_DAV = 1808;
constexpr int ZC_GLQ = 2064, ZC_GLK = 2192, ZC_GLV = 2320, ZC_GLR = 2576, ZC_GLA = 2832;

struct Params {
  const float *x, *c, *ctx, *c_ctx, *ada_w, *ada_b, *norm1_g, *norm2_g, *w_in, *s5_lam_re, *s5_lam_im, *s5_log_step,
      *s5_b_re, *s5_b_im, *s5_c_re, *s5_c_im, *s5_d, *s5_glu_w, *s5_glu_b, *ml_conv_w, *ml_conv_b, *ml_gate_b,
      *ml_norm_g, *da_lam, *da_norm_g, *gla_alpha_w, *gla_alpha_b, *gla_norm_g, *w_out, *mlp_w1, *mlp_w2, *final_norm_g;
  float* out;
  float* xres;
  ushort_t* z;
  ushort_t* mix;
  ushort_t* hidden;
  ushort_t *wt_in, *wt_out, *w1t, *w2t, *glut;
  ushort_t* mlqk;
  ushort_t* s5g;
  float* mlst;
  float* mod;
  ushort_t* h;
  float* alpha;
  float* gates;
  float* s5st;
  float* glast;
  ushort_t* vt;
  unsigned* qctr;
  unsigned* xbar;
};

__device__ __forceinline__ int ltid() { int t = threadIdx.x; asm volatile("" : "+v"(t)); return t; }
__device__ __forceinline__ int launder_s(int x) { asm volatile("" : "+s"(x)); return x; }
__device__ __forceinline__ float bf2f(ushort_t u) { return __uint_as_float(((unsigned)u) << 16); }
__device__ __forceinline__ ushort_t f2bf(float f) {
  unsigned u = __float_as_uint(f);
  u += 0x7fffu + ((u >> 16) & 1u);
  return (ushort_t)(u >> 16);
}
__device__ __forceinline__ unsigned pack2(float a, float b) {
  typedef __bf16 bf2_t __attribute__((ext_vector_type(2)));
  typedef float f2_t __attribute__((ext_vector_type(2)));
  f2_t v = {a, b};
  return __builtin_bit_cast(unsigned, __builtin_convertvector(v, bf2_t));
}
__device__ __forceinline__ float wave_sum(float v) {
#pragma unroll
  for (int o = 32; o; o >>= 1) v += __shfl_xor(v, o);
  return v;
}
__device__ __forceinline__ float sigmoidf_(float x) { return 1.f / (1.f + __expf(-x)); }
__device__ __forceinline__ float logsigmoidf_(float x) { return fminf(x, 0.f) - log1pf(__expf(-fabsf(x))); }
__device__ __forceinline__ void unpack8(uint4 v, float* f) {
  f[0] = __uint_as_float(v.x << 16); f[1] = __uint_as_float(v.x & 0xffff0000u);
  f[2] = __uint_as_float(v.y << 16); f[3] = __uint_as_float(v.y & 0xffff0000u);
  f[4] = __uint_as_float(v.z << 16); f[5] = __uint_as_float(v.z & 0xffff0000u);
  f[6] = __uint_as_float(v.w << 16); f[7] = __uint_as_float(v.w & 0xffff0000u);
}
__device__ __forceinline__ int dir_chunk(int d, int c) { return d == 0 ? c : (c < 2 ? 1 - c : 131 - c); }

__device__ void phase_init(const Params& P, int bid, int nblk, char* smem) {
  const int tid = ltid();
  if (bid == 0 && tid < 2 * DEPTH) P.qctr[tid] = 0u;
  size_t total4 = (size_t)NTOK * 256;
  for (size_t i = (size_t)bid * NT + tid; i < total4; i += (size_t)nblk * NT) {
    int r = (int)(i >> 8), c4 = (int)(i & 255);
    int b = r / TOK, t = r % TOK;
    const float4* src = (t < CTX) ? (const float4*)(P.ctx + ((size_t)(b * CTX + t)) * DM)
                                  : (const float4*)(P.x + ((size_t)(b * SEQ + t - CTX)) * DM);
    ((float4*)P.xres)[i] = src[c4];
  }
  float* sv = (float*)smem;
  float* red = sv + 3072;
  for (int i = tid; i < 3072; i += NT) {
    int row = i >> 10, k = i & 1023;
    float v = (row < 2) ? P.c[row * DM + k] : P.c_ctx[k];
    sv[i] = v / (1.f + expf(-v));
  }
  __syncthreads();
  for (int item = bid; item < 4 * 96; item += nblk) {
    int l = item / 96, cgp = item % 96;
    int jj = tid & 63, kq = tid >> 6;
    int col = cgp * 64 + jj;
    const float* w = P.ada_w + (size_t)l * DM * 6144 + col;
    float a0 = 0, a1 = 0, a2 = 0;
    for (int k = kq * 256; k < kq * 256 + 256; ++k) {
      float wv = w[(size_t)k * 6144];
      a0 += sv[k] * wv; a1 += sv[1024 + k] * wv; a2 += sv[2048 + k] * wv;
    }
    red[(kq * 3 + 0) * 64 + jj] = a0; red[(kq * 3 + 1) * 64 + jj] = a1; red[(kq * 3 + 2) * 64 + jj] = a2;
    __syncthreads();
    if (tid < 192) {
      int row = tid >> 6;
      float s = red[(0 * 3 + row) * 64 + jj] + red[(1 * 3 + row) * 64 + jj] + red[(2 * 3 + row) * 64 + jj] +
                red[(3 * 3 + row) * 64 + jj] + P.ada_b[l * 6144 + col];
      P.mod[(l * 3 + row) * 6144 + col] = s;
    }
    __syncthreads();
  }
}

__device__ void conv_tile(const float* __restrict__ W, int Nsrc, int K, ushort_t* Wt, int kt, int nt, int Nvalid, float* tile) {
  const int tid = ltid();
#pragma unroll
  for (int p = 0; p < 4; ++p) {
    int kk = p * 16 + (tid >> 4), nn = (tid & 15) * 4;
    int n = nt * 64 + nn;
    float4 v = make_float4(0, 0, 0, 0);
    if (n < Nvalid) v = *(const float4*)(W + (size_t)(kt * 64 + kk) * Nsrc + n);
    tile[kk * 65 + nn + 0] = v.x; tile[kk * 65 + nn + 1] = v.y; tile[kk * 65 + nn + 2] = v.z; tile[kk * 65 + nn + 3] = v.w;
  }
  __syncthreads();
#pragma unroll
  for (int p = 0; p < 4; ++p) {
    int nn = p * 16 + (tid >> 4), kk = (tid & 15) * 4;
    uint2 o;
    o.x = pack2(tile[(kk + 0) * 65 + nn], tile[(kk + 1) * 65 + nn]);
    o.y = pack2(tile[(kk + 2) * 65 + nn], tile[(kk + 3) * 65 + nn]);
    *(uint2*)(Wt + (size_t)(nt * 64 + nn) * K + kt * 64 + kk) = o;
  }
  __syncthreads();
}
__device__ void phase_convw(const Params& P, int l, int bid, int nblk, char* smem) {
  float* tile = (float*)smem;
  const int n0 = 16 * 46, n1 = n0 + 256, n2 = n1 + 1024, n3 = n2 + 1024, n4 = n3 + 16;
  for (int it = bid; it < n4; it += nblk) {
    if (it < n0) conv_tile(P.w_in + (size_t)l * DM * IND, IND, DM, P.wt_in, it / 46, it % 46, IND, tile);
    else if (it < n1) { int i = it - n0; conv_tile(P.w_out + (size_t)l * DM * DM, DM, DM, P.wt_out, i / 16, i % 16, DM, tile); }
    else if (it < n2) { int i = it - n1; conv_tile(P.mlp_w1 + (size_t)l * DM * DFF, DFF, DM, P.w1t, i / 64, i % 64, DFF, tile); }
    else if (it < n3) { int i = it - n2; conv_tile(P.mlp_w2 + (size_t)l * DFF * DM, DM, DFF, P.w2t, i / 16, i % 16, DM, tile); }
    else { int i = it - n3; conv_tile(P.s5_glu_w + (size_t)l * 256 * 256, 256, 256, P.glut, i / 4, i % 4, 256, tile); }
  }
}

__device__ void phase_norm(const Params& P, int l, int which, int bid, int nblk) {
  const int wid = ltid() >> 6, lane = ltid() & 63;
  const float* g = (which == 0 ? P.norm1_g : P.norm2_g) + l * DM;
  const int shoff = which == 0 ? 0 : 3072, scoff = shoff + 1024;
  for (int r = bid * 4 + wid; r < NTOK; r += nblk * 4) {
    int b = r / TOK, t = r % TOK;
    int mrow = (t < CTX) ? 2 : b;
    const float* md = P.mod + (l * 3 + mrow) * 6144;
    const float4* xr = (const float4*)(P.xres + (size_t)r * DM);
    float4 v[4];
    float ss = 0;
#pragma unroll
    for (int i = 0; i < 4; ++i) {
      v[i] = xr[lane + 64 * i];
      ss += v[i].x * v[i].x + v[i].y * v[i].y + v[i].z * v[i].z + v[i].w * v[i].w;
    }
    ss = wave_sum(ss);
    float rstd = rsqrtf(ss * (1.f / DM) + 1e-6f);
#pragma unroll
    for (int i = 0; i < 4; ++i) {
      int col = (lane + 64 * i) * 4;
      float4 gg = *(const float4*)(g + col);
      float4 sc = *(const float4*)(md + scoff + col);
      float4 sh = *(const float4*)(md + shoff + col);
      float y0 = v[i].x * rstd * gg.x * (1.f + sc.x) + sh.x;
      float y1 = v[i].y * rstd * gg.y * (1.f + sc.y) + sh.y;
      float y2 = v[i].z * rstd * gg.z * (1.f + sc.z) + sh.z;
      float y3 = v[i].w * rstd * gg.w * (1.f + sc.w) + sh.w;
      uint2 o; o.x = pack2(y0, y1); o.y = pack2(y2, y3);
      *(uint2*)(P.h + (size_t)r * DM + col) = o;
    }
  }
}

enum { G_ZIN = 0, G_GLU = 1, G_WOUT = 2, G_W1 = 3, G_W2 = 4 };
template <int MODE>
__device__ void gemm_phase(const Params& P, int l, const ushort_t* A, const ushort_t* Bt, int K, int ntn, int bid, int nblk, char* smem) {
  ushort_t* As = (ushort_t*)smem;
  ushort_t* Bs = As + 128 * 72;
  const int tid = ltid(), wid = tid >> 6, lane = tid & 63, fr = lane & 15, fq = lane >> 4, wr = wid >> 1, wc = wid & 1;
  const int ntiles = (NTOK / 128) * ntn;
  const int nk = K / 64;
  for (int tile = bid; tile < ntiles; tile += nblk) {
    const int mt = tile / ntn, nt = tile % ntn;
    const int row0 = mt * 128, col0 = nt * 128;
    f32x4 acc[4][4];
#pragma unroll
    for (int m = 0; m < 4; ++m)
#pragma unroll
      for (int n = 0; n < 4; ++n) acc[m][n] = f32x4{0.f, 0.f, 0.f, 0.f};
    const ushort_t* Ag = A + (size_t)row0 * K;
    const ushort_t* Bg = Bt + (size_t)col0 * K;
    const int lrr = tid >> 3, lck = tid & 7;
    const ushort_t* Ap = Ag + (size_t)lrr * K + lck * 8;
    const ushort_t* Bp = Bg + (size_t)lrr * K + lck * 8;
    const size_t rs32 = (size_t)32 * K;
    uint4 ra0 = *(const uint4*)(Ap), ra1 = *(const uint4*)(Ap + rs32), ra2 = *(const uint4*)(Ap + 2 * rs32), ra3 = *(const uint4*)(Ap + 3 * rs32);
    uint4 rb0 = *(const uint4*)(Bp), rb1 = *(const uint4*)(Bp + rs32), rb2 = *(const uint4*)(Bp + 2 * rs32), rb3 = *(const uint4*)(Bp + 3 * rs32);
    ushort_t* Asw = As + lrr * 72 + lck * 8;
    ushort_t* Bsw = Bs + lrr * 72 + lck * 8;
    for (int kt = 0; kt < nk; ++kt) {
      *(uint4*)(Asw) = ra0; *(uint4*)(Asw + 32 * 72) = ra1; *(uint4*)(Asw + 64 * 72) = ra2; *(uint4*)(Asw + 96 * 72) = ra3;
      *(uint4*)(Bsw) = rb0; *(uint4*)(Bsw + 32 * 72) = rb1; *(uint4*)(Bsw + 64 * 72) = rb2; *(uint4*)(Bsw + 96 * 72) = rb3;
      __syncthreads();
      if (kt + 1 < nk) {
        const int ko = (kt + 1) * 64;
        ra0 = *(const uint4*)(Ap + ko); ra1 = *(const uint4*)(Ap + rs32 + ko); ra2 = *(const uint4*)(Ap + 2 * rs32 + ko); ra3 = *(const uint4*)(Ap + 3 * rs32 + ko);
        rb0 = *(const uint4*)(Bp + ko); rb1 = *(const uint4*)(Bp + rs32 + ko); rb2 = *(const uint4*)(Bp + 2 * rs32 + ko); rb3 = *(const uint4*)(Bp + 3 * rs32 + ko);
      }
#pragma unroll
      for (int ks = 0; ks < 2; ++ks) {
        bf16x8 a[4], b[4];
#pragma unroll
        for (int m = 0; m < 4; ++m) a[m] = *(const bf16x8*)(As + (wr * 64 + m * 16 + fr) * 72 + ks * 32 + fq * 8);
#pragma unroll
        for (int n = 0; n < 4; ++n) b[n] = *(const bf16x8*)(Bs + (wc * 64 + n * 16 + fr) * 72 + ks * 32 + fq * 8);
#pragma unroll
        for (int m = 0; m < 4; ++m)
#pragma unroll
          for (int n = 0; n < 4; ++n) acc[m][n] = __builtin_amdgcn_mfma_f32_16x16x32_bf16(a[m], b[n], acc[m][n], 0, 0, 0);
      }
      __syncthreads();
    }
#pragma unroll
    for (int m = 0; m < 4; ++m) {
#pragma unroll
      for (int j = 0; j < 4; ++j) {
        const int row = row0 + wr * 64 + m * 16 + fq * 4 + j;
        int mrow = 0;
        if (MODE == G_WOUT || MODE == G_W2) { int b = row / TOK, t = row % TOK; mrow = (t < CTX) ? 2 : b; }
#pragma unroll
        for (int n = 0; n < 4; ++n) {
          const int col = col0 + wc * 64 + n * 16 + fr;
          const float v = acc[m][n][j];
          if (MODE == G_ZIN) {
            if (col < IND) {
              P.z[(size_t)row * IND + col] = f2bf(v);
              if (col >= ZC_MLG && col < ZC_MLG + 16) P.gates[(size_t)row * 48 + col - ZC_MLG] = v;
              else if (col >= ZC_GLA) P.gates[(size_t)row * 48 + 16 + col - ZC_GLA] = v;
            }
          } else if (MODE == G_GLU) {
            float g = bf2f(P.s5g[(size_t)row * 256 + col]);
            float val = v + P.s5_glu_b[l * 256 + col];
            P.mix[(size_t)row * DM + col] = f2bf(g * sigmoidf_(val));
          } else if (MODE == G_WOUT) {
            float gate = P.mod[(l * 3 + mrow) * 6144 + 2048 + col];
            P.xres[(size_t)row * DM + col] += gate * v;
          } else if (MODE == G_W1) {
            float rl = fmaxf(v, 0.f);
            P.hidden[(size_t)row * DFF + col] = f2bf(rl * rl);
          } else {
            float gate = P.mod[(l * 3 + mrow) * 6144 + 5120 + col];
            P.xres[(size_t)row * DM + col] += gate * v;
          }
        }
      }
    }
  }
}

__device__ void phase_prep(const Params& P, int l, int bid, int nblk) {
  const size_t gtid = (size_t)bid * NT + ltid(), gstride = (size_t)nblk * NT;
  for (size_t idx = gtid; idx < (size_t)NTOK * 64; idx += gstride) {
    const int r = (int)(idx >> 6), c = (int)(idx & 63) * 8;
    const int t = r % TOK;
    const float* cw = P.ml_conv_w + (size_t)l * 3 * 512 + c;
    const float* cb = P.ml_conv_b + l * 512 + c;
    float x0[8], xm[8], xp[8];
    unpack8(*(const uint4*)(P.z + (size_t)r * IND + ZC_MLQ + c), x0);
    const bool hp = (t != 0 && t != CTX), hn = (t != CTX - 1 && t != TOK - 1);
    if (hp) unpack8(*(const uint4*)(P.z + (size_t)(r - 1) * IND + ZC_MLQ + c), xm);
    if (hn) unpack8(*(const uint4*)(P.z + (size_t)(r + 1) * IND + ZC_MLQ + c), xp);
    float o[8];
    const float sc = (c >= 256) ? 0.125f : 1.f;
#pragma unroll
    for (int e = 0; e < 8; ++e) {
      float y = cw[512 + e] * x0[e] + cb[e];
      if (hp) y += cw[e] * xm[e];
      if (hn) y += cw[1024 + e] * xp[e];
      o[e] = y * sigmoidf_(y) * sc;
    }
    *(uint4*)(P.mlqk + (size_t)r * 512 + c) = make_uint4(pack2(o[0], o[1]), pack2(o[2], o[3]), pack2(o[4], o[5]), pack2(o[6], o[7]));
  }
  for (size_t idx = gtid; idx < (size_t)NTOK * 64; idx += gstride) {
    const int r = (int)(idx >> 6), dk = (int)(idx & 63) * 4;
    const int d = dk >> 7, kk = dk & 127;
    const float* W = P.gla_alpha_w + ((size_t)(l * 2 + d) * 16) * 128 + kk;
    const float4* a4 = (const float4*)(P.gates + (size_t)r * 48 + 16 + d * 16);
    float4 v = *(const float4*)(P.gla_alpha_b + (l * 2 + d) * 128 + kk);
#pragma unroll
    for (int q = 0; q < 4; ++q) {
      const float4 a = a4[q];
      const float av[4] = {a.x, a.y, a.z, a.w};
#pragma unroll
      for (int e = 0; e < 4; ++e) {
        const float4 w = *(const float4*)(W + (q * 4 + e) * 128);
        v.x += av[e] * w.x; v.y += av[e] * w.y; v.z += av[e] * w.z; v.w += av[e] * w.w;
      }
    }
    float4 o;
    o.x = __expf(logsigmoidf_(v.x) * (1.f / 16.f)); o.y = __expf(logsigmoidf_(v.y) * (1.f / 16.f));
    o.z = __expf(logsigmoidf_(v.z) * (1.f / 16.f)); o.w = __expf(logsigmoidf_(v.w) * (1.f / 16.f));
    *(float4*)(P.alpha + (size_t)r * 256 + dk) = o;
  }
  const float qscale = 0.17677669529663687f;
  for (size_t idx = gtid; idx < (size_t)NTOK * 64; idx += gstride) {
    const int r = (int)(idx >> 6), rem = (int)(idx & 63);
    const int which = rem >> 5, hm = (rem >> 2) & 7, quad = rem & 3;
    const int t = r % TOK;
    uint4* p = (uint4*)(P.z + (size_t)r * IND + (which ? ZC_DAK : ZC_DAQ) + hm * 32 + quad * 8);
    float x[8];
    unpack8(*p, x);
    if (t >= CTX) {
      const int tl = t - CTX;
      const float posv = (quad < 2) ? (float)(tl >> 6) : (float)(tl & 63);
      const int f0 = (quad & 1) * 4;
#pragma unroll
      for (int e = 0; e < 4; ++e) {
        const int f = f0 + e;
        const float inv = f == 0 ? 1.f : f == 1 ? 0.31622776601683794f : f == 2 ? 0.1f : f == 3 ? 0.031622776601683794f
                        : f == 4 ? 0.01f : f == 5 ? 0.0031622776601683794f : f == 6 ? 0.001f : 0.00031622776601683794f;
        const float ang = posv * inv;
        const float cs = cosf(ang), sn = sinf(ang);
        const float x1 = x[2 * e], x2 = x[2 * e + 1];
        x[2 * e] = x1 * cs - x2 * sn;
        x[2 * e + 1] = x1 * sn + x2 * cs;
      }
    }
    if (!which) {
#pragma unroll
      for (int e = 0; e < 8; ++e) x[e] *= qscale;
    }
    *p = make_uint4(pack2(x[0], x[1]), pack2(x[2], x[3]), pack2(x[4], x[5]), pack2(x[6], x[7]));
  }
}

struct S5Par { float lbr, lbi; f2 bb[16]; };
__device__ __forceinline__ void s5_params(const Params& P, int l, int d, int g, int p, S5Par& q) {
  int gi = (l * 2 + d) * 16 + g, idx = gi * 64 + p;
  float lre = P.s5_lam_re[idx], lim = P.s5_lam_im[idx];
  float dt = expf(P.s5_log_step[gi]);
  float mag = expf(lre * dt);
  q.lbr = mag * cosf(lim * dt); q.lbi = mag * sinf(lim * dt);
  float den = lre * lre + lim * lim;
  float fr_ = ((q.lbr - 1.f) * lre + q.lbi * lim) / den;
  float fi_ = (q.lbi * lre - (q.lbr - 1.f) * lim) / den;
#pragma unroll
  for (int h = 0; h < 16; ++h) {
    float br = P.s5_b_re[(size_t)idx * 16 + h], bi = P.s5_b_im[(size_t)idx * 16 + h];
    q.bb[h] = f2{fr_ * br - fi_ * bi, fr_ * bi + fi_ * br};
  }
}
__device__ __forceinline__ void s5_stage_u(const Params& P, int b, int g, int j, int d, int hf, int lane, float* us) {
  const int s = hf * 64 + lane;
  const int nl = d == 0 ? s : 127 - s;
  const uint4* src = (const uint4*)(P.z + (size_t)(b * TOK + j * 128 + nl) * IND + ZC_S5U + g * 16);
  float f[16];
  unpack8(src[0], f); unpack8(src[1], f + 8);
  float4* dst = (float4*)(us + lane * 16);
  dst[0] = make_float4(f[0], f[1], f[2], f[3]); dst[1] = make_float4(f[4], f[5], f[6], f[7]);
  dst[2] = make_float4(f[8], f[9], f[10], f[11]); dst[3] = make_float4(f[12], f[13], f[14], f[15]);
}
__device__ __forceinline__ void s5_step(const S5Par& q, const float* up, float& hr, float& hi) {
  const float4* u4 = (const float4*)up;
  f2 bu = {0.f, 0.f};
#pragma unroll
  for (int k = 0; k < 4; ++k) {
    float4 u = u4[k];
    bu += q.bb[4 * k + 0] * f2{u.x, u.x}; bu += q.bb[4 * k + 1] * f2{u.y, u.y};
    bu += q.bb[4 * k + 2] * f2{u.z, u.z}; bu += q.bb[4 * k + 3] * f2{u.w, u.w};
  }
  float nr = q.lbr * hr - q.lbi * hi + bu.x;
  float ni = q.lbr * hi + q.lbi * hr + bu.y;
  hr = nr; hi = ni;
}
__device__ void unit_s5_p1(const Params& P, int l, int unit, char* smem) {
  const int wid = ltid() >> 6, lane = ltid() & 63;
  float* us = (float*)smem + wid * 1024;
  {
    int item = unit * 4 + wid;
    int c = item % NCH, g = (item / NCH) % 16, d = (item / (NCH * 16)) % 2, b = item / (NCH * 32);
    int j = dir_chunk(d, c);
    S5Par q;
    s5_params(P, l, d, g, lane, q);
    float hr = 0.f, hi = 0.f;
    for (int hf = 0; hf < 2; ++hf) {
      __syncthreads();
      s5_stage_u(P, b, g, j, d, hf, lane, us);
      __syncthreads();
      for (int s = 0; s < 64; ++s) s5_step(q, us + s * 16, hr, hi);
    }
    float2* st = (float2*)(P.s5st + (size_t)item * 128);
    st[lane] = make_float2(hr, hi);
  }
}
__device__ void phase_s5_p2(const Params& P, int l, int bid, int nblk) {
  const int wid = ltid() >> 6, lane = ltid() & 63;
  for (int it = ((bid + nblk - 388 % nblk) % nblk) * 4 + wid; it < B_ * 2 * 16; it += nblk * 4) {
    int g = it % 16, d = (it / 16) % 2;
    int gi = (l * 2 + d) * 16 + g, idx = gi * 64 + lane;
    float lre = P.s5_lam_re[idx], lim = P.s5_lam_im[idx];
    float dt = expf(P.s5_log_step[gi]);
    float mag = expf(lre * dt);
    float ar = mag * cosf(lim * dt), ai = mag * sinf(lim * dt);
#pragma unroll
    for (int i = 0; i < 7; ++i) { float nr = ar * ar - ai * ai, ni = 2.f * ar * ai; ar = nr; ai = ni; }
    float cr = 0.f, ci = 0.f;
    float2* st = (float2*)(P.s5st + (size_t)it * NCH * 128);
    for (int c0 = 0; c0 < NCH; c0 += 10) {
      float2 x[10];
#pragma unroll
      for (int i = 0; i < 10; ++i) x[i] = st[(c0 + i) * 64 + lane];
#pragma unroll
      for (int i = 0; i < 10; ++i) {
        st[(c0 + i) * 64 + lane] = make_float2(cr, ci);
        float nr = ar * cr - ai * ci + x[i].x;
        float ni = ar * ci + ai * cr + x[i].y;
        cr = nr; ci = ni;
      }
    }
  }
}
template <int DIR>
__device__ __forceinline__ void s5_p3_dir(const Params& P, int l, int b, int g, int j, int lane, float* us, ushort_t* hs, float* ys) {
  const int fr = lane & 15, fq = lane >> 4;
  const int c = dir_chunk(DIR, j);
  S5Par q;
  s5_params(P, l, DIR, g, lane, q);
  bf16x8 cb[4];
  {
    const float* cre = P.s5_c_re + ((size_t)((l * 2 + DIR) * 16 + g) * 16 + fr) * 64;
    const float* cim = P.s5_c_im + ((size_t)((l * 2 + DIR) * 16 + g) * 16 + fr) * 64;
#pragma unroll
    for (int ks = 0; ks < 4; ++ks) {
#pragma unroll
      for (int e = 0; e < 8; ++e) {
        int k = ks * 32 + fq * 8 + e, p = k >> 1;
        float v = (e & 1) ? -cim[p] : cre[p];
        cb[ks][e] = (short)f2bf(v);
      }
    }
  }
  float2 st = ((const float2*)(P.s5st + (size_t)(((b * 2 + DIR) * 16 + g) * NCH + c) * 128))[lane];
  float hr = st.x, hi = st.y;
  const int col = g * 16 + fr;
  const float dsk = P.s5_d[l * 256 + col];
#pragma unroll 1
  for (int sbi = 0; sbi < 8; ++sbi) {
    const int nsb = DIR == 0 ? sbi : 7 - sbi;
    if ((sbi & 3) == 0) {
      __syncthreads();
      s5_stage_u(P, b, g, j, DIR, sbi >> 2, lane, us);
      __syncthreads();
    }
    for (int tii = 0; tii < 16; ++tii) {
      const int s = (sbi & 3) * 16 + tii;
      const int tin = DIR == 0 ? tii : 15 - tii;
      s5_step(q, us + s * 16, hr, hi);
      *(unsigned*)(hs + tin * 136 + 2 * lane) = pack2(hr, hi);
    }
    __syncthreads();
    f32x4 acc = f32x4{0.f, 0.f, 0.f, 0.f};
#pragma unroll
    for (int ks = 0; ks < 4; ++ks) {
      bf16x8 a = *(const bf16x8*)(hs + fr * 136 + ks * 32 + fq * 8);
      acc = __builtin_amdgcn_mfma_f32_16x16x32_bf16(a, cb[ks], acc, 0, 0, 0);
    }
    if (DIR == 0) {
#pragma unroll
      for (int jx = 0; jx < 4; ++jx) ys[(nsb * 16 + fq * 4 + jx) * 16 + fr] = acc[jx];
    } else {
#pragma unroll
      for (int jx = 0; jx < 4; ++jx) {
        const int tl = nsb * 16 + fq * 4 + jx;
        const size_t r = (size_t)(b * TOK + j * 128 + tl);
        float uval = bf2f(P.z[r * IND + ZC_S5U + col]);
        float y = acc[jx] + ys[tl * 16 + fr] + dsk * uval;
        float t3 = 0.7978845608028654f * (y + 0.044715f * y * y * y);
        float gl = 0.5f * y * (1.f + tanhf(t3));
        P.s5g[r * 256 + col] = f2bf(gl);
      }
    }
    __syncthreads();
  }
}
__device__ void unit_s5_p3(const Params& P, int l, int unit, char* smem) {
  const int wid = ltid() >> 6, lane = ltid() & 63;
  float* us = (float*)smem + wid * 1024;
  ushort_t* hs = (ushort_t*)smem + 4 * 2048 + wid * (16 * 136);
  float* ys = (float*)(smem + 16384 + 17408) + wid * 2048;
  {
    int item = unit * 4 + wid;
    int j = item % NCH, g = (item / NCH) % 16, b = item / (NCH * 16);
    s5_p3_dir<0>(P, l, b, g, j, lane, us, hs, ys);
    s5_p3_dir<1>(P, l, b, g, j, lane, us, hs, ys);
  }
}

__device__ __forceinline__ void ml_stage(const Params& P, int l, int b, int h, int d, int j, int sb, int lane, float* ks, float* qs,
                                         float* vs, float* gs, bool need_q) {
  const int ti = lane >> 2, part = lane & 3;
  const int sl = sb * 16 + ti;
  const int nl = d == 0 ? sl : 127 - sl;
  const size_t r = (size_t)(b * TOK + j * 128 + nl);
  float f[16];
  {
    const uint4* src = (const uint4*)(P.mlqk + r * 512 + 256 + h * 64 + part * 16);
    unpack8(src[0], f); unpack8(src[1], f + 8);
    float4* dst = (float4*)(ks + ti * 64 + part * 16);
    dst[0] = make_float4(f[0], f[1], f[2], f[3]); dst[1] = make_float4(f[4], f[5], f[6], f[7]);
    dst[2] = make_float4(f[8], f[9], f[10], f[11]); dst[3] = make_float4(f[12], f[13], f[14], f[15]);
  }
  if (need_q) {
    const uint4* src = (const uint4*)(P.mlqk + r * 512 + h * 64 + part * 16);
    unpack8(src[0], f); unpack8(src[1], f + 8);
    float4* dst = (float4*)(qs + ti * 64 + part * 16);
    dst[0] = make_float4(f[0], f[1], f[2], f[3]); dst[1] = make_float4(f[4], f[5], f[6], f[7]);
    dst[2] = make_float4(f[8], f[9], f[10], f[11]); dst[3] = make_float4(f[12], f[13], f[14], f[15]);
  }
  {
    const uint4* src = (const uint4*)(P.z + r * IND + ZC_MLV + h * 64 + part * 16);
    unpack8(src[0], f); unpack8(src[1], f + 8);
    float4* dst = (float4*)(vs + ti * 64 + part * 16);
    dst[0] = make_float4(f[0], f[1], f[2], f[3]); dst[1] = make_float4(f[4], f[5], f[6], f[7]);
    dst[2] = make_float4(f[8], f[9], f[10], f[11]); dst[3] = make_float4(f[12], f[13], f[14], f[15]);
  }
  if (part == 0) {
    float ig = P.gates[r * 48 + (2 * d) * 4 + h] + P.ml_gate_b[l * 16 + (2 * d) * 4 + h];
    float fp = P.gates[r * 48 + (2 * d + 1) * 4 + h] + P.ml_gate_b[l * 16 + (2 * d + 1) * 4 + h];
    gs[ti * 2] = ig;
    gs[ti * 2 + 1] = logsigmoidf_(fp);
  }
}
#define ML_WAVE_LDS (3 * 1024 + 32)
__device__ void unit_ml_p1(const Params& P, int l, int unit, char* smem) {
  const int wid = ltid() >> 6, lane = ltid() & 63;
  float* ks = (float*)smem + wid * ML_WAVE_LDS;
  float* qs = ks + 1024; float* vs = qs + 1024; float* gs = vs + 1024;
  {
    int item = unit * 4 + wid;
    int c = item % NCH, d = (item / NCH) % 2, h = (item / (NCH * 2)) % 4, b = item / (NCH * 8);
    int j = dir_chunk(d, c);
    f2 C[32];
#pragma unroll
    for (int k = 0; k < 32; ++k) C[k] = f2{0.f, 0.f};
    float n = 0.f, m = -INFINITY, bsum = 0.f;
    for (int sb = 0; sb < 8; ++sb) {
      __syncthreads();
      ml_stage(P, l, b, h, d, j, sb, lane, ks, qs, vs, gs, false);
      __syncthreads();
      for (int ti = 0; ti < 16; ++ti) {
        float ig = gs[ti * 2], lf = gs[ti * 2 + 1];
        float vv = vs[ti * 64 + lane];
        float mn = fmaxf(lf + m, ig);
        float a = __expf(lf + m - mn), sc = __expf(ig - mn);
        m = mn; bsum += lf;
        const float sv = sc * vv;
        const f2 a2 = {a, a}, s2 = {sv, sv};
        const float4* k4 = (const float4*)(ks + ti * 64);
#pragma unroll
        for (int k = 0; k < 16; ++k) {
          float4 kv = k4[k];
          C[2 * k] = a2 * C[2 * k] + s2 * f2{kv.x, kv.y};
          C[2 * k + 1] = a2 * C[2 * k + 1] + s2 * f2{kv.z, kv.w};
        }
        n = a * n + sc * ks[ti * 64 + lane];
      }
    }
    float* st = P.mlst + (size_t)item * MLST_SZ;
#pragma unroll
    for (int k = 0; k < 32; ++k) { st[(2 * k) * 64 + lane] = C[k].x; st[(2 * k + 1) * 64 + lane] = C[k].y; }
    st[4096 + lane] = n;
    if (lane == 0) { st[4160] = m; st[4161] = bsum; }
  }
}
__device__ void phase_ml_p2(const Params& P, int bid, int nblk) {
  const int wid = ltid() >> 6, lane = ltid() & 63;
  for (int it = bid * 4 + wid; it < 16 * 65; it += nblk * 4) {
    int bhd = it / 65, slab = it % 65;
    int e = slab * 64 + lane;
    float st = 0.f, m = 0.f;
    float* base = P.mlst + (size_t)bhd * NCH * MLST_SZ;
    for (int c0 = 0; c0 < NCH; c0 += 10) {
      float x[10], gt[10], bt[10];
#pragma unroll
      for (int i = 0; i < 10; ++i) {
        const float* pc = base + (size_t)(c0 + i) * MLST_SZ;
        x[i] = pc[e]; gt[i] = pc[4160]; bt[i] = pc[4161];
      }
#pragma unroll
      for (int i = 0; i < 10; ++i) {
        float* pc = base + (size_t)(c0 + i) * MLST_SZ;
        float mn = fmaxf(bt[i] + m, gt[i]);
        float a = __expf(bt[i] + m - mn), s = __expf(gt[i] - mn);
        pc[e] = st;
        st = a * st + s * x[i];
        if (slab == 0 && lane == 0) pc[4162] = m;
        m = mn;
      }
    }
  }
}
__device__ void unit_ml_p3(const Params& P, int l, int unit, char* smem) {
  const int wid = ltid() >> 6, lane = ltid() & 63;
  float* ks = (float*)smem + wid * ML_WAVE_LDS;
  float* qs = ks + 1024; float* vs = qs + 1024; float* gs = vs + 1024;
  {
    int item = unit * 4 + wid;
    int c = item % NCH, d = (item / NCH) % 2, h = (item / (NCH * 2)) % 4, b = item / (NCH * 8);
    int j = dir_chunk(d, c);
    const float* st = P.mlst + (size_t)item * MLST_SZ;
    f2 C[32];
#pragma unroll
    for (int k = 0; k < 32; ++k) C[k] = f2{st[(2 * k) * 64 + lane], st[(2 * k + 1) * 64 + lane]};
    float n = st[4096 + lane], m = st[4162];
    ushort_t* outp = d == 0 ? (P.mix + 256 + h * 64 + lane) : (P.z + ZC_MLQ + h * 64 + lane);
    const size_t ostride = d == 0 ? DM : IND;
    for (int sb = 0; sb < 8; ++sb) {
      __syncthreads();
      ml_stage(P, l, b, h, d, j, sb, lane, ks, qs, vs, gs, true);
      __syncthreads();
      for (int ti = 0; ti < 16; ++ti) {
        float ig = gs[ti * 2], lf = gs[ti * 2 + 1];
        float vv = vs[ti * 64 + lane];
        float mn = fmaxf(lf + m, ig);
        float a = __expf(lf + m - mn), sc = __expf(ig - mn);
        m = mn;
        const float sv = sc * vv;
        const f2 a2 = {a, a}, s2 = {sv, sv};
        const float4* k4 = (const float4*)(ks + ti * 64);
        const float4* q4 = (const float4*)(qs + ti * 64);
        f2 numa = {0.f, 0.f}, numb = {0.f, 0.f};
#pragma unroll
        for (int k = 0; k < 16; ++k) {
          float4 kv = k4[k], qv = q4[k];
          C[2 * k] = a2 * C[2 * k] + s2 * f2{kv.x, kv.y};
          C[2 * k + 1] = a2 * C[2 * k + 1] + s2 * f2{kv.z, kv.w};
          numa += C[2 * k] * f2{qv.x, qv.y};
          numb += C[2 * k + 1] * f2{qv.z, qv.w};
        }
        n = a * n + sc * ks[ti * 64 + lane];
        float den = wave_sum(n * qs[ti * 64 + lane]);
        float hv = ((numa.x + numa.y) + (numb.x + numb.y)) / fmaxf(fabsf(den), __expf(-m));
        int sl = sb * 16 + ti;
        int nl = d == 0 ? sl : 127 - sl;
        size_t r = (size_t)(b * TOK + j * 128 + nl);
        outp[r * ostride] = f2bf(hv);
      }
    }
  }
}

#define GL_WAVE_LDS (512 * 3 + 1024)
__device__ __forceinline__ void gl_stage(const Params& P, int b, int h, int d, int j, int sb, int lane, float* ks, float* qs,
                                         float* as, float* vs, bool need_q) {
  const int ti = lane >> 2, part = lane & 3;
  const int sl = sb * 16 + ti;
  const int nl = d == 0 ? sl : 127 - sl;
  const size_t r = (size_t)(b * TOK + j * 128 + nl);
  float f[16];
  {
    unpack8(*(const uint4*)(P.z + r * IND + ZC_GLK + h * 32 + part * 8), f);
    float4* dst = (float4*)(ks + ti * 32 + part * 8);
    dst[0] = make_float4(f[0], f[1], f[2], f[3]); dst[1] = make_float4(f[4], f[5], f[6], f[7]);
  }
  if (need_q) {
    const float qs_ = 0.17677669529663687f;
    unpack8(*(const uint4*)(P.z + r * IND + ZC_GLQ + h * 32 + part * 8), f);
    float4* dst = (float4*)(qs + ti * 32 + part * 8);
    dst[0] = make_float4(f[0] * qs_, f[1] * qs_, f[2] * qs_, f[3] * qs_);
    dst[1] = make_float4(f[4] * qs_, f[5] * qs_, f[6] * qs_, f[7] * qs_);
  }
  {
    const float4* src = (const float4*)(P.alpha + r * 256 + d * 128 + h * 32 + part * 8);
    float4* dst = (float4*)(as + ti * 32 + part * 8);
    dst[0] = src[0]; dst[1] = src[1];
  }
  {
    const uint4* src = (const uint4*)(P.z + r * IND + ZC_GLV + h * 64 + part * 16);
    unpack8(src[0], f); unpack8(src[1], f + 8);
    float4* dst = (float4*)(vs + ti * 64 + part * 16);
    dst[0] = make_float4(f[0], f[1], f[2], f[3]); dst[1] = make_float4(f[4], f[5], f[6], f[7]);
    dst[2] = make_float4(f[8], f[9], f[10], f[11]); dst[3] = make_float4(f[12], f[13], f[14], f[15]);
  }
}
__device__ void unit_gl_p1(const Params& P, int unit, char* smem) {
  const int wid = ltid() >> 6, lane = ltid() & 63;
  float* ks = (float*)smem + wid * GL_WAVE_LDS;
  float* qs = ks + 512; float* as = qs + 512; float* vs = as + 512;
  {
    int item = unit * 4 + wid;
    int c = item % NCH, d = (item / NCH) % 2, h = (item / (NCH * 2)) % 4, b = item / (NCH * 8);
    int j = dir_chunk(d, c);
    f2 S[16];
#pragma unroll
    for (int k = 0; k < 16; ++k) S[k] = f2{0.f, 0.f};
    float ap = 1.f;
    for (int sb = 0; sb < 8; ++sb) {
      __syncthreads();
      gl_stage(P, b, h, d, j, sb, lane, ks, qs, as, vs, false);
      __syncthreads();
      for (int ti = 0; ti < 16; ++ti) {
        const float vv = vs[ti * 64 + lane];
        const f2 v2 = {vv, vv};
        const float4* k4 = (const float4*)(ks + ti * 32);
        const float4* a4 = (const float4*)(as + ti * 32);
#pragma unroll
        for (int k = 0; k < 8; ++k) {
          float4 kv = k4[k], av = a4[k];
          S[2 * k] = f2{av.x, av.y} * S[2 * k] + f2{kv.x, kv.y} * v2;
          S[2 * k + 1] = f2{av.z, av.w} * S[2 * k + 1] + f2{kv.z, kv.w} * v2;
        }
        ap *= as[ti * 32 + (lane & 31)];
      }
    }
    float* st = P.glast + (size_t)item * GLST_SZ;
#pragma unroll
    for (int k = 0; k < 16; ++k) { st[(2 * k) * 64 + lane] = S[k].x; st[(2 * k + 1) * 64 + lane] = S[k].y; }
    if (lane < 32) st[2048 + lane] = ap;
  }
}
__device__ void phase_gl_p2(const Params& P, int bid, int nblk) {
  const int wid = ltid() >> 6, lane = ltid() & 63;
  for (int it = ((bid + nblk - 260 % nblk) % nblk) * 4 + wid; it < 16 * 32; it += nblk * 4) {
    int bhd = it / 32, slab = it % 32;
    int e = slab * 64 + lane;
    float st = 0.f;
    float* base = P.glast + (size_t)bhd * NCH * GLST_SZ;
    for (int c0 = 0; c0 < NCH; c0 += 10) {
      float x[10], A[10];
#pragma unroll
      for (int i = 0; i < 10; ++i) {
        const float* pc = base + (size_t)(c0 + i) * GLST_SZ;
        x[i] = pc[e]; A[i] = pc[2048 + slab];
      }
#pragma unroll
      for (int i = 0; i < 10; ++i) {
        float* pc = base + (size_t)(c0 + i) * GLST_SZ;
        pc[e] = st;
        st = A[i] * st + x[i];
      }
    }
  }
}
__device__ void unit_gl_p3(const Params& P, int unit, char* smem) {
  const int wid = ltid() >> 6, lane = ltid() & 63;
  float* ks = (float*)smem + wid * GL_WAVE_LDS;
  float* qs = ks + 512; float* as = qs + 512; float* vs = as + 512;
  {
    int item = unit * 4 + wid;
    int c = item % NCH, d = (item / NCH) % 2, h = (item / (NCH * 2)) % 4, b = item / (NCH * 8);
    int j = dir_chunk(d, c);
    const float* st = P.glast + (size_t)item * GLST_SZ;
    f2 S[16];
#pragma unroll
    for (int k = 0; k < 16; ++k) S[k] = f2{st[(2 * k) * 64 + lane], st[(2 * k + 1) * 64 + lane]};
    ushort_t* outp = d == 0 ? (P.mix + 768 + h * 64 + lane) : (P.z + ZC_MLK + h * 64 + lane);
    const size_t ostride = d == 0 ? DM : IND;
    for (int sb = 0; sb < 8; ++sb) {
      __syncthreads();
      gl_stage(P, b, h, d, j, sb, lane, ks, qs, as, vs, true);
      __syncthreads();
      for (int ti = 0; ti < 16; ++ti) {
        const float vv = vs[ti * 64 + lane];
        const f2 v2 = {vv, vv};
        const float4* k4 = (const float4*)(ks + ti * 32);
        const float4* a4 = (const float4*)(as + ti * 32);
        const float4* q4 = (const float4*)(qs + ti * 32);
        f2 oa = {0.f, 0.f}, ob = {0.f, 0.f};
#pragma unroll
        for (int k = 0; k < 8; ++k) {
          float4 kv = k4[k], av = a4[k], qv = q4[k];
          S[2 * k] = f2{av.x, av.y} * S[2 * k] + f2{kv.x, kv.y} * v2;
          S[2 * k + 1] = f2{av.z, av.w} * S[2 * k + 1] + f2{kv.z, kv.w} * v2;
          oa += f2{qv.x, qv.y} * S[2 * k];
          ob += f2{qv.z, qv.w} * S[2 * k + 1];
        }
        int sl = sb * 16 + ti;
        int nl = d == 0 ? sl : 127 - sl;
        size_t r = (size_t)(b * TOK + j * 128 + nl);
        outp[r * ostride] = f2bf((oa.x + oa.y) + (ob.x + ob.y));
      }
    }
  }
}
__device__ void phase_finish(const Params& P, int l, int bid, int nblk) {
  const int wid = ltid() >> 6, lane = ltid() & 63;
  for (int it = bid * 4 + wid; it < NTOK * 2; it += nblk * 4) {
    const int r = it >> 1, which = it & 1;
    const int ch = lane * 4;
    ushort_t* mp = P.mix + (size_t)r * DM + (which ? 768 : 256) + ch;
    const ushort_t* zp = P.z + (size_t)r * IND + (which ? ZC_MLK : ZC_MLQ) + ch;
    uint2 a = *(const uint2*)mp, bb = *(const uint2*)zp;
    float v[4];
    v[0] = __uint_as_float(a.x << 16) + __uint_as_float(bb.x << 16);
    v[1] = __uint_as_float(a.x & 0xffff0000u) + __uint_as_float(bb.x & 0xffff0000u);
    v[2] = __uint_as_float(a.y << 16) + __uint_as_float(bb.y << 16);
    v[3] = __uint_as_float(a.y & 0xffff0000u) + __uint_as_float(bb.y & 0xffff0000u);
    float ss = v[0] * v[0] + v[1] * v[1] + v[2] * v[2] + v[3] * v[3];
    ss += __shfl_xor(ss, 1); ss += __shfl_xor(ss, 2); ss += __shfl_xor(ss, 4); ss += __shfl_xor(ss, 8);
    float rstd = rsqrtf(ss * (1.f / 64.f) + 1e-6f);
    uint2 gz = *(const uint2*)(P.z + (size_t)r * IND + (which ? ZC_GLR : ZC_MLO) + ch);
    float gt[4] = {__uint_as_float(gz.x << 16), __uint_as_float(gz.x & 0xffff0000u), __uint_as_float(gz.y << 16),
                   __uint_as_float(gz.y & 0xffff0000u)};
    float o[4];
#pragma unroll
    for (int i = 0; i < 4; ++i) {
      if (which == 0) {
        float gain = P.ml_norm_g[l * 256 + ch + i];
        o[i] = sigmoidf_(gt[i]) * (v[i] * rstd * gain);
      } else {
        float gain = P.gla_norm_g[l * 64 + ((ch + i) & 63)];
        o[i] = (v[i] * rstd * gain) * (gt[i] * sigmoidf_(gt[i]));
      }
    }
    uint2 ov; ov.x = pack2(o[0], o[1]); ov.y = pack2(o[2], o[3]);
    *(uint2*)mp = ov;
  }
}

__device__ void phase_vt(const Params& P, int bid, int nblk, char* smem) {
  ushort_t* tile = (ushort_t*)smem;
  const int tid = ltid();
  const int nitems = B_ * 4 * (TOK / 64);
  for (int it = bid; it < nitems; it += nblk) {
    const int tb = it % 260, head = (it / 260) % 4, b = it / 1040;
    __syncthreads();
#pragma unroll
    for (int i = 0; i < 2; ++i) {
      int id = tid + 256 * i, tok = id >> 3, vc = id & 7;
      uint4 v = *(const uint4*)(P.z + (size_t)(b * TOK + tb * 64 + tok) * IND + ZC_DAV + head * 64 + vc * 8);
      unsigned* d = (unsigned*)(tile + tok * 66 + vc * 8);
      d[0] = v.x; d[1] = v.y; d[2] = v.z; d[3] = v.w;
    }
    __syncthreads();
#pragma unroll
    for (int i = 0; i < 2; ++i) {
      int id = tid + 256 * i, v = id >> 3, tc = id & 7;
      unsigned w[4];
#pragma unroll
      for (int e = 0; e < 4; ++e)
        w[e] = (unsigned)tile[(tc * 8 + 2 * e) * 66 + v] | ((unsigned)tile[(tc * 8 + 2 * e + 1) * 66 + v] << 16);
      *(uint4*)(P.vt + (size_t)((b * 4 + head) * 64 + v) * TOK + tb * 64 + tc * 8) = make_uint4(w[0], w[1], w[2], w[3]);
    }
  }
}

__device__ void phase_attn(const Params& P, int l, int bid, int nblk, char* smem) {
  ushort_t* Ks = (ushort_t*)smem;
  ushort_t* Vt = Ks + 64 * 72;
  const int tid = ltid(), wid = tid >> 6, lane = tid & 63, r = lane & 31, h = lane >> 5;
  const float lam_init = 0.8f - 0.6f * expf(-0.3f * (float)l);
  float lam;
  {
    const float* lp = P.da_lam + l * 128;
    float s01 = 0.f, s23 = 0.f;
    for (int i = 0; i < 32; ++i) { s01 += lp[i] * lp[32 + i]; s23 += lp[64 + i] * lp[96 + i]; }
    lam = expf(s01) - expf(s23) + lam_init;
  }
  const float LOG2E = 1.4426950408889634f;
  const int nitems = 1024 + 16;
  const int srow = tid >> 3, sck = tid & 7;
  for (int item = bid; item < nitems; item += nblk) {
    int b, head, q0, nkeys;
    if (item < 1024) { int qb = item % 128; head = (item / 128) % 4; b = item / 512; q0 = CTX + qb * 128; nkeys = TOK; }
    else { int i2 = item - 1024; int qb = i2 % 2; head = (i2 / 2) % 4; b = i2 / 8; q0 = qb * 128; nkeys = CTX; }
    const size_t qrow = (size_t)(b * TOK + q0 + wid * 32 + r);
    bf16x8 Qf[2][2];
#pragma unroll
    for (int mp = 0; mp < 2; ++mp)
#pragma unroll
      for (int s = 0; s < 2; ++s) Qf[mp][s] = *(const bf16x8*)(P.z + qrow * IND + ZC_DAQ + head * 64 + mp * 32 + 16 * s + 8 * h);
    f32x16 O[2][2];
#pragma unroll
    for (int mp = 0; mp < 2; ++mp)
#pragma unroll
      for (int mt = 0; mt < 2; ++mt)
#pragma unroll
        for (int i = 0; i < 16; ++i) O[mp][mt][i] = 0.f;
    float m[2] = {-INFINITY, -INFINITY}, lsum[2] = {0.f, 0.f};
    const ushort_t* kbase = P.z + (size_t)(b * TOK) * IND + ZC_DAK + head * 64 + (size_t)srow * IND + sck * 8;
    const ushort_t* vbase = P.vt + (size_t)((b * 4 + head) * 64 + srow) * TOK + sck * 8;
    uint4 rk0 = *(const uint4*)(kbase), rk1 = *(const uint4*)(kbase + (size_t)32 * IND);
    uint4 rv0 = *(const uint4*)(vbase), rv1 = *(const uint4*)(vbase + (size_t)32 * TOK);
    const int ntile = nkeys / 64;
    for (int kt = 0; kt < ntile; ++kt) {
      __syncthreads();
      *(uint4*)(Ks + srow * 72 + sck * 8) = rk0; *(uint4*)(Ks + (srow + 32) * 72 + sck * 8) = rk1;
      *(uint4*)(Vt + srow * 72 + sck * 8) = rv0; *(uint4*)(Vt + (srow + 32) * 72 + sck * 8) = rv1;
      __syncthreads();
      if (kt + 1 < ntile) {
        const ushort_t* kp = kbase + (size_t)((kt + 1) * 64) * IND;
        const ushort_t* vp = vbase + (kt + 1) * 64;
        rk0 = *(const uint4*)(kp); rk1 = *(const uint4*)(kp + (size_t)32 * IND);
        rv0 = *(const uint4*)(vp); rv1 = *(const uint4*)(vp + (size_t)32 * TOK);
      }
#pragma unroll
      for (int kb = 0; kb < 2; ++kb) {
        bf16x8 Pf[2][2];
#pragma unroll
        for (int mp = 0; mp < 2; ++mp) {
          f32x16 S;
#pragma unroll
          for (int i = 0; i < 16; ++i) S[i] = 0.f;
#pragma unroll
          for (int s = 0; s < 2; ++s) {
            bf16x8 a = *(const bf16x8*)(Ks + (kb * 32 + r) * 72 + mp * 32 + 16 * s + 8 * h);
            S = __builtin_amdgcn_mfma_f32_32x32x16_bf16(a, Qf[mp][s], S, 0, 0, 0);
          }
          float mx = S[0];
#pragma unroll
          for (int i = 1; i < 16; ++i) mx = fmaxf(mx, S[i]);
          mx = fmaxf(mx, __shfl_xor(mx, 32)) * LOG2E;
          if (__any(mx > m[mp])) {
            float mn = fmaxf(m[mp], mx);
            float al = __builtin_amdgcn_exp2f(m[mp] - mn);
            m[mp] = mn;
            lsum[mp] *= al;
#pragma unroll
            for (int i = 0; i < 16; ++i) { O[mp][0][i] *= al; O[mp][1][i] *= al; }
          }
          float p[16];
          float ps = 0.f;
#pragma unroll
          for (int i = 0; i < 16; ++i) { p[i] = __builtin_amdgcn_exp2f(fmaf(S[i], LOG2E, -m[mp])); ps += p[i]; }
          lsum[mp] += ps;
#pragma unroll
          for (int s = 0; s < 2; ++s) {
            uint4 w;
            w.x = pack2(p[8 * s + 0], p[8 * s + 1]); w.y = pack2(p[8 * s + 2], p[8 * s + 3]);
            w.z = pack2(p[8 * s + 4], p[8 * s + 5]); w.w = pack2(p[8 * s + 6], p[8 * s + 7]);
            Pf[mp][s] = __builtin_bit_cast(bf16x8, w);
          }
        }
#pragma unroll
        for (int mt = 0; mt < 2; ++mt) {
#pragma unroll
          for (int s = 0; s < 2; ++s) {
            const ushort_t* vp = Vt + (mt * 32 + r) * 72 + kb * 32 + 16 * s + 4 * h;
            uint2 lo = *(const uint2*)(vp), hi = *(const uint2*)(vp + 8);
            bf16x8 a = __builtin_bit_cast(bf16x8, make_uint4(lo.x, lo.y, hi.x, hi.y));
            O[0][mt] = __builtin_amdgcn_mfma_f32_32x32x16_bf16(a, Pf[0][s], O[0][mt], 0, 0, 0);
            O[1][mt] = __builtin_amdgcn_mfma_f32_32x32x16_bf16(a, Pf[1][s], O[1][mt], 0, 0, 0);
          }
        }
      }
    }
    const float l0 = lsum[0] + __shfl_xor(lsum[0], 32), l1 = lsum[1] + __shfl_xor(lsum[1], 32);
    const float i0 = 1.f / l0, i1 = lam / l1;
    float ss = 0.f;
#pragma unroll
    for (int mt = 0; mt < 2; ++mt)
#pragma unroll
      for (int i = 0; i < 16; ++i) {
        float v = O[0][mt][i] * i0 - O[1][mt][i] * i1;
        O[0][mt][i] = v;
        ss += v * v;
      }
    ss += __shfl_xor(ss, 32);
    const float rstd = rsqrtf(ss * (1.f / 64.f) + 1e-6f) * (1.f - lam_init);
    ushort_t* op = P.mix + qrow * DM + 512 + head * 64;
#pragma unroll
    for (int mt = 0; mt < 2; ++mt)
#pragma unroll
      for (int g = 0; g < 4; ++g) {
        const int v0 = mt * 32 + 8 * g + 4 * h;
        const float4 gn = *(const float4*)(P.da_norm_g + l * 64 + v0);
        uint2 o;
        o.x = pack2(O[0][mt][4 * g + 0] * rstd * gn.x, O[0][mt][4 * g + 1] * rstd * gn.y);
        o.y = pack2(O[0][mt][4 * g + 2] * rstd * gn.z, O[0][mt][4 * g + 3] * rstd * gn.w);
        *(uint2*)(op + v0) = o;
      }
  }
}

__device__ void phase_final(const Params& P, int bid, int nblk) {
  const int wid = ltid() >> 6, lane = ltid() & 63;
  for (int q = bid * 4 + wid; q < B_ * SEQ; q += nblk * 4) {
    int b = q / SEQ, tl = q % SEQ;
    const float4* xr = (const float4*)(P.xres + (size_t)(b * TOK + CTX + tl) * DM);
    float4 v[4];
    float ss = 0;
#pragma unroll
    for (int i = 0; i < 4; ++i) {
      v[i] = xr[lane + 64 * i];
      ss += v[i].x * v[i].x + v[i].y * v[i].y + v[i].z * v[i].z + v[i].w * v[i].w;
    }
    ss = wave_sum(ss);
    float rstd = rsqrtf(ss * (1.f / DM) + 1e-6f);
    float4* o = (float4*)(P.out + (size_t)q * DM);
#pragma unroll
    for (int i = 0; i < 4; ++i) {
      float4 gg = ((const float4*)P.final_norm_g)[lane + 64 * i];
      o[lane + 64 * i] = make_float4(v[i].x * rstd * gg.x, v[i].y * rstd * gg.y, v[i].z * rstd * gg.z, v[i].w * rstd * gg.w);
    }
  }
}


#define XB_TMO      128
#define XB_XCNT(j)  (256  + 64 * (j))
#define XB_XSUB(j)  (1280 + 64 * (j))
#define XB_XGEN(j)  (2304 + 64 * (j))
#define XB_TOP      3328
#define XB_TOPGEN   3392
#define XCD_BAR_WORDS 3456
#define XB_SPIN_CAP (1u << 20)
#define LAS __attribute__((address_space(3)))
__device__ __forceinline__ unsigned xb_ld(unsigned* p)              { return __hip_atomic_load(p, __ATOMIC_RELAXED, __HIP_MEMORY_SCOPE_AGENT); }
__device__ __forceinline__ unsigned xb_add(unsigned* p, unsigned v) { return __hip_atomic_fetch_add(p, v, __ATOMIC_RELAXED, __HIP_MEMORY_SCOPE_AGENT); }
__device__ __forceinline__ unsigned xb_xcc_id() { return (unsigned)__builtin_amdgcn_s_getreg((3 << 11) | 20) & 0xFu; }
#define XB_SPIN(cond, bar) do { unsigned _sp = 0; while (cond) { __builtin_amdgcn_s_sleep(1); \
    if ((++_sp & 255u) == 0u) { if (xb_ld(&(bar)[XB_TMO])) break; if (_sp > XB_SPIN_CAP) { atomicAdd(&(bar)[XB_TMO], 1u); break; } } } } while (0)
struct XcdBarrier { unsigned* bar; unsigned x; volatile LAS unsigned* st; };
__device__ __forceinline__ XcdBarrier xcd_barrier_post(unsigned* bar, volatile LAS unsigned* st) {
  XcdBarrier b; b.bar = bar; b.x = xb_xcc_id(); b.st = st;
  if (threadIdx.x == 0) (void)xb_add(&bar[XB_XCNT(b.x)], 1u);
  return b;
}
__device__ __forceinline__ void xcd_barrier_complete(unsigned* bar, unsigned x, unsigned& nloc, unsigned& nx) {
  const unsigned G = gridDim.x * gridDim.y * gridDim.z;
  unsigned sum, cnt, mine, sp = 0u;
  for (;;) {
    sum = 0u; cnt = 0u; mine = 0u;
#pragma unroll
    for (unsigned j = 0; j < 16; ++j) { const unsigned c = xb_ld(&bar[XB_XCNT(j)]); sum += c; cnt += (c > 0u) ? 1u : 0u; mine = (j == x) ? c : mine; }
    if (sum == G) break;
    __builtin_amdgcn_s_sleep(1);
    if ((++sp & 255u) == 0u) { if (xb_ld(&bar[XB_TMO])) break; if (sp > XB_SPIN_CAP) { atomicAdd(&bar[XB_TMO], 1u); break; } }
  }
  nloc = mine > 0u ? mine : 1u; nx = cnt > 0u ? cnt : 1u;
}
__device__ __forceinline__ void xcd_barrier(const XcdBarrier& b) {
  asm volatile("s_waitcnt vmcnt(0)" ::: "memory");
  __syncthreads();
  if (threadIdx.x == 0) {
    unsigned* bar = b.bar;
    __builtin_amdgcn_s_waitcnt(0);
    unsigned nloc = b.st[0], nx = b.st[1];
    if (nloc == 0u) { xcd_barrier_complete(bar, b.x, nloc, nx); b.st[0] = nloc; b.st[1] = nx; }
    const unsigned old = xb_add(&bar[XB_XSUB(b.x)], 1u);
    const unsigned gen = old / nloc;
    if (old + 1u == (gen + 1u) * nloc) {
      __builtin_amdgcn_fence(__ATOMIC_RELEASE, "agent");
      asm volatile("s_waitcnt vmcnt(0)" ::: "memory");
      const unsigned og = xb_add(&bar[XB_TOP], 1u);
      const unsigned tg = og / nx;
      if (og + 1u == (tg + 1u) * nx) xb_add(&bar[XB_TOPGEN], 1u);
      else XB_SPIN(xb_ld(&bar[XB_TOPGEN]) == tg, bar);
      __builtin_amdgcn_fence(__ATOMIC_ACQUIRE, "agent");
      xb_add(&bar[XB_XGEN(b.x)], 1u);
      asm volatile("s_waitcnt vmcnt(0)" ::: "memory");
    } else {
      XB_SPIN(xb_ld(&bar[XB_XGEN(b.x)]) == gen, bar);
      __builtin_amdgcn_fence(__ATOMIC_ACQUIRE, "agent");
      asm volatile("s_waitcnt vmcnt(0)" ::: "memory");
    }
  }
  __syncthreads();
}

constexpr int NPH = 11;
__device__ __forceinline__ int next_unit(unsigned* ctr, char* smem) {
  int* sh = (int*)(smem + SMEM_BYTES - 16);
  __syncthreads();
  if (ltid() == 0) *sh = (int)atomicAdd(ctr, 1u);
  __syncthreads();
  return *sh;
}
__device__ __forceinline__ void run_phase(const Params& P, int l, int ph, int bid, int nblk, char* smem) {
  bid = launder_s(bid); nblk = launder_s(nblk); l = launder_s(l);
  switch (ph) {
    case 0: phase_convw(P, l, bid, nblk, smem); phase_norm(P, l, 0, bid, nblk); break;
    case 1: gemm_phase<G_ZIN>(P, l, P.h, P.wt_in, DM, INDP / 128, bid, nblk, smem); break;
    case 2: phase_vt(P, bid, nblk, smem); phase_prep(P, l, bid, nblk); break;
    case 3:
      for (;;) {
        const int u = next_unit(P.qctr + l * 2, smem);
        if (u >= 520 + 520 + 2080) break;
        if (u < 520) unit_ml_p1(P, l, u, smem);
        else if (u < 1040) unit_gl_p1(P, u - 520, smem);
        else unit_s5_p1(P, l, u - 1040, smem);
      }
      break;
    case 4: phase_s5_p2(P, l, bid, nblk); phase_ml_p2(P, bid, nblk); phase_gl_p2(P, bid, nblk); __syncthreads();
            phase_attn(P, l, bid, nblk, smem); break;
    case 5:
      for (;;) {
        const int u = next_unit(P.qctr + l * 2 + 1, smem);
        if (u >= 520 + 520 + 1040) break;
        if (u < 520) unit_ml_p3(P, l, u, smem);
        else if (u < 1040) unit_gl_p3(P, u - 520, smem);
        else unit_s5_p3(P, l, u - 1040, smem);
      }
      break;
    case 6: phase_finish(P, l, bid, nblk); __syncthreads(); gemm_phase<G_GLU>(P, l, P.s5g, P.glut, 256, 2, bid, nblk, smem); break;
    case 7: gemm_phase<G_WOUT>(P, l, P.mix, P.wt_out, DM, 8, bid, nblk, smem); break;
    case 8: phase_norm(P, l, 1, bid, nblk); break;
    case 9: gemm_phase<G_W1>(P, l, P.h, P.w1t, DM, 32, bid, nblk, smem); break;
    case 10: gemm_phase<G_W2>(P, l, P.hidden, P.w2t, DFF, 8, bid, nblk, smem); break;
  }
}

#if MEGA
__global__ void __launch_bounds__(NT, 2) k_mega(Params P) {
  __shared__ __attribute__((aligned(16))) char smem[SMEM_BYTES];
  cg::grid_group grid = cg::this_grid();
  const int bid = blockIdx.x, nblk = gridDim.x;
  volatile LAS unsigned* st = (volatile LAS unsigned*)(smem + SMEM_BYTES - 32);
  if (threadIdx.x == 0) { st[0] = 0u; st[1] = 0u; }
  for (int i = bid * NT + threadIdx.x; i < XCD_BAR_WORDS; i += nblk * NT) P.xbar[i] = 0u;
  phase_init(P, bid, nblk, smem);
  grid.sync();
  XcdBarrier xb = xcd_barrier_post(P.xbar, st);
  for (int l = 0; l < DEPTH; ++l) {
    for (int ph = 0; ph < NPH; ++ph) {
      run_phase(P, l, ph, bid, nblk, smem);
      xcd_barrier(xb);
#if PROBE == 1
      if (ph == 4) { phase_attn(P, l, bid, nblk, smem); xcd_barrier(xb); }
#elif PROBE == 2
      if (ph == 1 || ph == 9) { run_phase(P, l, ph, bid, nblk, smem); xcd_barrier(xb); }
#elif PROBE == 4
      if (ph == 0) { for (int q = 0; q < 10; ++q) xcd_barrier(xb); }
#elif PROBE == 5
      if (ph == 0 || ph == 8) { run_phase(P, l, ph, bid, nblk, smem); xcd_barrier(xb); }
#endif
    }
  }
  phase_final(P, bid, nblk);
}
#else
__global__ void __launch_bounds__(NT, 2) k_init(Params P) {
  __shared__ __attribute__((aligned(16))) char smem[SMEM_BYTES];
  phase_init(P, blockIdx.x, gridDim.x, smem);
}
template <int PH>
__global__ void __launch_bounds__(NT, 2) k_phase(Params P, int l) {
  __shared__ __attribute__((aligned(16))) char smem[SMEM_BYTES];
  run_phase(P, l, PH, blockIdx.x, gridDim.x, smem);
}
__global__ void __launch_bounds__(NT, 2) k_final(Params P) { phase_final(P, blockIdx.x, gridDim.x); }
#endif

extern "C" void kernel_launch(void* const* d_in, const int* in_sizes, int n_in, void* d_out, int out_size, void* d_ws,
                              size_t ws_size, hipStream_t stream) {
  Params P{};
  const float** pp = (const float**)&P;
  for (int i = 0; i < 32; ++i) pp[i] = (const float*)d_in[i];
  P.out = (float*)d_out;
  char* w = (char*)d_ws;
  size_t off = 0;
  auto take = [&](size_t bytes) { char* p = w + off; off += (bytes + 255) & ~(size_t)255; return p; };
  P.xres = (float*)take((size_t)NTOK * DM * 4);
  char* R = take((size_t)NTOK * DFF * 2);
  P.z = (ushort_t*)R;
  P.mix = (ushort_t*)(R + (size_t)NTOK * IND * 2);
  P.hidden = (ushort_t*)R;
  P.wt_in = (ushort_t*)take((size_t)INDP * DM * 2);
  P.wt_out = (ushort_t*)take((size_t)DM * DM * 2);
  P.w1t = (ushort_t*)take((size_t)DFF * DM * 2);
  P.w2t = (ushort_t*)take((size_t)DM * DFF * 2);
  P.glut = (ushort_t*)take((size_t)256 * 256 * 2);
  P.mlqk = (ushort_t*)take((size_t)NTOK * 512 * 2);
  P.s5g = (ushort_t*)take((size_t)NTOK * 256 * 2);
  P.mlst = (float*)take((size_t)B_ * 4 * 2 * NCH * MLST_SZ * 4);
  P.mod = (float*)take((size_t)DEPTH * 3 * 6144 * 4);
  P.qctr = (unsigned*)take(256);
  P.xbar = (unsigned*)take((size_t)XCD_BAR_WORDS * 4);
  if (off > ws_size) { fprintf(stderr, "ws too small: need %zu have %zu\n", off, ws_size); return; }
  char* o = (char*)d_out;
  size_t ooff = 0;
  auto otake = [&](size_t bytes) { char* p = o + ooff; ooff += (bytes + 255) & ~(size_t)255; return p; };
  P.h = (ushort_t*)otake((size_t)NTOK * DM * 2);
  {
    char* hb = (char*)P.h;
    size_t ho = 0;
    auto htake = [&](size_t bytes) { char* p = hb + ho; ho += (bytes + 255) & ~(size_t)255; return p; };
    P.alpha = (float*)htake((size_t)NTOK * 256 * 4);
    P.s5st = (float*)htake((size_t)B_ * 2 * 16 * NCH * 128 * 4);
    P.glast = (float*)htake((size_t)B_ * 4 * 2 * NCH * GLST_SZ * 4);
    if (ho > (size_t)NTOK * DM * 2) { fprintf(stderr, "alias overflow\n"); return; }
  }
  P.gates = (float*)otake((size_t)NTOK * 48 * 4);
  P.vt = (ushort_t*)otake((size_t)B_ * 4 * 64 * TOK * 2);
  if (ooff > (size_t)out_size * 4) { fprintf(stderr, "out scratch too small\n"); return; }

#if MEGA
  static int grid_blocks = 0;
  if (!grid_blocks) {
    int dev = 0, cus = 0, per_cu = 0;
    hipGetDevice(&dev);
    hipDeviceGetAttribute(&cus, hipDeviceAttributeMultiprocessorCount, dev);
    hipOccupancyMaxActiveBlocksPerMultiprocessor(&per_cu, k_mega, NT, 0);
    if (per_cu > 2) per_cu = 2;
    grid_blocks = cus * per_cu;
  }
  void* args[] = {&P};
  hipError_t e = hipLaunchCooperativeKernel((void*)k_mega, dim3(grid_blocks), dim3(NT), args, 0, stream);
  if (e != hipSuccess) fprintf(stderr, "cooperative launch failed: %s (grid %d)\n", hipGetErrorString(e), grid_blocks);
#else
  const int G = 512;
  k_init<<<G, NT, 0, stream>>>(P);
  for (int l = 0; l < DEPTH; ++l) {
    k_phase<0><<<G, NT, 0, stream>>>(P, l);
    k_phase<1><<<G, NT, 0, stream>>>(P, l);
    k_phase<2><<<G, NT, 0, stream>>>(P, l);
    k_phase<3><<<G, NT, 0, stream>>>(P, l);
    k_phase<4><<<G, NT, 0, stream>>>(P, l);
    k_phase<5><<<G, NT, 0, stream>>>(P, l);
    k_phase<6><<<G, NT, 0, stream>>>(P, l);
    k_phase<7><<<G, NT, 0, stream>>>(P, l);
    k_phase<8><<<G, NT, 0, stream>>>(P, l);
    k_phase<9><<<G, NT, 0, stream>>>(P, l);
    k_phase<10><<<G, NT, 0, stream>>>(P, l);
  }
  k_final<<<G, NT, 0, stream>>>(P);
#endif
}
```

```cpp
#include <hip/hip_runtime.h>
#include <hip/hip_cooperative_groups.h>
#include <stdint.h>
#include <stdio.h>
namespace cg = cooperative_groups;

#ifndef MEGA
#define MEGA 1
#endif
#define PROBE 0

#define NT 512
#define NW 8
typedef unsigned short ushort_t;
using bf16x8 = __attribute__((ext_vector_type(8))) short;
using f32x4 = __attribute__((ext_vector_type(4))) float;
using f32x16 = __attribute__((ext_vector_type(16))) float;
typedef float f2 __attribute__((ext_vector_type(2)));

constexpr int B_ = 2, SEQ = 16384, CTX = 256, TOK = SEQ + CTX, NTOK = B_ * TOK, DM = 1024, DEPTH = 4;
constexpr int IND = 2864, INDP = 3072, DFF = 4096, NCH = 130;
constexpr int MLST_SZ = 4224;
constexpr int GLST_SZ = 2112;
constexpr int SMEM_BYTES = 8 * (8448 + 4352 + 4096) + 32;

constexpr int ZC_S5U = 0, ZC_MLQ = 256, ZC_MLK = 512, ZC_MLV = 768, ZC_MLO = 1024, ZC_MLG = 1280;
constexpr int ZC_DAQ = 1296, ZC_DAK = 1552, ZC_DAV = 1808;
constexpr int ZC_GLQ = 2064, ZC_GLK = 2192, ZC_GLV = 2320, ZC_GLR = 2576, ZC_GLA = 2832;

struct Params {
  const float *x, *c, *ctx, *c_ctx, *ada_w, *ada_b, *norm1_g, *norm2_g, *w_in, *s5_lam_re, *s5_lam_im, *s5_log_step,
      *s5_b_re, *s5_b_im, *s5_c_re, *s5_c_im, *s5_d, *s5_glu_w, *s5_glu_b, *ml_conv_w, *ml_conv_b, *ml_gate_b,
      *ml_norm_g, *da_lam, *da_norm_g, *gla_alpha_w, *gla_alpha_b, *gla_norm_g, *w_out, *mlp_w1, *mlp_w2, *final_norm_g;
  float* out;
  float* xres;
  ushort_t* z;
  ushort_t* mix;
  ushort_t* hidden;
  ushort_t *wt_in, *wt_out, *w1t, *w2t, *glut;
  ushort_t* mlqk;
  ushort_t* s5g;
  float* mlst;
  float* mod;
  ushort_t* h;
  float* alpha;
  float* gates;
  float* s5st;
  float* glast;
  ushort_t* vt;
  unsigned* qctr;
  uint4* s5tab;
  unsigned* xbar;
};

__shared__ int g_wtab[64];
__device__ __forceinline__ int hw_slot() { return __builtin_amdgcn_s_getreg((5 << 11) | 4) & 63; }
__device__ __forceinline__ int ltid() {
  const int wv = g_wtab[hw_slot()];
  int lane;
  asm volatile("v_mbcnt_lo_u32_b32 %0, -1, 0\n\tv_mbcnt_hi_u32_b32 %0, -1, %0" : "=v"(lane));
  return wv * 64 + lane;
}
__device__ __forceinline__ int launder_s(int x) { asm volatile("" : "+s"(x)); return x; }
__device__ __forceinline__ float bf2f(ushort_t u) { return __uint_as_float(((unsigned)u) << 16); }
__device__ __forceinline__ ushort_t f2bf(float f) {
  unsigned u = __float_as_uint(f);
  u += 0x7fffu + ((u >> 16) & 1u);
  return (ushort_t)(u >> 16);
}
__device__ __forceinline__ unsigned pack2(float a, float b) {
  typedef __bf16 bf2_t __attribute__((ext_vector_type(2)));
  typedef float f2_t __attribute__((ext_vector_type(2)));
  f2_t v = {a, b};
  return __builtin_bit_cast(unsigned, __builtin_convertvector(v, bf2_t));
}
__device__ __forceinline__ float wave_sum(float v) {
#pragma unroll
  for (int o = 32; o; o >>= 1) v += __shfl_xor(v, o);
  return v;
}
__device__ __forceinline__ float sigmoidf_(float x) { return 1.f / (1.f + __expf(-x)); }
__device__ __forceinline__ float logsigmoidf_(float x) { return fminf(x, 0.f) - __logf(1.f + __expf(-fabsf(x))); }
__device__ __forceinline__ void unpack8(uint4 v, float* f) {
  f[0] = __uint_as_float(v.x << 16); f[1] = __uint_as_float(v.x & 0xffff0000u);
  f[2] = __uint_as_float(v.y << 16); f[3] = __uint_as_float(v.y & 0xffff0000u);
  f[4] = __uint_as_float(v.z << 16); f[5] = __uint_as_float(v.z & 0xffff0000u);
  f[6] = __uint_as_float(v.w << 16); f[7] = __uint_as_float(v.w & 0xffff0000u);
}
__device__ __forceinline__ int dir_chunk(int d, int c) { return d == 0 ? c : (c < 2 ? 1 - c : 131 - c); }

__device__ void phase_init(const Params& P, int bid, int nblk, char* smem) {
  const int tid = ltid();
  if (bid == 0 && tid < 2 * DEPTH) P.qctr[tid] = 0u;
  size_t total4 = (size_t)NTOK * 256;
  {
    const size_t st4 = (size_t)nblk * NT;
    auto srcp = [&](size_t i) -> const float4* {
      int r = (int)(i >> 8), c4 = (int)(i & 255);
      int b = r / TOK, t = r % TOK;
      const float4* src = (t < CTX) ? (const float4*)(P.ctx + ((size_t)(b * CTX + t)) * DM)
                                    : (const float4*)(P.x + ((size_t)(b * SEQ + t - CTX)) * DM);
      return src + c4;
    };
    for (size_t i0 = (size_t)bid * NT + tid; i0 < total4; i0 += st4 * 4) {
      const size_t i1 = i0 + st4, i2 = i0 + 2 * st4, i3 = i0 + 3 * st4;
      const float4 v0 = *srcp(i0);
      const float4 v1 = *srcp(i1 < total4 ? i1 : i0);
      const float4 v2 = *srcp(i2 < total4 ? i2 : i0);
      const float4 v3 = *srcp(i3 < total4 ? i3 : i0);
      ((float4*)P.xres)[i0] = v0;
      if (i1 < total4) ((float4*)P.xres)[i1] = v1;
      if (i2 < total4) ((float4*)P.xres)[i2] = v2;
      if (i3 < total4) ((float4*)P.xres)[i3] = v3;
    }
  }
  float* sv = (float*)smem;
  float* red = sv + 3072;
  for (int i = tid; i < 3072; i += NT) {
    int row = i >> 10, k = i & 1023;
    float v = (row < 2) ? P.c[row * DM + k] : P.c_ctx[k];
    sv[i] = v / (1.f + __expf(-v));
  }
  __syncthreads();
  for (int item = bid; item < 4 * 96; item += nblk) {
    int l = item / 96, cgp = item % 96;
    int jj = tid & 63, kq = tid >> 6;
    int col = cgp * 64 + jj;
    const float* w = P.ada_w + (size_t)l * DM * 6144 + col;
    float a0 = 0, a1 = 0, a2 = 0;
    for (int k = kq * 128; k < kq * 128 + 128; ++k) {
      float wv = w[(size_t)k * 6144];
      a0 += sv[k] * wv; a1 += sv[1024 + k] * wv; a2 += sv[2048 + k] * wv;
    }
    red[(kq * 3 + 0) * 64 + jj] = a0; red[(kq * 3 + 1) * 64 + jj] = a1; red[(kq * 3 + 2) * 64 + jj] = a2;
    __syncthreads();
    if (tid < 192) {
      int row = tid >> 6;
      float s = P.ada_b[l * 6144 + col];
#pragma unroll
      for (int q = 0; q < 8; ++q) s += red[(q * 3 + row) * 64 + jj];
      P.mod[(l * 3 + row) * 6144 + col] = s;
    }
    __syncthreads();
  }
}

__device__ void conv_tile(const float* __restrict__ W, int Nsrc, int K, ushort_t* Wt, int kt, int nt, int Nvalid, float* tile) {
  const int tid = ltid();
  {
    float4 v[2];
#pragma unroll
    for (int p = 0; p < 2; ++p) {
      int kk = p * 32 + (tid >> 4), nn = (tid & 15) * 4;
      int n = nt * 64 + nn;
      v[p] = make_float4(0, 0, 0, 0);
      if (n < Nvalid) v[p] = *(const float4*)(W + (size_t)(kt * 64 + kk) * Nsrc + n);
    }
#pragma unroll
    for (int p = 0; p < 2; ++p) {
      int kk = p * 32 + (tid >> 4), nn = (tid & 15) * 4;
      tile[kk * 65 + nn + 0] = v[p].x; tile[kk * 65 + nn + 1] = v[p].y; tile[kk * 65 + nn + 2] = v[p].z; tile[kk * 65 + nn + 3] = v[p].w;
    }
  }
  __syncthreads();
#pragma unroll
  for (int p = 0; p < 2; ++p) {
    int nn = p * 32 + (tid >> 4), kk = (tid & 15) * 4;
    uint2 o;
    o.x = pack2(tile[(kk + 0) * 65 + nn], tile[(kk + 1) * 65 + nn]);
    o.y = pack2(tile[(kk + 2) * 65 + nn], tile[(kk + 3) * 65 + nn]);
    *(uint2*)(Wt + (size_t)(nt * 64 + nn) * K + kt * 64 + kk) = o;
  }
  __syncthreads();
}
__device__ void phase_convw(const Params& P, int l, int bid, int nblk, char* smem) {
  float* tile = (float*)smem;
  const int n0 = 16 * 48, n1 = n0 + 256, n2 = n1 + 1024, n3 = n2 + 1024, n4 = n3 + 16;
  for (int it = bid; it < n4; it += nblk) {
    if (it < n0) conv_tile(P.w_in + (size_t)l * DM * IND, IND, DM, P.wt_in, it / 48, it % 48, IND, tile);
    else if (it < n1) { int i = it - n0; conv_tile(P.w_out + (size_t)l * DM * DM, DM, DM, P.wt_out, i / 16, i % 16, DM, tile); }
    else if (it < n2) { int i = it - n1; conv_tile(P.mlp_w1 + (size_t)l * DM * DFF, DFF, DM, P.w1t, i / 64, i % 64, DFF, tile); }
    else if (it < n3) { int i = it - n2; conv_tile(P.mlp_w2 + (size_t)l * DFF * DM, DM, DFF, P.w2t, i / 16, i % 16, DM, tile); }
    else { int i = it - n3; conv_tile(P.s5_glu_w + (size_t)l * 256 * 256, 256, 256, P.glut, i / 4, i % 4, 256, tile); }
  }
}

__device__ void phase_norm(const Params& P, int l, int which, int bid, int nblk) {
  const int wid = ltid() >> 6, lane = ltid() & 63;
  const float* g = (which == 0 ? P.norm1_g : P.norm2_g) + l * DM;
  const int shoff = which == 0 ? 0 : 3072, scoff = shoff + 1024;
  float4 gg[4];
#pragma unroll
  for (int i = 0; i < 4; ++i) gg[i] = *(const float4*)(g + (lane + 64 * i) * 4);
  const int nw = nblk * NW;
  for (int r0 = bid * NW + wid; r0 < NTOK; r0 += 2 * nw) {
    const int r1 = r0 + nw;
    const bool has1 = r1 < NTOK;
    const int rr1 = has1 ? r1 : r0;
    const int m0 = ((r0 % TOK) < CTX) ? 2 : r0 / TOK, m1 = ((rr1 % TOK) < CTX) ? 2 : rr1 / TOK;
    const float* md0 = P.mod + (l * 3 + m0) * 6144;
    const float* md1 = P.mod + (l * 3 + m1) * 6144;
    float4 v0[4], v1[4], sc0[4], sh0[4], sc1[4], sh1[4];
#pragma unroll
    for (int i = 0; i < 4; ++i) {
      v0[i] = ((const float4*)(P.xres + (size_t)r0 * DM))[lane + 64 * i];
      v1[i] = ((const float4*)(P.xres + (size_t)rr1 * DM))[lane + 64 * i];
      sc0[i] = *(const float4*)(md0 + scoff + (lane + 64 * i) * 4); sh0[i] = *(const float4*)(md0 + shoff + (lane + 64 * i) * 4);
      sc1[i] = *(const float4*)(md1 + scoff + (lane + 64 * i) * 4); sh1[i] = *(const float4*)(md1 + shoff + (lane + 64 * i) * 4);
    }
    float s0 = 0.f, s1 = 0.f;
#pragma unroll
    for (int i = 0; i < 4; ++i) {
      s0 += v0[i].x * v0[i].x + v0[i].y * v0[i].y + v0[i].z * v0[i].z + v0[i].w * v0[i].w;
      s1 += v1[i].x * v1[i].x + v1[i].y * v1[i].y + v1[i].z * v1[i].z + v1[i].w * v1[i].w;
    }
    s0 = wave_sum(s0); s1 = wave_sum(s1);
    const float rs0 = rsqrtf(s0 * (1.f / DM) + 1e-6f), rs1 = rsqrtf(s1 * (1.f / DM) + 1e-6f);
#pragma unroll
    for (int i = 0; i < 4; ++i) {
      const int col = (lane + 64 * i) * 4;
      uint2 o;
      o.x = pack2(v0[i].x * rs0 * gg[i].x * (1.f + sc0[i].x) + sh0[i].x, v0[i].y * rs0 * gg[i].y * (1.f + sc0[i].y) + sh0[i].y);
      o.y = pack2(v0[i].z * rs0 * gg[i].z * (1.f + sc0[i].z) + sh0[i].z, v0[i].w * rs0 * gg[i].w * (1.f + sc0[i].w) + sh0[i].w);
      *(uint2*)(P.h + (size_t)r0 * DM + col) = o;
      if (has1) {
        o.x = pack2(v1[i].x * rs1 * gg[i].x * (1.f + sc1[i].x) + sh1[i].x, v1[i].y * rs1 * gg[i].y * (1.f + sc1[i].y) + sh1[i].y);
        o.y = pack2(v1[i].z * rs1 * gg[i].z * (1.f + sc1[i].z) + sh1[i].z, v1[i].w * rs1 * gg[i].w * (1.f + sc1[i].w) + sh1[i].w);
        *(uint2*)(P.h + (size_t)r1 * DM + col) = o;
      }
    }
  }
}

namespace pg8 {
#define PG8_LAS __attribute__((address_space(3)))
typedef unsigned short bf16_t;
typedef ::bf16x8 bf16x8;
typedef ::f32x4 f32x4;
typedef unsigned u32x4 __attribute__((ext_vector_type(4)));
constexpr int BM = 256, BK = 64, HALF = 128, HTB = HALF * BK * 2  , STAGE_BYTES = 8 * HTB, NXCD = 8, WGM = 8;

__host__ __device__ __forceinline__ int lds_byte(int r, int c) { const int st = (r >> 4) * 2 + (c >> 5), rr = r & 15, cc = c & 31, ob = rr * 64 + cc * 2; return st * 1024 + (ob ^ (((ob >> 9) & 1) << 5)); }
__host__ __device__ __forceinline__ void stage_rc(int b, int& R, int& C) { const int st = b / 1024, sb = b % 1024, swz = sb ^ (((sb >> 9) & 1) << 5); R = (st >> 1) * 16 + swz / 64; C = (st & 1) * 32 + (swz % 64) / 2; }
__host__ __device__ __forceinline__ int perm32(int rho) { const int n = rho >> 4, i = rho & 15; return 8 * (i >> 2) + 4 * n + (i & 3); }

struct Unit { int pm, pn; int koff; };
struct Gemm { const bf16_t* A; const bf16_t* Bt; int M, N, K, ld; };
struct StaticOrder {
    int nM, nN, nwg, G, c;
    __host__ __device__ void init(int M, int N, int G_, int c_) { nM = M / BM; nN = N / BM; nwg = nM * nN; G = G_; c = c_; }
    __host__ __device__ bool next(int i, Unit& u) const {
        const long L = (long)i * G + c; if (L >= nwg) return false;
        int wgid = (int)L; { const int q = nwg / NXCD, r = nwg % NXCD, xcd = wgid % NXCD, off = wgid / NXCD; wgid = (xcd < r ? xcd * (q + 1) : r * (q + 1) + (xcd - r) * q) + off; }
        const int nig = WGM * nN, gid = wgid / nig, fm = gid * WGM, gsz = (nM - fm) < WGM ? (nM - fm) : WGM;
        u.pm = fm + ((wgid % nig) % gsz); u.pn = (wgid % nig) / gsz; u.koff = 0; return true;
    }
    __device__ __forceinline__ void a_ready(const Unit&) const {}
    __device__ __forceinline__ void done(const Unit&) const {}
};
template <class Epi, class Sched, bool STAMP = false>
__device__ __forceinline__ void gemm_phase(PG8_LAS unsigned char* lds, const Gemm g, const Sched& S, const Epi& E, unsigned long long* stamps) {
    const int tid = ltid(), wid = __builtin_amdgcn_readfirstlane(tid >> 6), lane = tid & 63, wr = wid >> 2, wc = wid & 3, fr = lane & 15, fq = lane >> 4;
    const int K = g.ld, nt = g.K / BK;
    int ts_lo = 0, ts_hi = 0, nts = 0; const unsigned long long rt_entry = STAMP ? (unsigned long long)wall_clock64() : 0ull;
#define PG8_STAMP() do { if (STAMP && wid == 0 && nts < 64) { const unsigned long long _c = (unsigned long long)clock64(); \
        ts_lo = (lane == nts) ? (int)(unsigned)_c : ts_lo; ts_hi = (lane == nts) ? (int)(unsigned)(_c >> 32) : ts_hi; ++nts; } } while (0)
    PG8_STAMP();
    unsigned voffA[2], voffB[2];
#pragma unroll
    for (int i = 0; i < 2; ++i) { int R, C; stage_rc(tid * 16 + i * 8192, R, C); const int Rb = Epi::PERM ? ((R & ~31) + perm32(R & 31)) : R;
        voffA[i] = (unsigned)(R * K + C) * 2u; voffB[i] = (unsigned)(Rb * K + C) * 2u; }
    const size_t kstep = (size_t)(BK * 2);
    const size_t hstep = (size_t)HALF * K * 2;
    const size_t tstep = 2 * hstep;
    const unsigned ldsw = (unsigned)wid * 1024u;
    const int aoff = lds_byte(wr * 64 + fr, fq * 8), boff = lds_byte(wc * 32 + fr, fq * 8);
#define PG8_SA(b, h) (((b) * 2 + (h)) * HTB)
#define PG8_SB(b, h) ((4 + (b) * 2 + (h)) * HTB)
#define PG8_STAGE(bufoff, gbase, voff) do { _Pragma("unroll") for (int _i = 0; _i < 2; ++_i) \
        __builtin_amdgcn_global_load_lds((const unsigned*)((const char*)(gbase) + (voff)[_i]), (PG8_LAS unsigned*)(lds + (bufoff) + ldsw + _i * 8192), 16, 0, 0); } while (0)
#define PG8_LDA(dst, b, h) do { _Pragma("unroll") for (int m = 0; m < 4; ++m) _Pragma("unroll") for (int k = 0; k < 2; ++k) dst[m][k] = *(const PG8_LAS bf16x8*)(lds + PG8_SA(b, h) + aoff + m * 2048 + k * 1024); } while (0)
#define PG8_LDB(dst, b, h) do { _Pragma("unroll") for (int n = 0; n < 2; ++n) _Pragma("unroll") for (int k = 0; k < 2; ++k) dst[n][k] = *(const PG8_LAS bf16x8*)(lds + PG8_SB(b, h) + boff + n * 2048 + k * 1024); } while (0)
#define PG8_MMA(ai, bj, At, Bt) do { __builtin_amdgcn_s_setprio(1); _Pragma("unroll") for (int m = 0; m < 4; ++m) _Pragma("unroll") for (int n = 0; n < 2; ++n) _Pragma("unroll") for (int k = 0; k < 2; ++k) \
        acc[ai][bj][m][n] = __builtin_amdgcn_mfma_f32_16x16x32_bf16(Bt[n][k], At[m][k], acc[ai][bj][m][n], 0, 0, 0); __builtin_amdgcn_s_setprio(0); } while (0)
#define PG8_WAIT_V(n) asm volatile("s_waitcnt vmcnt(" #n ")" ::: "memory")
#define PG8_WAIT_L(n) asm volatile("s_waitcnt lgkmcnt(" #n ")" ::: "memory")
#define PG8_BAR __builtin_amdgcn_s_barrier()
#define PG8_SCHED __builtin_amdgcn_sched_barrier(0)
    Unit cur, nxt; int ui = 0;
    if (!S.next(0, cur)) return;
    f32x4 acc[2][2][4][2];
#pragma unroll
    for (int a = 0; a < 2; ++a)
#pragma unroll
        for (int b = 0; b < 2; ++b)
#pragma unroll
            for (int m = 0; m < 4; ++m)
#pragma unroll
                for (int n = 0; n < 2; ++n) acc[a][b][m][n] = (f32x4){0.f, 0.f, 0.f, 0.f};
    bf16x8 At[4][2], B0[2][2], B1[2][2];
    const char* cA = (const char*)g.A + (size_t)cur.pm * tstep + cur.koff; const char* cB = (const char*)g.Bt + (size_t)cur.pn * tstep + cur.koff;
    S.a_ready(cur);
    PG8_STAGE(PG8_SB(0, 0), cB, voffB); PG8_STAGE(PG8_SA(0, 0), cA, voffA); PG8_STAGE(PG8_SB(0, 1), cB + hstep, voffB); PG8_STAGE(PG8_SA(0, 1), cA + hstep, voffA);
    if (wr == 1) PG8_BAR;
    PG8_WAIT_V(4); PG8_BAR;
    PG8_STAGE(PG8_SB(1, 0), cB + kstep, voffB); PG8_STAGE(PG8_SA(1, 0), cA + kstep, voffA); PG8_STAGE(PG8_SB(1, 1), cB + hstep + kstep, voffB);
    PG8_WAIT_V(6); PG8_BAR;
    PG8_STAMP();
    for (;;) {
        const bool has_next = S.next(ui + 1, nxt);
        const char* nA = has_next ? (const char*)g.A + (size_t)nxt.pm * tstep + nxt.koff : cA; const char* nB = has_next ? (const char*)g.Bt + (size_t)nxt.pn * tstep + nxt.koff : cB;
        for (int t = 0; t < nt; t += 2) {
            const bool last = (t == nt - 2);
            const char* a1 = cA + (size_t)(t + 1) * kstep;
            const char* a2 = last ? nA : cA + (size_t)(t + 2) * kstep; const char* b2 = last ? nB : cB + (size_t)(t + 2) * kstep;
            const char* a3 = a2 + kstep; const char* b3 = b2 + kstep;
            if (last && has_next) S.a_ready(nxt);
            PG8_LDB(B0, 0, 0); PG8_SCHED; PG8_LDA(At, 0, 0); PG8_STAGE(PG8_SA(1, 1), a1 + hstep, voffA);
            PG8_WAIT_L(8); PG8_BAR; PG8_WAIT_L(0); PG8_MMA(0, 0, At, B0); PG8_BAR; PG8_SCHED;
            PG8_LDB(B1, 0, 1); PG8_STAGE(PG8_SB(0, 0), b2, voffB);
            PG8_BAR; PG8_WAIT_L(0); PG8_MMA(0, 1, At, B1); PG8_BAR;
            PG8_LDA(At, 0, 1); PG8_STAGE(PG8_SA(0, 0), a2, voffA);
            PG8_BAR; PG8_WAIT_L(0); PG8_MMA(1, 0, At, B0); PG8_BAR; PG8_SCHED;
            PG8_STAGE(PG8_SB(0, 1), b2 + hstep, voffB);
            PG8_WAIT_V(6); PG8_BAR; PG8_MMA(1, 1, At, B1); PG8_BAR;
            PG8_LDB(B0, 1, 0); PG8_SCHED; PG8_LDA(At, 1, 0); PG8_STAGE(PG8_SA(0, 1), a2 + hstep, voffA);
            PG8_WAIT_L(8); PG8_BAR; PG8_WAIT_L(0); PG8_MMA(0, 0, At, B0); PG8_BAR; PG8_SCHED;
            PG8_LDB(B1, 1, 1); PG8_STAGE(PG8_SB(1, 0), b3, voffB);
            PG8_BAR; PG8_WAIT_L(0); PG8_MMA(0, 1, At, B1); PG8_BAR;
            PG8_LDA(At, 1, 1); PG8_STAGE(PG8_SA(1, 0), a3, voffA);
            PG8_BAR; PG8_WAIT_L(0); PG8_MMA(1, 0, At, B0); PG8_BAR; PG8_SCHED;
            PG8_STAGE(PG8_SB(1, 1), b3 + hstep, voffB);
            PG8_WAIT_V(6); PG8_BAR; PG8_MMA(1, 1, At, B1); PG8_BAR;
        }
        PG8_STAMP();
        if constexpr (!Epi::AFTER_DRAIN) { E(acc, cur, wr, wc, fr, fq); S.done(cur); }
        PG8_STAMP();
        if (!has_next) break;
#pragma unroll
        for (int a = 0; a < 2; ++a)
#pragma unroll
            for (int b = 0; b < 2; ++b)
#pragma unroll
                for (int m = 0; m < 4; ++m)
#pragma unroll
                    for (int n = 0; n < 2; ++n) acc[a][b][m][n] = (f32x4){0.f, 0.f, 0.f, 0.f};
        cur = nxt; cA = nA; cB = nB; ++ui;
    }
    PG8_WAIT_V(0);
    if (wr == 0) PG8_BAR;
    PG8_BAR;
    if constexpr (Epi::AFTER_DRAIN) { E.fused(acc, cur, wr, wc, fr, fq, lds, wid, lane); S.done(cur); }
    PG8_STAMP();
    if (STAMP && wid == 0) { stamps[lane] = lane < nts ? (((unsigned long long)(unsigned)ts_hi << 32) | (unsigned)ts_lo) : 0ull;
        if (lane == 62) stamps[62] = rt_entry; if (lane == 63) stamps[63] = (unsigned long long)wall_clock64(); }
#undef PG8_STAMP
#undef PG8_SA
#undef PG8_SB
#undef PG8_STAGE
#undef PG8_LDA
#undef PG8_LDB
#undef PG8_MMA
#undef PG8_WAIT_V
#undef PG8_WAIT_L
#undef PG8_BAR
#undef PG8_SCHED
}
}

struct EpiZin {
  static constexpr bool PERM = true, AFTER_DRAIN = false;
  ushort_t* z; float* gates;
  __device__ __forceinline__ void operator()(const pg8::f32x4 (&acc)[2][2][4][2], const pg8::Unit& u, int wr, int wc, int fr, int fq) const {
    asm volatile("" : "+v"(fr), "+v"(fq));
    const int row0 = u.pm * 256 + wr * 64 + fr, col0 = u.pn * 256 + wc * 32 + 8 * fq;
#pragma unroll
    for (int ai = 0; ai < 2; ++ai)
#pragma unroll
      for (int m = 0; m < 4; ++m) {
        const size_t row = (size_t)(row0 + ai * 128 + m * 16);
#pragma unroll
        for (int bj = 0; bj < 2; ++bj) {
          const int col = col0 + bj * 128;
          if (col < IND) {
            const pg8::f32x4 v0 = acc[ai][bj][m][0], v1 = acc[ai][bj][m][1];
            *(uint4*)(z + row * IND + col) = make_uint4(pack2(v0[0], v0[1]), pack2(v0[2], v0[3]), pack2(v1[0], v1[1]), pack2(v1[2], v1[3]));
            if (col >= ZC_MLG && col < ZC_MLG + 16) {
              float* gp = gates + row * 48 + (col - ZC_MLG);
              *(float4*)gp = make_float4(v0[0], v0[1], v0[2], v0[3]); *(float4*)(gp + 4) = make_float4(v1[0], v1[1], v1[2], v1[3]);
            } else if (col >= ZC_GLA) {
              float* gp = gates + row * 48 + 16 + (col - ZC_GLA);
              *(float4*)gp = make_float4(v0[0], v0[1], v0[2], v0[3]); *(float4*)(gp + 4) = make_float4(v1[0], v1[1], v1[2], v1[3]);
            }
          }
        }
      }
  }
};
struct EpiGlu {
  static constexpr bool PERM = true, AFTER_DRAIN = false;
  const ushort_t* s5g; const float* bias; ushort_t* mix;
  __device__ __forceinline__ void operator()(const pg8::f32x4 (&acc)[2][2][4][2], const pg8::Unit& u, int wr, int wc, int fr, int fq) const {
    asm volatile("" : "+v"(fr), "+v"(fq));
    const int row0 = u.pm * 256 + wr * 64 + fr, col0 = wc * 32 + 8 * fq;
    float4 bz[2][2];
#pragma unroll
    for (int bj = 0; bj < 2; ++bj) { bz[bj][0] = *(const float4*)(bias + col0 + bj * 128); bz[bj][1] = *(const float4*)(bias + col0 + bj * 128 + 4); }
#pragma unroll
    for (int ai = 0; ai < 2; ++ai) {
      uint4 gx[4][2];
#pragma unroll
      for (int m = 0; m < 4; ++m)
#pragma unroll
        for (int bj = 0; bj < 2; ++bj) gx[m][bj] = *(const uint4*)(s5g + (size_t)(row0 + ai * 128 + m * 16) * 256 + col0 + bj * 128);
#pragma unroll
      for (int m = 0; m < 4; ++m) {
        const size_t row = (size_t)(row0 + ai * 128 + m * 16);
#pragma unroll
        for (int bj = 0; bj < 2; ++bj) {
          const int col = col0 + bj * 128;
          float g[8], o[8];
          unpack8(gx[m][bj], g);
          const float4 b0 = bz[bj][0], b1 = bz[bj][1];
          const pg8::f32x4 v0 = acc[ai][bj][m][0], v1 = acc[ai][bj][m][1];
          o[0] = g[0] * sigmoidf_(v0[0] + b0.x); o[1] = g[1] * sigmoidf_(v0[1] + b0.y); o[2] = g[2] * sigmoidf_(v0[2] + b0.z); o[3] = g[3] * sigmoidf_(v0[3] + b0.w);
          o[4] = g[4] * sigmoidf_(v1[0] + b1.x); o[5] = g[5] * sigmoidf_(v1[1] + b1.y); o[6] = g[6] * sigmoidf_(v1[2] + b1.z); o[7] = g[7] * sigmoidf_(v1[3] + b1.w);
          *(uint4*)(mix + row * DM + col) = make_uint4(pack2(o[0], o[1]), pack2(o[2], o[3]), pack2(o[4], o[5]), pack2(o[6], o[7]));
        }
      }
    }
  }
};
struct EpiW1 {
  static constexpr bool PERM = true, AFTER_DRAIN = false;
  ushort_t* hidden;
  __device__ __forceinline__ void operator()(const pg8::f32x4 (&acc)[2][2][4][2], const pg8::Unit& u, int wr, int wc, int fr, int fq) const {
    asm volatile("" : "+v"(fr), "+v"(fq));
    const int row0 = u.pm * 256 + wr * 64 + fr, col0 = u.pn * 256 + wc * 32 + 8 * fq;
#pragma unroll
    for (int ai = 0; ai < 2; ++ai)
#pragma unroll
      for (int m = 0; m < 4; ++m) {
        const size_t row = (size_t)(row0 + ai * 128 + m * 16);
#pragma unroll
        for (int bj = 0; bj < 2; ++bj) {
          float o[8];
#pragma unroll
          for (int e = 0; e < 4; ++e) { float a = fmaxf(acc[ai][bj][m][0][e], 0.f), c = fmaxf(acc[ai][bj][m][1][e], 0.f); o[e] = a * a; o[4 + e] = c * c; }
          *(uint4*)(hidden + row * DFF + col0 + bj * 128) = make_uint4(pack2(o[0], o[1]), pack2(o[2], o[3]), pack2(o[4], o[5]), pack2(o[6], o[7]));
        }
      }
  }
};
template <bool ATOMIC>
struct EpiRes {
  static constexpr bool PERM = false, AFTER_DRAIN = false;
  float* xres; const float* gate;
  __device__ __forceinline__ void operator()(const pg8::f32x4 (&acc)[2][2][4][2], const pg8::Unit& u, int wr, int wc, int fr, int fq) const {
    asm volatile("" : "+v"(fr), "+v"(fq));
    const int row0 = u.pm * 256 + wr * 64 + fr, col0 = u.pn * 256 + wc * 32 + 4 * fq;
#pragma unroll
    for (int am = 0; am < 4; ++am) {
      const int ai = am >> 1;
      float4 gv[2][4], xv[2][4];
#pragma unroll
      for (int mm = 0; mm < 2; ++mm) {
        const int m = (am & 1) * 2 + mm;
        const int row = row0 + ai * 128 + m * 16;
        const int b = row / TOK, t = row % TOK;
        const float* gr = gate + ((t < CTX) ? 2 : b) * 6144;
        const float* xp = xres + (size_t)row * DM;
#pragma unroll
        for (int q = 0; q < 4; ++q) {
          const int col = col0 + (q >> 1) * 128 + (q & 1) * 16;
          gv[mm][q] = *(const float4*)(gr + col);
          if (!ATOMIC) xv[mm][q] = *(const float4*)(xp + col);
        }
      }
#pragma unroll
      for (int mm = 0; mm < 2; ++mm) {
        const int m = (am & 1) * 2 + mm;
        const int row = row0 + ai * 128 + m * 16;
        float* xp = xres + (size_t)row * DM;
#pragma unroll
        for (int q = 0; q < 4; ++q) {
          const int col = col0 + (q >> 1) * 128 + (q & 1) * 16;
          const pg8::f32x4 v = acc[ai][q >> 1][m][q & 1];
          const float4 g4 = gv[mm][q];
          if (ATOMIC) {
            atomicAdd(xp + col, g4.x * v[0]); atomicAdd(xp + col + 1, g4.y * v[1]); atomicAdd(xp + col + 2, g4.z * v[2]); atomicAdd(xp + col + 3, g4.w * v[3]);
          } else {
            float4 x = xv[mm][q];
            x.x += g4.x * v[0]; x.y += g4.y * v[1]; x.z += g4.z * v[2]; x.w += g4.w * v[3];
            *(float4*)(xp + col) = x;
          }
        }
      }
    }
  }
};
struct TailOrder {
  int first, nN, nun, nsplit, kbytes, c;
  __device__ bool next(int i, pg8::Unit& u) const {
    if (i > 0 || c >= nun * nsplit) return false;
    const int t = first + c / nsplit;
    u.pm = t / nN; u.pn = t % nN; u.koff = (c % nsplit) * kbytes; return true;
  }
  __device__ __forceinline__ void a_ready(const pg8::Unit&) const {}
  __device__ __forceinline__ void done(const pg8::Unit&) const {}
};
struct RowOrder {
  int nN, ntile, G, c;
  __device__ bool next(int i, pg8::Unit& u) const {
    const int t = i * G + c;
    if (t >= ntile) return false;
    u.pm = t / nN; u.pn = t % nN; u.koff = 0; return true;
  }
  __device__ __forceinline__ void a_ready(const pg8::Unit&) const {}
  __device__ __forceinline__ void done(const pg8::Unit&) const {}
};
enum { G_ZIN = 0, G_GLU = 1, G_WOUT = 2, G_W1 = 3, G_W2 = 4 };
template <int MODE>
__device__ void gemm_phase(const Params& P, int l, int bid, int nblk, char* smem) {
  PG8_LAS unsigned char* lds = (PG8_LAS unsigned char*)smem;
  __syncthreads();
  if (MODE == G_ZIN) {
    pg8::Gemm g{P.h, P.wt_in, NTOK, INDP, DM, DM};
    pg8::StaticOrder S; S.init(NTOK, INDP, nblk, bid);
    EpiZin E{P.z, P.gates};
    pg8::gemm_phase<EpiZin, pg8::StaticOrder, false>(lds, g, S, E, nullptr);
  } else if (MODE == G_GLU) {
    const int kg = launder_s(256);
    pg8::Gemm g{P.s5g, P.glut, NTOK, 256, kg, kg};
    pg8::StaticOrder S; S.init(NTOK, 256, nblk, bid);
    EpiGlu E{P.s5g, P.s5_glu_b + l * 256, P.mix};
    pg8::gemm_phase<EpiGlu, pg8::StaticOrder, false>(lds, g, S, E, nullptr);
  } else if (MODE == G_W1) {
    pg8::Gemm g{P.h, P.w1t, NTOK, DFF, DM, DM};
    pg8::StaticOrder S; S.init(NTOK, DFF, nblk, bid);
    EpiW1 E{P.hidden};
    pg8::gemm_phase<EpiW1, pg8::StaticOrder, false>(lds, g, S, E, nullptr);
  } else {
    const ushort_t* A = MODE == G_WOUT ? P.mix : P.hidden;
    const ushort_t* Bt = MODE == G_WOUT ? P.wt_out : P.w2t;
    const int K = MODE == G_WOUT ? DM : DFF;
    const float* gate = P.mod + (size_t)l * 3 * 6144 + (MODE == G_WOUT ? 2048 : 5120);
    const int ntile = (NTOK / 256) * 4;
    const int nfull = (ntile / nblk) * nblk;
    {
      pg8::Gemm g{A, Bt, NTOK, DM, K, K};
      RowOrder S{4, nfull, nblk, bid};
      EpiRes<false> E{P.xres, gate};
      pg8::gemm_phase<EpiRes<false>, RowOrder, false>(lds, g, S, E, nullptr);
    }
    if (nfull < ntile) {
      const int nun = ntile - nfull;
      int nsplit = nblk / nun; if (nsplit > K / 256) nsplit = K / 256; if (nsplit < 1) nsplit = 1;
      while ((K / 256) % nsplit) --nsplit;
      const int ks = K / nsplit;
      __syncthreads();
      pg8::Gemm g{A, Bt, NTOK, DM, ks, K};
      TailOrder S{nfull, 4, nun, nsplit, ks * 2, bid};
      EpiRes<true> E{P.xres, gate};
      pg8::gemm_phase<EpiRes<true>, TailOrder, false>(lds, g, S, E, nullptr);
    }
  }
  __syncthreads();
}

__device__ void s5_build_tab(const Params& P, int l, int dg, int lane);
__device__ void phase_prep(const Params& P, int l, int bid, int nblk, bool skip_rope = false) {
  {
    const int gw = bid * NW + (ltid() >> 6);
    if (gw < 32) s5_build_tab(P, l, gw, ltid() & 63);
  }
  const size_t gtid = (size_t)bid * NT + ltid(), gstride = (size_t)nblk * NT;
  const int cg = (int)(gtid & 63);
  const size_t nit = (size_t)NTOK * 64;
  {
    const int c = cg * 8;
    const float* cwp = P.ml_conv_w + (size_t)l * 3 * 512 + c;
    float w0[8], w1[8], w2[8], cb[8];
#pragma unroll
    for (int e = 0; e < 8; ++e) { w0[e] = cwp[e]; w1[e] = cwp[512 + e]; w2[e] = cwp[1024 + e]; cb[e] = P.ml_conv_b[l * 512 + c + e]; }
    const float sc = (c >= 256) ? 0.125f : 1.f;
    for (size_t idx0 = gtid; idx0 < nit; idx0 += 2 * gstride) {
      uint4 x0[2], xm[2], xp[2];
      bool hp[2], hn[2], ok[2];
      int rr[2];
#pragma unroll
      for (int q = 0; q < 2; ++q) {
        const size_t idx = idx0 + q * gstride;
        ok[q] = idx < nit;
        const int r = ok[q] ? (int)(idx >> 6) : (int)(idx0 >> 6);
        rr[q] = r;
        const int t = r % TOK;
        hp[q] = (t != 0 && t != CTX); hn[q] = (t != CTX - 1 && t != TOK - 1);
        x0[q] = *(const uint4*)(P.z + (size_t)r * IND + ZC_MLQ + c);
        xm[q] = *(const uint4*)(P.z + (size_t)(hp[q] ? r - 1 : r) * IND + ZC_MLQ + c);
        xp[q] = *(const uint4*)(P.z + (size_t)(hn[q] ? r + 1 : r) * IND + ZC_MLQ + c);
      }
#pragma unroll
      for (int q = 0; q < 2; ++q) {
        float a0[8], am[8], ap[8], o[8];
        unpack8(x0[q], a0); unpack8(xm[q], am); unpack8(xp[q], ap);
#pragma unroll
        for (int e = 0; e < 8; ++e) {
          float y = w1[e] * a0[e] + cb[e];
          if (hp[q]) y += w0[e] * am[e];
          if (hn[q]) y += w2[e] * ap[e];
          o[e] = y * sigmoidf_(y) * sc;
        }
        if (ok[q]) *(uint4*)(P.mlqk + (size_t)rr[q] * 512 + c) = make_uint4(pack2(o[0], o[1]), pack2(o[2], o[3]), pack2(o[4], o[5]), pack2(o[6], o[7]));
      }
    }
  }
  {
    const int dk = cg * 4, d = dk >> 7, kk = dk & 127;
    const float* W = P.gla_alpha_w + ((size_t)(l * 2 + d) * 16) * 128 + kk;
    float4 wr[16];
#pragma unroll
    for (int q = 0; q < 16; ++q) wr[q] = *(const float4*)(W + q * 128);
    const float4 bias = *(const float4*)(P.gla_alpha_b + (l * 2 + d) * 128 + kk);
    for (size_t idx0 = gtid; idx0 < nit; idx0 += 2 * gstride) {
      float4 ga[2][4];
      bool ok[2];
      int rr[2];
#pragma unroll
      for (int q = 0; q < 2; ++q) {
        const size_t idx = idx0 + q * gstride;
        ok[q] = idx < nit;
        rr[q] = ok[q] ? (int)(idx >> 6) : (int)(idx0 >> 6);
        const float4* a4 = (const float4*)(P.gates + (size_t)rr[q] * 48 + 16 + d * 16);
#pragma unroll
        for (int e = 0; e < 4; ++e) ga[q][e] = a4[e];
      }
#pragma unroll
      for (int q = 0; q < 2; ++q) {
        float4 v = bias;
#pragma unroll
        for (int e = 0; e < 4; ++e) {
          const float av[4] = {ga[q][e].x, ga[q][e].y, ga[q][e].z, ga[q][e].w};
#pragma unroll
          for (int f = 0; f < 4; ++f) {
            const float4 w = wr[e * 4 + f];
            v.x += av[f] * w.x; v.y += av[f] * w.y; v.z += av[f] * w.z; v.w += av[f] * w.w;
          }
        }
        float4 o;
        o.x = __expf(logsigmoidf_(v.x) * (1.f / 16.f)); o.y = __expf(logsigmoidf_(v.y) * (1.f / 16.f));
        o.z = __expf(logsigmoidf_(v.z) * (1.f / 16.f)); o.w = __expf(logsigmoidf_(v.w) * (1.f / 16.f));
        if (ok[q]) *(float4*)(P.alpha + (size_t)rr[q] * 256 + dk) = o;
      }
    }
  }
  if (skip_rope) return;
  {
    const float qscale = 0.17677669529663687f * 1.4426950408889634f;
    const int which = cg >> 5, hm = (cg >> 2) & 7, quad = cg & 3;
    const int f0 = (quad & 1) * 4;
    float inv[4];
#pragma unroll
    for (int e = 0; e < 4; ++e) {
      const int f = f0 + e;
      inv[e] = f == 0 ? 1.f : f == 1 ? 0.31622776601683794f : f == 2 ? 0.1f : f == 3 ? 0.031622776601683794f
             : f == 4 ? 0.01f : f == 5 ? 0.0031622776601683794f : f == 6 ? 0.001f : 0.00031622776601683794f;
    }
    const int colb = (which ? ZC_DAK : ZC_DAQ) + hm * 32 + quad * 8;
    for (size_t idx0 = gtid; idx0 < nit; idx0 += 2 * gstride) {
      uint4 xv[2];
      bool ok[2];
      int rr[2];
#pragma unroll
      for (int q = 0; q < 2; ++q) {
        const size_t idx = idx0 + q * gstride;
        ok[q] = idx < nit;
        rr[q] = ok[q] ? (int)(idx >> 6) : (int)(idx0 >> 6);
        xv[q] = *(const uint4*)(P.z + (size_t)rr[q] * IND + colb);
      }
#pragma unroll
      for (int q = 0; q < 2; ++q) {
        float x[8];
        unpack8(xv[q], x);
        const int t = rr[q] % TOK;
        if (t >= CTX) {
          const int tl = t - CTX;
          const float posv = (quad < 2) ? (float)(tl >> 6) : (float)(tl & 63);
#pragma unroll
          for (int e = 0; e < 4; ++e) {
            const float ang = posv * inv[e];
            const float cs = __cosf(ang), sn = __sinf(ang);
            const float x1 = x[2 * e], x2 = x[2 * e + 1];
            x[2 * e] = x1 * cs - x2 * sn;
            x[2 * e + 1] = x1 * sn + x2 * cs;
          }
        }
        if (!which) {
#pragma unroll
          for (int e = 0; e < 8; ++e) x[e] *= qscale;
        }
        if (ok[q]) *(uint4*)(P.z + (size_t)rr[q] * IND + colb) = make_uint4(pack2(x[0], x[1]), pack2(x[2], x[3]), pack2(x[4], x[5]), pack2(x[6], x[7]));
      }
    }
  }
}

struct S5Lam { float lbr, lbi; };
__device__ __forceinline__ void s5_disc(const Params& P, int gi, int p, float dt, float& lbr, float& lbi, float& fr_, float& fi_) {
  const int idx = gi * 64 + p;
  const float lre = P.s5_lam_re[idx], lim = P.s5_lam_im[idx];
  const float mag = __expf(lre * dt);
  lbr = mag * __cosf(lim * dt); lbi = mag * __sinf(lim * dt);
  const float den = lre * lre + lim * lim;
  fr_ = ((lbr - 1.f) * lre + lbi * lim) / den;
  fi_ = (lbi * lre - (lbr - 1.f) * lim) / den;
}
__device__ __forceinline__ void s5_bfrags(const Params& P, int l, int d, int g, int lane, bf16x8 (&bfr)[8], S5Lam& lam) {
  const int fr = lane & 15, fq = lane >> 4;
  const int gi = (l * 2 + d) * 16 + g;
  const float dt = __expf(P.s5_log_step[gi]);
  {
    float a, b2;
    s5_disc(P, gi, lane, dt, lam.lbr, lam.lbi, a, b2);
  }
#pragma unroll
  for (int nt = 0; nt < 8; ++nt) {
    const int n = nt * 16 + fr, p = n >> 1, ri = n & 1;
    float lbr, lbi, fr_, fi_;
    s5_disc(P, gi, p, dt, lbr, lbi, fr_, fi_);
    const float* bre = P.s5_b_re + (size_t)(gi * 64 + p) * 16 + (fq & 1) * 8;
    const float* bim = P.s5_b_im + (size_t)(gi * 64 + p) * 16 + (fq & 1) * 8;
#pragma unroll
    for (int e = 0; e < 8; ++e) {
      const float br = bre[e], bi = bim[e];
      float v = ri == 0 ? fr_ * br - fi_ * bi : fr_ * bi + fi_ * br;
      if (fq >= 2) v = 0.f;
      bfr[nt][e] = (short)f2bf(v);
    }
  }
}
__device__ __forceinline__ void s5_cfrags(const Params& P, int l, int d, int g, int lane, bf16x8 (&cb)[4]) {
  const int fr = lane & 15, fq = lane >> 4;
  const float* cre = P.s5_c_re + ((size_t)((l * 2 + d) * 16 + g) * 16 + fr) * 64;
  const float* cim = P.s5_c_im + ((size_t)((l * 2 + d) * 16 + g) * 16 + fr) * 64;
#pragma unroll
  for (int ks = 0; ks < 4; ++ks) {
#pragma unroll
    for (int e = 0; e < 8; ++e) {
      int k = ks * 32 + fq * 8 + e, p = k >> 1;
      float v = (e & 1) ? -cim[p] : cre[p];
      cb[ks][e] = (short)f2bf(v);
    }
  }
}
__device__ void s5_build_tab(const Params& P, int l, int dg, int lane) {
  bf16x8 bfr[8], cb[4];
  S5Lam lam;
  s5_bfrags(P, l, dg >> 4, dg & 15, lane, bfr, lam);
  s5_cfrags(P, l, dg >> 4, dg & 15, lane, cb);
  uint4* t = P.s5tab + (size_t)dg * 13 * 64 + lane;
#pragma unroll
  for (int f = 0; f < 8; ++f) t[f * 64] = __builtin_bit_cast(uint4, bfr[f]);
#pragma unroll
  for (int f = 0; f < 4; ++f) t[(8 + f) * 64] = __builtin_bit_cast(uint4, cb[f]);
  t[12 * 64] = make_uint4(__float_as_uint(lam.lbr), __float_as_uint(lam.lbi), 0u, 0u);
}
__device__ __forceinline__ void s5_load_tab(const Params& P, int d, int g, int lane, bf16x8 (&bfr)[8], S5Lam& lam) {
  const uint4* t = P.s5tab + (size_t)(d * 16 + g) * 13 * 64 + lane;
#pragma unroll
  for (int f = 0; f < 8; ++f) bfr[f] = __builtin_bit_cast(bf16x8, t[f * 64]);
  const uint4 lv = t[12 * 64];
  lam.lbr = __uint_as_float(lv.x); lam.lbi = __uint_as_float(lv.y);
}
__device__ __forceinline__ void s5_load_ctab(const Params& P, int d, int g, int lane, bf16x8 (&cb)[4]) {
  const uint4* t = P.s5tab + (size_t)(d * 16 + g) * 13 * 64 + lane;
#pragma unroll
  for (int f = 0; f < 4; ++f) cb[f] = __builtin_bit_cast(bf16x8, t[(8 + f) * 64]);
}
#define S5_BU_STRIDE 132
__device__ __forceinline__ uint4 s5_load_u(const Params& P, size_t row0, int g, int DIRv, int sbi, int lane) {
  const int fr = lane & 15, fq = lane >> 4;
  const int sp = sbi * 16 + fr;
  const size_t row = row0 + (DIRv == 0 ? sp : 127 - sp);
  uint4 a = make_uint4(0u, 0u, 0u, 0u);
  if (fq < 2) a = *(const uint4*)(P.z + row * IND + ZC_S5U + g * 16 + fq * 8);
  return a;
}
__device__ __forceinline__ void s5_bu_to_lds(const uint4 ua, const bf16x8 (&bfr)[8], float* BuS, int lane) {
  const int fr = lane & 15, fq = lane >> 4;
  const bf16x8 a = __builtin_bit_cast(bf16x8, ua);
#pragma unroll
  for (int nt = 0; nt < 8; ++nt) {
    f32x4 acc = f32x4{0.f, 0.f, 0.f, 0.f};
    acc = __builtin_amdgcn_mfma_f32_16x16x32_bf16(a, bfr[nt], acc, 0, 0, 0);
#pragma unroll
    for (int jx = 0; jx < 4; ++jx) BuS[(fq * 4 + jx) * S5_BU_STRIDE + nt * 16 + fr] = acc[jx];
  }
}
__device__ void unit_s5_p1(const Params& P, int l, int unit, char* smem) {
  const int wid = ltid() >> 6, lane = ltid() & 63;
  float* BuS = (float*)(smem + wid * (16 * S5_BU_STRIDE * 4));
  {
    int item = unit * NW + wid;
    int c = item % NCH, g = (item / NCH) % 16, d = (item / (NCH * 16)) % 2, b = item / (NCH * 32);
    int j = dir_chunk(d, c);
    const size_t row0 = (size_t)(b * TOK + j * 128);
    bf16x8 bfr[8];
    S5Lam lam;
    s5_load_tab(P, d, g, lane, bfr, lam);
    float hr = 0.f, hi = 0.f;
    uint4 ua = s5_load_u(P, row0, g, d, 0, lane);
    for (int sbi = 0; sbi < 8; ++sbi) {
      __syncthreads();
      s5_bu_to_lds(ua, bfr, BuS, lane);
      __syncthreads();
      if (sbi + 1 < 8) ua = s5_load_u(P, row0, g, d, sbi + 1, lane);
      for (int tii = 0; tii < 16; ++tii) {
        const float2 bu = *(const float2*)(BuS + tii * S5_BU_STRIDE + 2 * lane);
        const float nr = lam.lbr * hr - lam.lbi * hi + bu.x;
        const float ni = lam.lbr * hi + lam.lbi * hr + bu.y;
        hr = nr; hi = ni;
      }
    }
    float2* st = (float2*)(P.s5st + (size_t)item * 128);
    st[lane] = make_float2(hr, hi);
  }
}
__device__ void phase_s5_p2(const Params& P, int l, int bid, int nblk) {
  const int wid = ltid() >> 6, lane = ltid() & 63;
  for (int it = ((bid + nblk - 194 % nblk) % nblk) * NW + wid; it < B_ * 2 * 16; it += nblk * NW) {
    int g = it % 16, d = (it / 16) % 2;
    int gi = (l * 2 + d) * 16 + g, idx = gi * 64 + lane;
    float lre = P.s5_lam_re[idx], lim = P.s5_lam_im[idx];
    float dt = __expf(P.s5_log_step[gi]);
    float mag = __expf(lre * dt);
    float ar = mag * __cosf(lim * dt), ai = mag * __sinf(lim * dt);
#pragma unroll
    for (int i = 0; i < 7; ++i) { float nr = ar * ar - ai * ai, t = ar * ai, ni = t + t; ar = nr; ai = ni; }
    float cr, ci;
    asm volatile("v_mov_b32 %0, 0\n\tv_mov_b32 %1, 0" : "=v"(cr), "=v"(ci));
    float2* st = (float2*)(P.s5st + (size_t)it * NCH * 128);
    for (int c0 = 0; c0 < NCH; c0 += 26) {
      float2 x[26];
#pragma unroll
      for (int i = 0; i < 26; ++i) x[i] = st[(c0 + i) * 64 + lane];
#pragma unroll
      for (int i = 0; i < 26; ++i) {
        st[(c0 + i) * 64 + lane] = make_float2(cr, ci);
        float nr = ar * cr - ai * ci + x[i].x;
        float ni = ar * ci + ai * cr + x[i].y;
        cr = nr; ci = ni;
      }
    }
  }
}
template <int DIR>
__device__ __forceinline__ void s5_p3_dir(const Params& P, int l, int b, int g, int j, int lane, float* BuS, ushort_t* hs, ushort_t* ys) {
  const int fr = lane & 15, fq = lane >> 4;
  const int c = dir_chunk(DIR, j);
  const size_t row0 = (size_t)(b * TOK + j * 128);
  bf16x8 bfr[8];
  S5Lam lam;
  s5_load_tab(P, DIR, g, lane, bfr, lam);
  bf16x8 cb[4];
  s5_load_ctab(P, DIR, g, lane, cb);
  float2 st = ((const float2*)(P.s5st + (size_t)(((b * 2 + DIR) * 16 + g) * NCH + c) * 128))[lane];
  float hr = st.x, hi = st.y;
  const int col = g * 16 + fr;
  const float dsk = P.s5_d[l * 256 + col];
  uint4 ua = s5_load_u(P, row0, g, DIR, 0, lane);
#pragma unroll 1
  for (int sbi = 0; sbi < 8; ++sbi) {
    const int nsb = DIR == 0 ? sbi : 7 - sbi;
    __syncthreads();
    s5_bu_to_lds(ua, bfr, BuS, lane);
    __syncthreads();
    if (sbi + 1 < 8) ua = s5_load_u(P, row0, g, DIR, sbi + 1, lane);
    for (int tii = 0; tii < 16; ++tii) {
      const int tin = DIR == 0 ? tii : 15 - tii;
      const float2 bu = *(const float2*)(BuS + tii * S5_BU_STRIDE + 2 * lane);
      const float nr = lam.lbr * hr - lam.lbi * hi + bu.x;
      const float ni = lam.lbr * hi + lam.lbi * hr + bu.y;
      hr = nr; hi = ni;
      *(unsigned*)(hs + tin * 136 + 2 * lane) = pack2(hr, hi);
    }
    __syncthreads();
    f32x4 acc = f32x4{0.f, 0.f, 0.f, 0.f};
#pragma unroll
    for (int ks = 0; ks < 4; ++ks) {
      bf16x8 a = *(const bf16x8*)(hs + fr * 136 + ks * 32 + fq * 8);
      acc = __builtin_amdgcn_mfma_f32_16x16x32_bf16(a, cb[ks], acc, 0, 0, 0);
    }
    if (DIR == 0) {
#pragma unroll
      for (int jx = 0; jx < 4; ++jx) ys[(nsb * 16 + fq * 4 + jx) * 16 + fr] = f2bf(acc[jx]);
    } else {
#pragma unroll
      for (int jx = 0; jx < 4; ++jx) {
        const int tl = nsb * 16 + fq * 4 + jx;
        const size_t r = row0 + tl;
        float uval = bf2f(P.z[r * IND + ZC_S5U + col]);
        float y = acc[jx] + bf2f(ys[tl * 16 + fr]) + dsk * uval;
        float t3 = 0.7978845608028654f * (y + 0.044715f * y * y * y);
        float gl = y * (1.f - 1.f / (1.f + __expf(2.f * t3)));
        P.s5g[r * 256 + col] = f2bf(gl);
      }
    }
  }
}
#define S5_WAVE_LDS (16 * S5_BU_STRIDE * 4 + 16 * 136 * 2 + 128 * 16 * 2)
__device__ void unit_s5_p3(const Params& P, int l, int unit, char* smem) {
  const int wid = ltid() >> 6, lane = ltid() & 63;
  char* base = smem + wid * S5_WAVE_LDS;
  float* BuS = (float*)base;
  ushort_t* hs = (ushort_t*)(base + 16 * S5_BU_STRIDE * 4);
  ushort_t* ys = hs + 16 * 136;
  {
    int item = unit * NW + wid;
    int j = item % NCH, g = (item / NCH) % 16, b = item / (NCH * 16);
    s5_p3_dir<0>(P, l, b, g, j, lane, BuS, hs, ys);
    s5_p3_dir<1>(P, l, b, g, j, lane, BuS, hs, ys);
  }
}

struct MlRegs { uint4 k0, k1, q0, q1, v0, v1; float ig, fp; };
__device__ __forceinline__ void st16(float* dst, uint4 a, uint4 b) {
  float f[16];
  unpack8(a, f); unpack8(b, f + 8);
  float4* d = (float4*)dst;
  d[0] = make_float4(f[0], f[1], f[2], f[3]); d[1] = make_float4(f[4], f[5], f[6], f[7]);
  d[2] = make_float4(f[8], f[9], f[10], f[11]); d[3] = make_float4(f[12], f[13], f[14], f[15]);
}
__device__ __forceinline__ void ml_load(const Params& P, int l, int b, int h, int d, int j, int sb, int lane, bool need_q, MlRegs& R) {
  const int ti = lane >> 2, part = lane & 3;
  const int sl = sb * 16 + ti;
  const int nl = d == 0 ? sl : 127 - sl;
  const size_t r = (size_t)(b * TOK + j * 128 + nl);
  const uint4* sk = (const uint4*)(P.mlqk + r * 512 + 256 + h * 64 + part * 16);
  R.k0 = sk[0]; R.k1 = sk[1];
  if (need_q) { const uint4* sq = (const uint4*)(P.mlqk + r * 512 + h * 64 + part * 16); R.q0 = sq[0]; R.q1 = sq[1]; }
  const uint4* sv = (const uint4*)(P.z + r * IND + ZC_MLV + h * 64 + part * 16);
  R.v0 = sv[0]; R.v1 = sv[1];
  if (part == 0) {
    R.ig = P.gates[r * 48 + (2 * d) * 4 + h] + P.ml_gate_b[l * 16 + (2 * d) * 4 + h];
    R.fp = P.gates[r * 48 + (2 * d + 1) * 4 + h] + P.ml_gate_b[l * 16 + (2 * d + 1) * 4 + h];
  }
}
__device__ __forceinline__ void ml_store(const MlRegs& R, int lane, bool need_q, float* ks, float* qs, float* vs, float* gs) {
  const int ti = lane >> 2, part = lane & 3;
  st16(ks + ti * 64 + part * 16, R.k0, R.k1);
  if (need_q) st16(qs + ti * 64 + part * 16, R.q0, R.q1);
  st16(vs + ti * 64 + part * 16, R.v0, R.v1);
  if (part == 0) { gs[ti * 2] = R.ig; gs[ti * 2 + 1] = logsigmoidf_(R.fp); }
}
#define ML_WAVE_LDS (3 * 1024 + 32)
__device__ __forceinline__ float wave_scan_add(float v, int lane) {
#pragma unroll
  for (int o = 1; o < 64; o <<= 1) { float t = __shfl_up(v, o); if (lane >= o) v += t; }
  return v;
}
__device__ __forceinline__ float wave_scan_max(float v, int lane) {
#pragma unroll
  for (int o = 1; o < 64; o <<= 1) { float t = __shfl_up(v, o); if (lane >= o) v = fmaxf(v, t); }
  return v;
}
#define ML3_ITEM_LDS 38912
__device__ void unit_ml_p1(const Params& P, int l, int unit, char* smem) {
  const int tid = ltid(), wid = tid >> 6, lane = tid & 63, r = lane & 31, h = lane >> 5;
  const int sub = wid >> 2, w4 = wid & 3, kt = w4 >> 1, vt = w4 & 1, t256 = tid & 255;
  const int item = unit * 2 + sub;
  const int c = item % NCH, d = (item / NCH) % 2, hh = (item / (NCH * 2)) % 4, b = item / (NCH * 8);
  const int j = dir_chunk(d, c);
  ushort_t* Ktc = (ushort_t*)(smem + sub * ML3_ITEM_LDS);
  ushort_t* Vtc = Ktc + 64 * 136;
  float* eS = (float*)(Vtc + 64 * 136);
  float* st = P.mlst + (size_t)item * MLST_SZ;
  const float LOG2E = 1.4426950408889634f;
  const size_t row0 = (size_t)(b * TOK + j * 128);
  __syncthreads();
  if (w4 == 0) {
    const float gbi = P.ml_gate_b[l * 16 + (2 * d) * 4 + hh], gbf = P.ml_gate_b[l * 16 + (2 * d + 1) * 4 + hh];
    float ig[2], lf[2];
#pragma unroll
    for (int q = 0; q < 2; ++q) {
      const int s = 2 * lane + q;
      const int nl = d == 0 ? s : 127 - s;
      ig[q] = P.gates[(row0 + nl) * 48 + (2 * d) * 4 + hh] + gbi;
      lf[q] = logsigmoidf_(P.gates[(row0 + nl) * 48 + (2 * d + 1) * 4 + hh] + gbf);
    }
    const float c1 = lf[0] + lf[1];
    const float incl = wave_scan_add(c1, lane);
    const float F0 = incl - c1 + lf[0], F1 = incl;
    const float b0 = ig[0] - F0, b1 = ig[1] - F1;
    float bm = fmaxf(b0, b1);
#pragma unroll
    for (int o = 32; o; o >>= 1) bm = fmaxf(bm, __shfl_xor(bm, o));
    const float Ftot = __shfl(incl, 63);
    eS[2 * lane] = __builtin_amdgcn_exp2f((b0 - bm) * LOG2E);
    eS[2 * lane + 1] = __builtin_amdgcn_exp2f((b1 - bm) * LOG2E);
    if (lane == 0) { st[4160] = Ftot + bm; st[4161] = Ftot; }
  }
  __syncthreads();
  {
    uint4 kx[4], vx[4];
#pragma unroll
    for (int i = 0; i < 4; ++i) {
      const int id = t256 + 256 * i, s = id >> 3, ck = id & 7;
      const int nl = d == 0 ? s : 127 - s;
      kx[i] = *(const uint4*)(P.mlqk + (row0 + nl) * 512 + 256 + hh * 64 + ck * 8);
      vx[i] = *(const uint4*)(P.z + (row0 + nl) * IND + ZC_MLV + hh * 64 + ck * 8);
    }
#pragma unroll
    for (int i = 0; i < 4; ++i) {
      const int id = t256 + 256 * i, s = id >> 3, ck = id & 7;
      const float es = eS[s];
      float kf[8];
      unpack8(kx[i], kf);
      ushort_t* kd = Ktc + (ck * 8) * 136 + s;
#pragma unroll
      for (int e = 0; e < 8; ++e) kd[e * 136] = f2bf(kf[e] * es);
      const uint4 vv = vx[i];
      ushort_t* vd = Vtc + (ck * 8) * 136 + s;
      vd[0 * 136] = (ushort_t)(vv.x & 0xffffu); vd[1 * 136] = (ushort_t)(vv.x >> 16);
      vd[2 * 136] = (ushort_t)(vv.y & 0xffffu); vd[3 * 136] = (ushort_t)(vv.y >> 16);
      vd[4 * 136] = (ushort_t)(vv.z & 0xffffu); vd[5 * 136] = (ushort_t)(vv.z >> 16);
      vd[6 * 136] = (ushort_t)(vv.w & 0xffffu); vd[7 * 136] = (ushort_t)(vv.w >> 16);
    }
  }
  __syncthreads();
  f32x16 C;
#pragma unroll
  for (int i = 0; i < 16; ++i) C[i] = 0.f;
  float nsum = 0.f;
#pragma unroll
  for (int ks = 0; ks < 8; ++ks) {
    const uint4 ar = *(const uint4*)(Ktc + (kt * 32 + r) * 136 + 16 * ks + 8 * h);
    const uint4 br = *(const uint4*)(Vtc + (vt * 32 + r) * 136 + 16 * ks + 8 * h);
    C = __builtin_amdgcn_mfma_f32_32x32x16_bf16(__builtin_bit_cast(bf16x8, ar), __builtin_bit_cast(bf16x8, br), C, 0, 0, 0);
    float af[8];
    unpack8(ar, af);
    nsum += ((af[0] + af[1]) + (af[2] + af[3])) + ((af[4] + af[5]) + (af[6] + af[7]));
  }
#pragma unroll
  for (int i = 0; i < 16; ++i) st[(size_t)(kt * 32 + (i & 3) + 8 * (i >> 2) + 4 * h) * 64 + vt * 32 + r] = C[i];
  nsum += __shfl_xor(nsum, 32);
  if (vt == 0 && h == 0) st[4096 + kt * 32 + r] = nsum;
}
__device__ void phase_ml_p2(const Params& P, int bid, int nblk) {
  const int wid = ltid() >> 6, lane = ltid() & 63;
  for (int it = bid * NW + wid; it < 16 * 65; it += nblk * NW) {
    int bhd = it / 65, slab = it % 65;
    int e = slab * 64 + lane;
    float st = 0.f, m = 0.f;
    float* base = P.mlst + (size_t)bhd * NCH * MLST_SZ;
    for (int c0 = 0; c0 < NCH; c0 += 26) {
      float x[26], gt[26], bt[26];
#pragma unroll
      for (int i = 0; i < 26; ++i) {
        const float* pc = base + (size_t)(c0 + i) * MLST_SZ;
        x[i] = pc[e]; gt[i] = pc[4160]; bt[i] = pc[4161];
      }
#pragma unroll
      for (int i = 0; i < 26; ++i) {
        float* pc = base + (size_t)(c0 + i) * MLST_SZ;
        float mn = fmaxf(bt[i] + m, gt[i]);
        float a = __expf(bt[i] + m - mn), s = __expf(gt[i] - mn);
        pc[e] = st;
        st = a * st + s * x[i];
        if (slab == 0 && lane == 0) pc[4162] = m;
        m = mn;
      }
    }
  }
}
__device__ void unit_ml_p3(const Params& P, int l, int unit, char* smem) {
  const int tid = ltid(), wid = tid >> 6, lane = tid & 63, r = lane & 31, h = lane >> 5;
  const int sub = wid >> 2, tt = wid & 3, t256 = tid & 255;
  const int item = unit * 2 + sub;
  const int c = item % NCH, d = (item / NCH) % 2, hh = (item / (NCH * 2)) % 4, b = item / (NCH * 8);
  const int j = dir_chunk(d, c);
  ushort_t* Kc = (ushort_t*)(smem + sub * ML3_ITEM_LDS);
  ushort_t* Vtc = Kc + 128 * 72;
  float* bS = (float*)(Vtc + 64 * 136);
  float* MS = bS + 128;
  float* FS = MS + 128;
  const float* st = P.mlst + (size_t)item * MLST_SZ;
  const float m_prev = st[4162];
  const float LOG2E = 1.4426950408889634f;
  const size_t row0 = (size_t)(b * TOK + j * 128);
  const int tl = tt * 32 + r;
  const size_t qrow = row0 + (d == 0 ? tl : 127 - tl);
  bf16x8 Qf[4];
  float graw[2] = {0.f, 0.f}, fraw[2] = {0.f, 0.f};
  __syncthreads();
  {
    uint4 kx[4], vx[4];
#pragma unroll
    for (int i = 0; i < 4; ++i) {
      const int id = t256 + 256 * i, s = id >> 3, ck = id & 7;
      const int nl = d == 0 ? s : 127 - s;
      kx[i] = *(const uint4*)(P.mlqk + (row0 + nl) * 512 + 256 + hh * 64 + ck * 8);
      vx[i] = *(const uint4*)(P.z + (row0 + nl) * IND + ZC_MLV + hh * 64 + ck * 8);
    }
#pragma unroll
    for (int ks = 0; ks < 4; ++ks) Qf[ks] = *(const bf16x8*)(P.mlqk + qrow * 512 + hh * 64 + 16 * ks + 8 * h);
    if (tt == 0) {
#pragma unroll
      for (int q = 0; q < 2; ++q) {
        const int s = 2 * lane + q;
        const int nl = d == 0 ? s : 127 - s;
        graw[q] = P.gates[(row0 + nl) * 48 + (2 * d) * 4 + hh];
        fraw[q] = P.gates[(row0 + nl) * 48 + (2 * d + 1) * 4 + hh];
      }
    }
#pragma unroll
    for (int i = 0; i < 4; ++i) {
      const int id = t256 + 256 * i, s = id >> 3, ck = id & 7;
      *(uint4*)(Kc + s * 72 + ck * 8) = kx[i];
      const uint4 vv = vx[i];
      ushort_t* vd = Vtc + (ck * 8) * 136 + s;
      vd[0 * 136] = (ushort_t)(vv.x & 0xffffu); vd[1 * 136] = (ushort_t)(vv.x >> 16);
      vd[2 * 136] = (ushort_t)(vv.y & 0xffffu); vd[3 * 136] = (ushort_t)(vv.y >> 16);
      vd[4 * 136] = (ushort_t)(vv.z & 0xffffu); vd[5 * 136] = (ushort_t)(vv.z >> 16);
      vd[6 * 136] = (ushort_t)(vv.w & 0xffffu); vd[7 * 136] = (ushort_t)(vv.w >> 16);
    }
  }
  if (tt == 0) {
    const float gbi = P.ml_gate_b[l * 16 + (2 * d) * 4 + hh], gbf = P.ml_gate_b[l * 16 + (2 * d + 1) * 4 + hh];
    float ig[2], lf[2];
#pragma unroll
    for (int q = 0; q < 2; ++q) {
      const int s = 2 * lane + q;
      const int nl = d == 0 ? s : 127 - s;
      ig[q] = graw[q] + gbi;
      lf[q] = logsigmoidf_(fraw[q] + gbf);
    }
    const float c1 = lf[0] + lf[1];
    const float incl = wave_scan_add(c1, lane);
    const float F0 = incl - c1 + lf[0], F1 = incl;
    const float b0 = ig[0] - F0, b1 = ig[1] - F1;
    const float pm1 = fmaxf(b0, b1);
    const float pincl = wave_scan_max(pm1, lane);
    float pexcl = __shfl_up(pincl, 1);
    if (lane == 0) pexcl = -INFINITY;
    const float M0 = fmaxf(m_prev, fmaxf(pexcl, b0)), M1 = fmaxf(m_prev, pincl);
    bS[2 * lane] = b0; bS[2 * lane + 1] = b1;
    MS[2 * lane] = M0; MS[2 * lane + 1] = M1;
    FS[2 * lane] = F0; FS[2 * lane + 1] = F1;
  }
  __syncthreads();
  const float Mt = MS[tl], Mtc = Mt * LOG2E;
  f32x16 O[2];
#pragma unroll
  for (int mt = 0; mt < 2; ++mt)
#pragma unroll
    for (int i = 0; i < 16; ++i) O[mt][i] = 0.f;
  float dsum = 0.f;
  for (int ss = 0; ss <= tt; ++ss) {
    f32x16 S;
#pragma unroll
    for (int i = 0; i < 16; ++i) S[i] = 0.f;
#pragma unroll
    for (int ks = 0; ks < 4; ++ks) {
      const bf16x8 a = *(const bf16x8*)(Kc + (ss * 32 + r) * 72 + 16 * ks + 8 * h);
      S = __builtin_amdgcn_mfma_f32_32x32x16_bf16(a, Qf[ks], S, 0, 0, 0);
    }
    float p[16];
#pragma unroll
    for (int g = 0; g < 4; ++g) {
      const float4 bv = *(const float4*)(bS + ss * 32 + 8 * g + 4 * h);
      const float bb[4] = {bv.x, bv.y, bv.z, bv.w};
#pragma unroll
      for (int e = 0; e < 4; ++e) {
        const int sidx = ss * 32 + 8 * g + 4 * h + e;
        float w = __builtin_amdgcn_exp2f(fmaf(bb[e], LOG2E, -Mtc));
        if (sidx > tl) w = 0.f;
        const float pv = S[4 * g + e] * w;
        p[4 * g + e] = pv;
        dsum += pv;
      }
    }
    bf16x8 Pf[2];
#pragma unroll
    for (int s2 = 0; s2 < 2; ++s2) {
      uint4 w4;
      w4.x = pack2(p[8 * s2 + 0], p[8 * s2 + 1]); w4.y = pack2(p[8 * s2 + 2], p[8 * s2 + 3]);
      w4.z = pack2(p[8 * s2 + 4], p[8 * s2 + 5]); w4.w = pack2(p[8 * s2 + 6], p[8 * s2 + 7]);
      Pf[s2] = __builtin_bit_cast(bf16x8, w4);
    }
#pragma unroll
    for (int mt = 0; mt < 2; ++mt)
#pragma unroll
      for (int s2 = 0; s2 < 2; ++s2) {
        const ushort_t* vp = Vtc + (mt * 32 + r) * 136 + ss * 32 + 16 * s2 + 4 * h;
        const uint2 lo = *(const uint2*)(vp), hi = *(const uint2*)(vp + 8);
        const bf16x8 a = __builtin_bit_cast(bf16x8, make_uint4(lo.x, lo.y, hi.x, hi.y));
        O[mt] = __builtin_amdgcn_mfma_f32_32x32x16_bf16(a, Pf[s2], O[mt], 0, 0, 0);
      }
  }
  dsum += __shfl_xor(dsum, 32);
  f32x16 Oi[2];
#pragma unroll
  for (int mt = 0; mt < 2; ++mt)
#pragma unroll
    for (int i = 0; i < 16; ++i) Oi[mt][i] = 0.f;
  float nq = 0.f;
#pragma unroll
  for (int ks = 0; ks < 4; ++ks) {
    const int k0 = 16 * ks + 8 * h;
#pragma unroll
    for (int mt = 0; mt < 2; ++mt) {
      const float* cp = st + (size_t)k0 * 64 + mt * 32 + r;
      uint4 w4;
      w4.x = pack2(cp[0 * 64], cp[1 * 64]); w4.y = pack2(cp[2 * 64], cp[3 * 64]);
      w4.z = pack2(cp[4 * 64], cp[5 * 64]); w4.w = pack2(cp[6 * 64], cp[7 * 64]);
      Oi[mt] = __builtin_amdgcn_mfma_f32_32x32x16_bf16(__builtin_bit_cast(bf16x8, w4), Qf[ks], Oi[mt], 0, 0, 0);
    }
    float qf[8];
    unpack8(__builtin_bit_cast(uint4, Qf[ks]), qf);
    const float4 n0 = *(const float4*)(st + 4096 + k0), n1 = *(const float4*)(st + 4096 + k0 + 4);
    nq += n0.x * qf[0] + n0.y * qf[1] + n0.z * qf[2] + n0.w * qf[3] + n1.x * qf[4] + n1.y * qf[5] + n1.z * qf[6] + n1.w * qf[7];
  }
  nq += __shfl_xor(nq, 32);
  const float at = __builtin_amdgcn_exp2f(m_prev * LOG2E - Mtc);
  const float den = dsum + at * nq;
  const float mt_full = FS[tl] + Mt;
  const float inv = 1.f / fmaxf(fabsf(den), __builtin_amdgcn_exp2f(-mt_full * LOG2E));
  ushort_t* outp = d == 0 ? (P.mix + qrow * DM + 256 + hh * 64) : (P.z + qrow * IND + ZC_MLQ + hh * 64);
#pragma unroll
  for (int mt = 0; mt < 2; ++mt)
#pragma unroll
    for (int g = 0; g < 4; ++g) {
      const int v0 = mt * 32 + 8 * g + 4 * h;
      uint2 o;
      o.x = pack2((O[mt][4 * g + 0] + at * Oi[mt][4 * g + 0]) * inv, (O[mt][4 * g + 1] + at * Oi[mt][4 * g + 1]) * inv);
      o.y = pack2((O[mt][4 * g + 2] + at * Oi[mt][4 * g + 2]) * inv, (O[mt][4 * g + 3] + at * Oi[mt][4 * g + 3]) * inv);
      *(uint2*)(outp + v0) = o;
    }
}

#define GL_WAVE_LDS 13312
template <bool OUT>
__device__ void unit_gl_mfma(const Params& P, int unit, char* smem) {
  const int tid = ltid(), wid = tid >> 6, lane = tid & 63, r = lane & 31, h = lane >> 5;
  const int item = unit * NW + wid;
  const int c = item % NCH, d = (item / NCH) % 2, hh = (item / (NCH * 2)) % 4, b = item / (NCH * 8);
  const int j = dir_chunk(d, c);
  ushort_t* qT = (ushort_t*)(smem + wid * GL_WAVE_LDS);
  ushort_t* kT = qT + 32 * 40;
  ushort_t* kH = kT + 32 * 40;
  ushort_t* Vt = kH + 32 * 40;
  float* Dv = (float*)(Vt + 64 * 40);
  float* st = P.glast + (size_t)item * GLST_SZ;
  const size_t row0 = (size_t)(b * TOK + j * 128);
  f32x16 R[2];
#pragma unroll
  for (int vt = 0; vt < 2; ++vt)
#pragma unroll
    for (int i = 0; i < 16; ++i) R[vt][i] = OUT ? st[(size_t)((i & 3) + 8 * (i >> 2) + 4 * h) * 64 + vt * 32 + r] : 0.f;
  float aprod = 1.f;
  const float qscale = 0.17677669529663687f;
  for (int u = 0; u < 4; ++u) {
    __syncthreads();
    {
      float al[32];
      ushort_t xr[32];
      const int xcol = (h == 0 ? ZC_GLQ : ZC_GLK) + hh * 32 + r;
#pragma unroll
      for (int s2 = 0; s2 < 32; ++s2) {
        const int sp = 32 * u + s2;
        const size_t row = row0 + (d == 0 ? sp : 127 - sp);
        al[s2] = P.alpha[row * 256 + d * 128 + hh * 32 + r];
        xr[s2] = P.z[row * IND + xcol];
      }
      uint4 vv[4];
      {
        const int sp = 32 * u + (lane >> 1), vh = lane & 1;
        const size_t row = row0 + (d == 0 ? sp : 127 - sp);
        const uint4* sv = (const uint4*)(P.z + row * IND + ZC_GLV + hh * 64 + vh * 32);
#pragma unroll
        for (int q = 0; q < 4; ++q) vv[q] = sv[q];
      }
      float A = 1.f;
      float kr[32];
#pragma unroll
      for (int s2 = 0; s2 < 32; ++s2) {
        A *= al[s2];
        kr[s2] = (h == 0) ? bf2f(xr[s2]) * qscale * A : bf2f(xr[s2]) * __builtin_amdgcn_rcpf(A);
      }
      if (OUT) {
        ushort_t* dst = h == 0 ? qT : kT;
#pragma unroll
        for (int s2 = 0; s2 < 32; ++s2) dst[s2 * 40 + r] = f2bf(kr[s2]);
      }
      if (h == 1) {
        Dv[r] = A;
#pragma unroll
        for (int s2 = 0; s2 < 32; s2 += 2) *(unsigned*)(kH + r * 40 + s2) = pack2(kr[s2] * A, kr[s2 + 1] * A);
      } else {
        aprod *= A;
      }
#pragma unroll
      for (int q = 0; q < 4; ++q) {
        ushort_t* vd = Vt + ((lane & 1) * 32 + q * 8) * 40 + (lane >> 1);
        vd[0 * 40] = (ushort_t)(vv[q].x & 0xffffu); vd[1 * 40] = (ushort_t)(vv[q].x >> 16);
        vd[2 * 40] = (ushort_t)(vv[q].y & 0xffffu); vd[3 * 40] = (ushort_t)(vv[q].y >> 16);
        vd[4 * 40] = (ushort_t)(vv[q].z & 0xffffu); vd[5 * 40] = (ushort_t)(vv[q].z >> 16);
        vd[6 * 40] = (ushort_t)(vv[q].w & 0xffffu); vd[7 * 40] = (ushort_t)(vv[q].w >> 16);
      }
    }
    __syncthreads();
    if (OUT) {
      f32x16 Pm;
#pragma unroll
      for (int i = 0; i < 16; ++i) Pm[i] = 0.f;
#pragma unroll
      for (int ks = 0; ks < 2; ++ks) {
        const bf16x8 ak = *(const bf16x8*)(kT + r * 40 + 16 * ks + 8 * h);
        const bf16x8 bq = *(const bf16x8*)(qT + r * 40 + 16 * ks + 8 * h);
        Pm = __builtin_amdgcn_mfma_f32_32x32x16_bf16(ak, bq, Pm, 0, 0, 0);
      }
#pragma unroll
      for (int i = 0; i < 16; ++i) { const int sl = (i & 3) + 8 * (i >> 2) + 4 * h; if (sl > r) Pm[i] = 0.f; }
      f32x16 O[2];
#pragma unroll
      for (int vt = 0; vt < 2; ++vt)
#pragma unroll
        for (int i = 0; i < 16; ++i) O[vt][i] = 0.f;
#pragma unroll
      for (int s2 = 0; s2 < 2; ++s2) {
        uint4 w4;
        w4.x = pack2(Pm[8 * s2 + 0], Pm[8 * s2 + 1]); w4.y = pack2(Pm[8 * s2 + 2], Pm[8 * s2 + 3]);
        w4.z = pack2(Pm[8 * s2 + 4], Pm[8 * s2 + 5]); w4.w = pack2(Pm[8 * s2 + 6], Pm[8 * s2 + 7]);
        const bf16x8 Pf = __builtin_bit_cast(bf16x8, w4);
        const ushort_t* qp = qT + r * 40 + 16 * s2 + 4 * h;
        const uint2 ql = *(const uint2*)(qp), qh = *(const uint2*)(qp + 8);
        const bf16x8 Bq = __builtin_bit_cast(bf16x8, make_uint4(ql.x, ql.y, qh.x, qh.y));
#pragma unroll
        for (int vt = 0; vt < 2; ++vt) {
          const ushort_t* vp = Vt + (vt * 32 + r) * 40 + 16 * s2 + 4 * h;
          const uint2 lo = *(const uint2*)(vp), hi = *(const uint2*)(vp + 8);
          O[vt] = __builtin_amdgcn_mfma_f32_32x32x16_bf16(__builtin_bit_cast(bf16x8, make_uint4(lo.x, lo.y, hi.x, hi.y)), Pf, O[vt], 0, 0, 0);
          uint4 r4;
          r4.x = pack2(R[vt][8 * s2 + 0], R[vt][8 * s2 + 1]); r4.y = pack2(R[vt][8 * s2 + 2], R[vt][8 * s2 + 3]);
          r4.z = pack2(R[vt][8 * s2 + 4], R[vt][8 * s2 + 5]); r4.w = pack2(R[vt][8 * s2 + 6], R[vt][8 * s2 + 7]);
          O[vt] = __builtin_amdgcn_mfma_f32_32x32x16_bf16(__builtin_bit_cast(bf16x8, r4), Bq, O[vt], 0, 0, 0);
        }
      }
      const int tp = 32 * u + r;
      const size_t qrow = row0 + (d == 0 ? tp : 127 - tp);
      ushort_t* outp = d == 0 ? (P.mix + qrow * DM + 768 + hh * 64) : (P.z + qrow * IND + ZC_MLK + hh * 64);
#pragma unroll
      for (int vt = 0; vt < 2; ++vt)
#pragma unroll
        for (int g = 0; g < 4; ++g) {
          uint2 o;
          o.x = pack2(O[vt][4 * g + 0], O[vt][4 * g + 1]); o.y = pack2(O[vt][4 * g + 2], O[vt][4 * g + 3]);
          *(uint2*)(outp + vt * 32 + 8 * g + 4 * h) = o;
        }
    }
#pragma unroll
    for (int g = 0; g < 4; ++g) {
      const float4 dv = *(const float4*)(Dv + 8 * g + 4 * h);
#pragma unroll
      for (int vt = 0; vt < 2; ++vt) { R[vt][4 * g + 0] *= dv.x; R[vt][4 * g + 1] *= dv.y; R[vt][4 * g + 2] *= dv.z; R[vt][4 * g + 3] *= dv.w; }
    }
#pragma unroll
    for (int s2 = 0; s2 < 2; ++s2) {
      const bf16x8 ak = *(const bf16x8*)(kH + r * 40 + 16 * s2 + 8 * h);
#pragma unroll
      for (int vt = 0; vt < 2; ++vt) {
        const bf16x8 bv = *(const bf16x8*)(Vt + (vt * 32 + r) * 40 + 16 * s2 + 8 * h);
        R[vt] = __builtin_amdgcn_mfma_f32_32x32x16_bf16(ak, bv, R[vt], 0, 0, 0);
      }
    }
  }
  if (!OUT) {
#pragma unroll
    for (int vt = 0; vt < 2; ++vt)
#pragma unroll
      for (int i = 0; i < 16; ++i) st[(size_t)((i & 3) + 8 * (i >> 2) + 4 * h) * 64 + vt * 32 + r] = R[vt][i];
    if (h == 0) st[2048 + r] = aprod;
  }
}
__device__ void unit_gl_p1(const Params& P, int unit, char* smem) { unit_gl_mfma<false>(P, unit, smem); }
__device__ void phase_gl_p2(const Params& P, int bid, int nblk) {
  const int wid = ltid() >> 6, lane = ltid() & 63;
  for (int it = ((bid + nblk - 130 % nblk) % nblk) * NW + wid; it < 16 * 32; it += nblk * NW) {
    int bhd = it / 32, slab = it % 32;
    int e = slab * 64 + lane;
    float st = 0.f;
    float* base = P.glast + (size_t)bhd * NCH * GLST_SZ;
    for (int c0 = 0; c0 < NCH; c0 += 26) {
      float x[26], A[26];
#pragma unroll
      for (int i = 0; i < 26; ++i) {
        const float* pc = base + (size_t)(c0 + i) * GLST_SZ;
        x[i] = pc[e]; A[i] = pc[2048 + slab];
      }
#pragma unroll
      for (int i = 0; i < 26; ++i) {
        float* pc = base + (size_t)(c0 + i) * GLST_SZ;
        pc[e] = st;
        st = A[i] * st + x[i];
      }
    }
  }
}
__device__ void unit_gl_p3(const Params& P, int unit, char* smem) { unit_gl_mfma<true>(P, unit, smem); }
__device__ void phase_finish(const Params& P, int l, int bid, int nblk) {
  const int wid = ltid() >> 6, lane = ltid() & 63;
  const int ch = lane * 4;
  const float4 gml = *(const float4*)(P.ml_norm_g + l * 256 + ch);
  const float4 ggl = *(const float4*)(P.gla_norm_g + l * 64 + (ch & 63));
  const int nw = nblk * NW;
  for (int it0 = bid * NW + wid; it0 < NTOK * 2; it0 += 4 * nw) {
    uint2 a[4], bb[4], gz[4];
#pragma unroll
    for (int q = 0; q < 4; ++q) {
      const int it = it0 + q * nw;
      const int itc = it < NTOK * 2 ? it : it0;
      const int r = itc >> 1, which = itc & 1;
      a[q] = *(const uint2*)(P.mix + (size_t)r * DM + (which ? 768 : 256) + ch);
      bb[q] = *(const uint2*)(P.z + (size_t)r * IND + (which ? ZC_MLK : ZC_MLQ) + ch);
      gz[q] = *(const uint2*)(P.z + (size_t)r * IND + (which ? ZC_GLR : ZC_MLO) + ch);
    }
#pragma unroll
    for (int q = 0; q < 4; ++q) {
      const int it = it0 + q * nw;
      const int r = it >> 1, which = it & 1;
      float v[4];
      v[0] = __uint_as_float(a[q].x << 16) + __uint_as_float(bb[q].x << 16);
      v[1] = __uint_as_float(a[q].x & 0xffff0000u) + __uint_as_float(bb[q].x & 0xffff0000u);
      v[2] = __uint_as_float(a[q].y << 16) + __uint_as_float(bb[q].y << 16);
      v[3] = __uint_as_float(a[q].y & 0xffff0000u) + __uint_as_float(bb[q].y & 0xffff0000u);
      float ss = v[0] * v[0] + v[1] * v[1] + v[2] * v[2] + v[3] * v[3];
      ss += __shfl_xor(ss, 1); ss += __shfl_xor(ss, 2); ss += __shfl_xor(ss, 4); ss += __shfl_xor(ss, 8);
      const float rstd = rsqrtf(ss * (1.f / 64.f) + 1e-6f);
      const float gt[4] = {__uint_as_float(gz[q].x << 16), __uint_as_float(gz[q].x & 0xffff0000u), __uint_as_float(gz[q].y << 16),
                           __uint_as_float(gz[q].y & 0xffff0000u)};
      const float4 gn = which == 0 ? gml : ggl;
      const float gnv[4] = {gn.x, gn.y, gn.z, gn.w};
      float o[4];
#pragma unroll
      for (int i = 0; i < 4; ++i) {
        const float sg = sigmoidf_(gt[i]);
        o[i] = (v[i] * rstd * gnv[i]) * (which == 0 ? sg : gt[i] * sg);
      }
      if (it < NTOK * 2) {
        uint2 ov; ov.x = pack2(o[0], o[1]); ov.y = pack2(o[2], o[3]);
        *(uint2*)(P.mix + (size_t)r * DM + (which ? 768 : 256) + ch) = ov;
      }
    }
  }
}

__device__ void phase_vt(const Params& P, int bid, int nblk, char* smem) {
  ushort_t* tile = (ushort_t*)smem;
  const int tid = ltid();
  const int nitems = B_ * 4 * (TOK / 64);
  for (int it = bid; it < nitems; it += nblk) {
    const int tb = it % 260, head = (it / 260) % 4, b = it / 1040;
    __syncthreads();
    {
      int id = tid, tok = id >> 3, vc = id & 7;
      uint4 v = *(const uint4*)(P.z + (size_t)(b * TOK + tb * 64 + tok) * IND + ZC_DAV + head * 64 + vc * 8);
      unsigned* d = (unsigned*)(tile + tok * 66 + vc * 8);
      d[0] = v.x; d[1] = v.y; d[2] = v.z; d[3] = v.w;
    }
    __syncthreads();
    {
      int id = tid, v = id >> 3, tc = id & 7;
      unsigned w[4];
#pragma unroll
      for (int e = 0; e < 4; ++e)
        w[e] = (unsigned)tile[(tc * 8 + 2 * e) * 66 + v] | ((unsigned)tile[(tc * 8 + 2 * e + 1) * 66 + v] << 16);
      *(uint4*)(P.vt + (size_t)((b * 4 + head) * 64 + v) * TOK + tb * 64 + tc * 8) = make_uint4(w[0], w[1], w[2], w[3]);
    }
  }
}

__device__ void phase_attn(const Params& P, int l, int bid, int nblk, char* smem) {
  ushort_t* Ks = (ushort_t*)smem;
  ushort_t* Vt = Ks + 128 * 72;
  constexpr int SLOT = 128 * 72 + 64 * 136;
  const int tid = ltid(), wid = tid >> 6, lane = tid & 63, r = lane & 31, h = lane >> 5;
  const float lam_init = 0.8f - 0.6f * __expf(-0.3f * (float)l);
  float lam;
  {
    const float* lp = P.da_lam + l * 128;
    float s01 = 0.f, s23 = 0.f;
    for (int i = 0; i < 32; ++i) { s01 += lp[i] * lp[32 + i]; s23 += lp[64 + i] * lp[96 + i]; }
    lam = __expf(s01) - __expf(s23) + lam_init;
  }
  const float LOG2E = 1.4426950408889634f;
  const int nitems = 512 + 8;
  const int krow = tid >> 2, kck = (tid & 3) * 2;
  const int vrow = tid >> 3, vck = (tid & 7) * 2;
  for (int item = bid; item < nitems; item += nblk) {
    int b, head, q0, nkeys;
    if (item < 512) { int qb = item % 64; head = (item / 64) % 4; b = item / 256; q0 = CTX + qb * 256; nkeys = TOK; }
    else { int i2 = item - 512; head = i2 % 4; b = i2 / 4; q0 = 0; nkeys = CTX; }
    const size_t qrow = (size_t)(b * TOK + q0 + wid * 32 + r);
    bf16x8 Qf[2][2];
#pragma unroll
    for (int mp = 0; mp < 2; ++mp)
#pragma unroll
      for (int s = 0; s < 2; ++s) Qf[mp][s] = *(const bf16x8*)(P.z + qrow * IND + ZC_DAQ + head * 64 + mp * 32 + 16 * s + 8 * h);
    f32x16 O[2][2];
#pragma unroll
    for (int mp = 0; mp < 2; ++mp)
#pragma unroll
      for (int mt = 0; mt < 2; ++mt)
#pragma unroll
        for (int i = 0; i < 16; ++i) O[mp][mt][i] = 0.f;
    float m[2] = {0.f, 0.f}, lsum[2] = {0.f, 0.f};
    bf16x8 Bm[2];
#pragma unroll
    for (int mp = 0; mp < 2; ++mp)
#pragma unroll
      for (int e = 0; e < 8; ++e) Bm[mp][e] = 0;
    bf16x8 Aone;
#pragma unroll
    for (int e = 0; e < 8; ++e) Aone[e] = (h == 0 && e == 0) ? (short)0x3F80 : (short)0;
    const ushort_t* kbase = P.z + (size_t)(b * TOK) * IND + ZC_DAK + head * 64 + (size_t)krow * IND + kck * 8;
    const ushort_t* vbase = P.vt + (size_t)((b * 4 + head) * 64 + vrow) * TOK + vck * 8;
    ushort_t* kst = Ks + krow * 72 + kck * 8;
    ushort_t* vst = Vt + vrow * 136 + vck * 8;
    const int nst = nkeys / 128;
    uint4 ka0 = ((const uint4*)kbase)[0], ka1 = ((const uint4*)kbase)[1];
    uint4 va0 = ((const uint4*)vbase)[0], va1 = ((const uint4*)vbase)[1];
    uint4 kb0 = ka0, kb1 = ka1, vb0 = va0, vb1 = va1;
    if (nst > 1) {
      const uint4* kp = (const uint4*)(kbase + (size_t)128 * IND); const uint4* vp = (const uint4*)(vbase + 128);
      kb0 = kp[0]; kb1 = kp[1]; vb0 = vp[0]; vb1 = vp[1];
    }
    __syncthreads();
    ((uint4*)kst)[0] = ka0; ((uint4*)kst)[1] = ka1; ((uint4*)vst)[0] = va0; ((uint4*)vst)[1] = va1;
    ((uint4*)(kst + SLOT))[0] = kb0; ((uint4*)(kst + SLOT))[1] = kb1; ((uint4*)(vst + SLOT))[0] = vb0; ((uint4*)(vst + SLOT))[1] = vb1;
    __syncthreads();
    f32x16 Sc[2], Sn[2];
#pragma unroll
    for (int mp = 0; mp < 2; ++mp) {
#pragma unroll
      for (int i = 0; i < 16; ++i) { Sc[mp][i] = 0.f; Sn[mp][i] = 0.f; }
#pragma unroll
      for (int s2 = 0; s2 < 2; ++s2) {
        bf16x8 a = *(const bf16x8*)(Ks + r * 72 + mp * 32 + 16 * s2 + 8 * h);
        Sc[mp] = __builtin_amdgcn_mfma_f32_32x32x16_bf16(a, Qf[mp][s2], Sc[mp], 0, 0, 0);
      }
    }
    int rb = 0;
    for (int st = 0; st < nst; ++st) {
      const int rb1 = rb == 2 ? 0 : rb + 1, rb2 = rb1 == 2 ? 0 : rb1 + 1;
      const ushort_t* Kc = Ks + rb * SLOT;
      const ushort_t* Vc = Vt + rb * SLOT;
      const ushort_t* Kn = Ks + rb1 * SLOT;
      const bool stage2 = st + 2 < nst;
#pragma unroll
      for (int kb = 0; kb < 4; ++kb) {
        if (stage2 && kb == 0) { const uint4* kp = (const uint4*)(kbase + (size_t)((st + 2) * 128) * IND); ka0 = kp[0]; ka1 = kp[1]; }
        if (stage2 && kb == 2) { const uint4* vp = (const uint4*)(vbase + (st + 2) * 128); va0 = vp[0]; va1 = vp[1]; }
        const bool have_next = (kb < 3) || (st + 1 < nst);
        if (have_next) {
          const ushort_t* Kx = kb < 3 ? Kc + (kb + 1) * 32 * 72 : Kn;
#pragma unroll
          for (int mp = 0; mp < 2; ++mp) {
#pragma unroll
            for (int i = 0; i < 16; ++i) Sn[mp][i] = 0.f;
#pragma unroll
            for (int s2 = 0; s2 < 2; ++s2) {
              bf16x8 a = *(const bf16x8*)(Kx + r * 72 + mp * 32 + 16 * s2 + 8 * h);
              Sn[mp] = __builtin_amdgcn_mfma_f32_32x32x16_bf16(a, Qf[mp][s2], Sn[mp], 0, 0, 0);
            }
            Sn[mp] = __builtin_amdgcn_mfma_f32_32x32x16_bf16(Aone, Bm[mp], Sn[mp], 0, 0, 0);
          }
        }
        const bool first = (st == 0 && kb == 0);
#pragma unroll
        for (int mp = 0; mp < 2; ++mp) {
          float mx = Sc[mp][0];
#pragma unroll
          for (int i = 1; i < 16; ++i) mx = fmaxf(mx, Sc[mp][i]);
          mx = fmaxf(mx, __shfl_xor(mx, 32));
          if (first || __any(mx > 0.25f)) {
            const bool upd = first || mx > 0.25f;
            const float mn = upd ? bf2f(f2bf(m[mp] + mx + 0.25f)) : m[mp];
            const float dd = mn - m[mp];
            m[mp] = mn;
            const float al = first ? 1.f : __builtin_amdgcn_exp2f(-dd);
#pragma unroll
            for (int i = 0; i < 16; ++i) { Sc[mp][i] -= dd; Sn[mp][i] -= dd; O[mp][0][i] *= al; O[mp][1][i] *= al; }
            lsum[mp] *= al;
            Bm[mp][0] = (h == 0) ? (short)f2bf(-mn) : (short)0;
          }
          bf16x8 Pf[2];
          {
            float p[16];
            float ps = 0.f;
#pragma unroll
            for (int i = 0; i < 16; ++i) { p[i] = __builtin_amdgcn_exp2f(Sc[mp][i]); ps += p[i]; }
            lsum[mp] += ps;
#pragma unroll
            for (int s2 = 0; s2 < 2; ++s2) {
              uint4 w;
              w.x = pack2(p[8 * s2 + 0], p[8 * s2 + 1]); w.y = pack2(p[8 * s2 + 2], p[8 * s2 + 3]);
              w.z = pack2(p[8 * s2 + 4], p[8 * s2 + 5]); w.w = pack2(p[8 * s2 + 6], p[8 * s2 + 7]);
              Pf[s2] = __builtin_bit_cast(bf16x8, w);
            }
          }
#pragma unroll
          for (int mt = 0; mt < 2; ++mt)
#pragma unroll
            for (int s2 = 0; s2 < 2; ++s2) {
              const ushort_t* vp = Vc + (mt * 32 + r) * 136 + kb * 32 + 16 * s2 + 4 * h;
              uint2 lo = *(const uint2*)(vp), hi = *(const uint2*)(vp + 8);
              bf16x8 a = __builtin_bit_cast(bf16x8, make_uint4(lo.x, lo.y, hi.x, hi.y));
              O[mp][mt] = __builtin_amdgcn_mfma_f32_32x32x16_bf16(a, Pf[s2], O[mp][mt], 0, 0, 0);
            }
        }
        Sc[0] = Sn[0]; Sc[1] = Sn[1];
        if (stage2 && kb == 1) { ((uint4*)(kst + rb2 * SLOT))[0] = ka0; ((uint4*)(kst + rb2 * SLOT))[1] = ka1; }
        if (stage2 && kb == 3) { ((uint4*)(vst + rb2 * SLOT))[0] = va0; ((uint4*)(vst + rb2 * SLOT))[1] = va1; }
      }
      __syncthreads();
      rb = rb1;
    }
    const float l0 = lsum[0] + __shfl_xor(lsum[0], 32), l1 = lsum[1] + __shfl_xor(lsum[1], 32);
    const float i0 = 1.f / l0, i1 = lam / l1;
    float ss = 0.f;
#pragma unroll
    for (int mt = 0; mt < 2; ++mt)
#pragma unroll
      for (int i = 0; i < 16; ++i) {
        float v = O[0][mt][i] * i0 - O[1][mt][i] * i1;
        O[0][mt][i] = v;
        ss += v * v;
      }
    ss += __shfl_xor(ss, 32);
    const float rstd = rsqrtf(ss * (1.f / 64.f) + 1e-6f) * (1.f - lam_init);
    ushort_t* op = P.mix + qrow * DM + 512 + head * 64;
#pragma unroll
    for (int mt = 0; mt < 2; ++mt)
#pragma unroll
      for (int g = 0; g < 4; ++g) {
        const int v0 = mt * 32 + 8 * g + 4 * h;
        const float4 gn = *(const float4*)(P.da_norm_g + l * 64 + v0);
        uint2 o;
        o.x = pack2(O[0][mt][4 * g + 0] * rstd * gn.x, O[0][mt][4 * g + 1] * rstd * gn.y);
        o.y = pack2(O[0][mt][4 * g + 2] * rstd * gn.z, O[0][mt][4 * g + 3] * rstd * gn.w);
        *(uint2*)(op + v0) = o;
      }
  }
}

__device__ void phase_final(const Params& P, int bid, int nblk) {
  const int wid = ltid() >> 6, lane = ltid() & 63;
  float4 gg[4];
#pragma unroll
  for (int i = 0; i < 4; ++i) gg[i] = ((const float4*)P.final_norm_g)[lane + 64 * i];
  const int nw = nblk * NW;
  for (int q0 = bid * NW + wid; q0 < B_ * SEQ; q0 += 2 * nw) {
    const int q1 = q0 + nw;
    const bool has1 = q1 < B_ * SEQ;
    const int qq1 = has1 ? q1 : q0;
    const float4* x0 = (const float4*)(P.xres + (size_t)((q0 / SEQ) * TOK + CTX + q0 % SEQ) * DM);
    const float4* x1 = (const float4*)(P.xres + (size_t)((qq1 / SEQ) * TOK + CTX + qq1 % SEQ) * DM);
    float4 v0[4], v1[4];
#pragma unroll
    for (int i = 0; i < 4; ++i) { v0[i] = x0[lane + 64 * i]; v1[i] = x1[lane + 64 * i]; }
    float s0 = 0.f, s1 = 0.f;
#pragma unroll
    for (int i = 0; i < 4; ++i) {
      s0 += v0[i].x * v0[i].x + v0[i].y * v0[i].y + v0[i].z * v0[i].z + v0[i].w * v0[i].w;
      s1 += v1[i].x * v1[i].x + v1[i].y * v1[i].y + v1[i].z * v1[i].z + v1[i].w * v1[i].w;
    }
    s0 = wave_sum(s0); s1 = wave_sum(s1);
    const float rs0 = rsqrtf(s0 * (1.f / DM) + 1e-6f), rs1 = rsqrtf(s1 * (1.f / DM) + 1e-6f);
    float4* o0 = (float4*)(P.out + (size_t)q0 * DM);
    float4* o1 = (float4*)(P.out + (size_t)qq1 * DM);
#pragma unroll
    for (int i = 0; i < 4; ++i) {
      o0[lane + 64 * i] = make_float4(v0[i].x * rs0 * gg[i].x, v0[i].y * rs0 * gg[i].y, v0[i].z * rs0 * gg[i].z, v0[i].w * rs0 * gg[i].w);
      if (has1) o1[lane + 64 * i] = make_float4(v1[i].x * rs1 * gg[i].x, v1[i].y * rs1 * gg[i].y, v1[i].z * rs1 * gg[i].z, v1[i].w * rs1 * gg[i].w);
    }
  }
}

#define XB_TMO      128
#define XB_XCNT(j)  (256  + 64 * (j))
#define XB_XSUB(j)  (1280 + 64 * (j))
#define XB_XGEN(j)  (2304 + 64 * (j))
#define XB_TOP      3328
#define XB_TOPGEN   3392
#define XCD_BAR_WORDS 3456
#define XB_SPIN_CAP (1u << 20)
#define LAS __attribute__((address_space(3)))
__device__ __forceinline__ unsigned xb_ld(unsigned* p)              { return __hip_atomic_load(p, __ATOMIC_RELAXED, __HIP_MEMORY_SCOPE_AGENT); }
__device__ __forceinline__ unsigned xb_add(unsigned* p, unsigned v) { return __hip_atomic_fetch_add(p, v, __ATOMIC_RELAXED, __HIP_MEMORY_SCOPE_AGENT); }
__device__ __forceinline__ unsigned xb_xcc_id() { return (unsigned)__builtin_amdgcn_s_getreg((3 << 11) | 20) & 0xFu; }
#define XB_SPIN(cond, bar) do { unsigned _sp = 0; while (cond) { __builtin_amdgcn_s_sleep(1); \
    if ((++_sp & 255u) == 0u) { if (xb_ld(&(bar)[XB_TMO])) break; if (_sp > XB_SPIN_CAP) { atomicAdd(&(bar)[XB_TMO], 1u); break; } } } } while (0)
struct XcdBarrier { unsigned* bar; unsigned x; volatile LAS unsigned* st; };
__device__ __forceinline__ XcdBarrier xcd_barrier_post(unsigned* bar, volatile LAS unsigned* st) {
  XcdBarrier b; b.bar = bar; b.x = xb_xcc_id(); b.st = st;
  if (ltid() == 0) (void)xb_add(&bar[XB_XCNT(b.x)], 1u);
  return b;
}
__device__ __forceinline__ void xcd_barrier_complete(unsigned* bar, unsigned x, unsigned& nloc, unsigned& nx) {
  const unsigned G = gridDim.x * gridDim.y * gridDim.z;
  unsigned sum, cnt, mine, sp = 0u;
  for (;;) {
    sum = 0u; cnt = 0u; mine = 0u;
#pragma unroll
    for (unsigned j = 0; j < 16; ++j) { const unsigned c = xb_ld(&bar[XB_XCNT(j)]); sum += c; cnt += (c > 0u) ? 1u : 0u; mine = (j == x) ? c : mine; }
    if (sum == G) break;
    __builtin_amdgcn_s_sleep(1);
    if ((++sp & 255u) == 0u) { if (xb_ld(&bar[XB_TMO])) break; if (sp > XB_SPIN_CAP) { atomicAdd(&bar[XB_TMO], 1u); break; } }
  }
  nloc = mine > 0u ? mine : 1u; nx = cnt > 0u ? cnt : 1u;
}
__device__ __forceinline__ void xcd_barrier(const XcdBarrier& b) {
  asm volatile("s_waitcnt vmcnt(0)" ::: "memory");
  __syncthreads();
  if (ltid() == 0) {
    unsigned* bar = b.bar;
    __builtin_amdgcn_s_waitcnt(0);
    unsigned nloc = b.st[0], nx = b.st[1];
    if (nloc == 0u) { xcd_barrier_complete(bar, b.x, nloc, nx); b.st[0] = nloc; b.st[1] = nx; }
    const unsigned old = xb_add(&bar[XB_XSUB(b.x)], 1u);
    const unsigned gen = old / nloc;
    if (old + 1u == (gen + 1u) * nloc) {
      __builtin_amdgcn_fence(__ATOMIC_RELEASE, "agent");
      asm volatile("s_waitcnt vmcnt(0)" ::: "memory");
      const unsigned og = xb_add(&bar[XB_TOP], 1u);
      const unsigned tg = og / nx;
      if (og + 1u == (tg + 1u) * nx) xb_add(&bar[XB_TOPGEN], 1u);
      else XB_SPIN(xb_ld(&bar[XB_TOPGEN]) == tg, bar);
      __builtin_amdgcn_fence(__ATOMIC_ACQUIRE, "agent");
      xb_add(&bar[XB_XGEN(b.x)], 1u);
      asm volatile("s_waitcnt vmcnt(0)" ::: "memory");
    } else {
      XB_SPIN(xb_ld(&bar[XB_XGEN(b.x)]) == gen, bar);
      __builtin_amdgcn_fence(__ATOMIC_ACQUIRE, "agent");
      asm volatile("s_waitcnt vmcnt(0)" ::: "memory");
    }
  }
  __syncthreads();
}

constexpr int NPH = 11;
__device__ __forceinline__ int next_unit(unsigned* ctr, char* smem) {
  int* sh = (int*)(smem + SMEM_BYTES - 16);
  __syncthreads();
  if (ltid() == 0) *sh = (int)atomicAdd(ctr, 1u);
  __syncthreads();
  return *sh;
}
__device__ __forceinline__ void run_phase(const Params& P, int l, int ph, int bid, int nblk, char* smem) {
  bid = launder_s(bid); nblk = launder_s(nblk); l = launder_s(l);
  switch (ph) {
    case 0: phase_convw(P, l, bid, nblk, smem); phase_norm(P, l, 0, bid, nblk); break;
    case 1: gemm_phase<G_ZIN>(P, l, bid, nblk, smem); break;
    case 2: phase_vt(P, bid, nblk, smem); phase_prep(P, l, bid, nblk); break;
    case 3:
      for (;;) {
        const int u = next_unit(P.qctr + l * 2, smem);
        if (u >= 260 + 1040 + 1040) break;
        if (u < 260) unit_gl_p1(P, u, smem);
        else if (u < 1300) unit_s5_p1(P, l, u - 260, smem);
        else unit_ml_p1(P, l, u - 1300, smem);
      }
      break;
    case 4: phase_s5_p2(P, l, bid, nblk); phase_ml_p2(P, bid, nblk); phase_gl_p2(P, bid, nblk); __syncthreads();
            phase_attn(P, l, bid, nblk, smem); break;
    case 5:
      for (;;) {
        const int u = next_unit(P.qctr + l * 2 + 1, smem);
        if (u >= 520 + 260 + 1040) break;
        if (u < 520) unit_s5_p3(P, l, u, smem);
        else if (u < 780) unit_gl_p3(P, u - 520, smem);
        else unit_ml_p3(P, l, u - 780, smem);
      }
      break;
    case 6: phase_finish(P, l, bid, nblk); __syncthreads(); gemm_phase<G_GLU>(P, l, bid, nblk, smem); break;
    case 7: gemm_phase<G_WOUT>(P, l, bid, nblk, smem); break;
    case 8: phase_norm(P, l, 1, bid, nblk); break;
    case 9: gemm_phase<G_W1>(P, l, bid, nblk, smem); break;
    case 10: gemm_phase<G_W2>(P, l, bid, nblk, smem); break;
  }
}

#if MEGA
__global__ void __launch_bounds__(NT, 2) k_mega(Params P) {
  __shared__ __attribute__((aligned(16))) char smem[SMEM_BYTES];
  cg::grid_group grid = cg::this_grid();
  const int bid = blockIdx.x, nblk = gridDim.x;
  volatile LAS unsigned* st = (volatile LAS unsigned*)(smem + SMEM_BYTES - 32);
  if ((threadIdx.x & 63) == 0) g_wtab[hw_slot()] = threadIdx.x >> 6;
  if (threadIdx.x == 0) { st[0] = 0u; st[1] = 0u; }
  __syncthreads();
  for (int i = bid * NT + ltid(); i < XCD_BAR_WORDS; i += nblk * NT) P.xbar[i] = 0u;
  phase_init(P, bid, nblk, smem);
  grid.sync();
  XcdBarrier xb = xcd_barrier_post(P.xbar, st);
  for (int l = 0; l < DEPTH; ++l) {
    for (int ph = 0; ph < NPH; ++ph) {
#ifdef ONLYPH
      if (ph != ONLYPH) continue;
#endif
      run_phase(P, l, ph, bid, nblk, smem);
      xcd_barrier(xb);
#if PROBE >= 10 && PROBE <= 12
      if (ph == 3 || ph == 5) {
        const bool p3 = (ph == 5);
        if (PROBE == 10) { const int n = p3 ? 520 : 1040; for (int u = bid; u < n; u += nblk) { if (p3) unit_s5_p3(P, l, u, smem); else unit_s5_p1(P, l, u, smem); } }
        if (PROBE == 11) { for (int u = bid; u < 260; u += nblk) { if (p3) unit_gl_p3(P, u, smem); else unit_gl_p1(P, u, smem); } }
        if (PROBE == 12) { for (int u = bid; u < 1040; u += nblk) { if (p3) unit_ml_p3(P, l, u, smem); else unit_ml_p1(P, l, u, smem); } }
        xcd_barrier(xb);
      }
#elif PROBE == 8
      if (ph == 0 || ph == 8) { run_phase(P, l, ph, bid, nblk, smem); xcd_barrier(xb); }
      if (ph == 6) { gemm_phase<G_GLU>(P, l, bid, nblk, smem); xcd_barrier(xb); }
      if (ph == 2) { phase_prep(P, l, bid, nblk, true); xcd_barrier(xb); }
#endif
    }
  }
  phase_final(P, bid, nblk);
}
#endif

extern "C" void kernel_launch(void* const* d_in, const int* in_sizes, int n_in, void* d_out, int out_size, void* d_ws,
                              size_t ws_size, hipStream_t stream) {
  Params P{};
  const float** pp = (const float**)&P;
  for (int i = 0; i < 32; ++i) pp[i] = (const float*)d_in[i];
  P.out = (float*)d_out;
  char* w = (char*)d_ws;
  size_t off = 0;
  auto take = [&](size_t bytes) { char* p = w + off; off += (bytes + 255) & ~(size_t)255; return p; };
  P.xres = (float*)take((size_t)NTOK * DM * 4);
  char* R = take((size_t)NTOK * DFF * 2);
  P.z = (ushort_t*)R;
  P.mix = (ushort_t*)(R + (size_t)NTOK * IND * 2);
  P.hidden = (ushort_t*)R;
  P.wt_in = (ushort_t*)take((size_t)INDP * DM * 2);
  P.wt_out = (ushort_t*)take((size_t)DM * DM * 2);
  P.w1t = (ushort_t*)take((size_t)DFF * DM * 2);
  P.w2t = (ushort_t*)take((size_t)DM * DFF * 2);
  P.glut = (ushort_t*)take((size_t)256 * 256 * 2);
  P.mlqk = (ushort_t*)take((size_t)NTOK * 512 * 2);
  P.s5g = (ushort_t*)take((size_t)NTOK * 256 * 2);
  P.mlst = (float*)take((size_t)B_ * 4 * 2 * NCH * MLST_SZ * 4);
  P.mod = (float*)take((size_t)DEPTH * 3 * 6144 * 4);
  P.qctr = (unsigned*)take(256);
  P.s5tab = (uint4*)take((size_t)32 * 13 * 64 * 16);
  P.xbar = (unsigned*)take((size_t)XCD_BAR_WORDS * 4);
  if (off > ws_size) { fprintf(stderr, "ws too small: need %zu have %zu\n", off, ws_size); return; }
  char* o = (char*)d_out;
  size_t ooff = 0;
  auto otake = [&](size_t bytes) { char* p = o + ooff; ooff += (bytes + 255) & ~(size_t)255; return p; };
  P.h = (ushort_t*)otake((size_t)NTOK * DM * 2);
  {
    char* hb = (char*)P.h;
    size_t ho = 0;
    auto htake = [&](size_t bytes) { char* p = hb + ho; ho += (bytes + 255) & ~(size_t)255; return p; };
    P.alpha = (float*)htake((size_t)NTOK * 256 * 4);
    P.s5st = (float*)htake((size_t)B_ * 2 * 16 * NCH * 128 * 4);
    P.glast = (float*)htake((size_t)B_ * 4 * 2 * NCH * GLST_SZ * 4);
    if (ho > (size_t)NTOK * DM * 2) { fprintf(stderr, "alias overflow\n"); return; }
  }
  P.gates = (float*)otake((size_t)NTOK * 48 * 4);
  P.vt = (ushort_t*)otake((size_t)B_ * 4 * 64 * TOK * 2);
  if (ooff > (size_t)out_size * 4) { fprintf(stderr, "out scratch too small\n"); return; }

#if MEGA
  static int grid_blocks = 0;
  if (!grid_blocks) {
    int dev = 0, cus = 0, per_cu = 0;
    hipGetDevice(&dev);
    hipDeviceGetAttribute(&cus, hipDeviceAttributeMultiprocessorCount, dev);
    hipOccupancyMaxActiveBlocksPerMultiprocessor(&per_cu, k_mega, NT, 0);
    if (per_cu > 1) per_cu = 1;
    grid_blocks = cus * per_cu;
  }
  void* args[] = {&P};
  hipError_t e = hipLaunchCooperativeKernel((void*)k_mega, dim3(grid_blocks), dim3(NT), args, 0, stream);
  if (e != hipSuccess) fprintf(stderr, "cooperative launch failed: %s (grid %d)\n", hipGetErrorString(e), grid_blocks);
#endif
}
```

```cpp
#include <hip/hip_runtime.h>
#include <hip/hip_cooperative_groups.h>
#include <stdint.h>
#include <stdio.h>
namespace cg = cooperative_groups;

#ifndef MEGA
#define MEGA 1
#endif
#define PROBE 0

#define NT 512
#define NW 8
typedef unsigned short ushort_t;
using bf16x8 = __attribute__((ext_vector_type(8))) short;
using f32x4 = __attribute__((ext_vector_type(4))) float;
using f32x16 = __attribute__((ext_vector_type(16))) float;
typedef float f2 __attribute__((ext_vector_type(2)));

constexpr int B_ = 2, SEQ = 16384, CTX = 256, TOK = SEQ + CTX, NTOK = B_ * TOK, DM = 1024, DEPTH = 4;
constexpr int IND = 2864, INDP = 3072, DFF = 4096, NCH = 130;
constexpr int MLST_SZ = 4224;
constexpr int GLST_SZ = 2112;
constexpr int SMEM_BYTES = 8 * (8448 + 4352 + 4096) + 32;

constexpr int ZC_S5U = 0, ZC_MLQ = 256, ZC_MLK = 512, ZC_MLV = 768, ZC_MLO = 1024, ZC_MLG = 1280;
constexpr int ZC_DAQ = 1296, ZC_DAK = 1552, ZC_DAV = 1808;
constexpr int ZC_GLQ = 2064, ZC_GLK = 2192, ZC_GLV = 2320, ZC_GLR = 2576, ZC_GLA = 2832;

struct Params {
  const float *x, *c, *ctx, *c_ctx, *ada_w, *ada_b, *norm1_g, *norm2_g, *w_in, *s5_lam_re, *s5_lam_im, *s5_log_step,
      *s5_b_re, *s5_b_im, *s5_c_re, *s5_c_im, *s5_d, *s5_glu_w, *s5_glu_b, *ml_conv_w, *ml_conv_b, *ml_gate_b,
      *ml_norm_g, *da_lam, *da_norm_g, *gla_alpha_w, *gla_alpha_b, *gla_norm_g, *w_out, *mlp_w1, *mlp_w2, *final_norm_g;
  float* out;
  float* xres;
  ushort_t* z;
  ushort_t* mix;
  ushort_t* hidden;
  ushort_t *wt_in, *wt_out, *w1t, *w2t, *glut;
  ushort_t* mlqk;
  ushort_t* s5g;
  float* mlst;
  float* mod;
  ushort_t* h;
  float* alpha;
  float* gates;
  float* s5st;
  float* glast;
  ushort_t* vt;
  unsigned* qctr;
  uint4* s5tab;
  unsigned* xbar;
};

__shared__ int g_wtab[64];
__device__ __forceinline__ int hw_slot() { return __builtin_amdgcn_s_getreg((5 << 11) | 4) & 63; }
__device__ __forceinline__ int ltid() {
  const int wv = g_wtab[hw_slot()];
  int lane;
  asm volatile("v_mbcnt_lo_u32_b32 %0, -1, 0\n\tv_mbcnt_hi_u32_b32 %0, -1, %0" : "=v"(lane));
  return wv * 64 + lane;
}
__device__ __forceinline__ int launder_s(int x) { asm volatile("" : "+s"(x)); return x; }
__device__ __forceinline__ float bf2f(ushort_t u) { return __uint_as_float(((unsigned)u) << 16); }
__device__ __forceinline__ ushort_t f2bf(float f) {
  unsigned u = __float_as_uint(f);
  u += 0x7fffu + ((u >> 16) & 1u);
  return (ushort_t)(u >> 16);
}
__device__ __forceinline__ unsigned pack2(float a, float b) {
  typedef __bf16 bf2_t __attribute__((ext_vector_type(2)));
  typedef float f2_t __attribute__((ext_vector_type(2)));
  f2_t v = {a, b};
  return __builtin_bit_cast(unsigned, __builtin_convertvector(v, bf2_t));
}
__device__ __forceinline__ float wave_sum(float v) {
#pragma unroll
  for (int o = 32; o; o >>= 1) v += __shfl_xor(v, o);
  return v;
}
__device__ __forceinline__ float sigmoidf_(float x) { return 1.f / (1.f + __expf(-x)); }
__device__ __forceinline__ float logsigmoidf_(float x) { return fminf(x, 0.f) - __logf(1.f + __expf(-fabsf(x))); }
__device__ __forceinline__ void unpack8(uint4 v, float* f) {
  f[0] = __uint_as_float(v.x << 16); f[1] = __uint_as_float(v.x & 0xffff0000u);
  f[2] = __uint_as_float(v.y << 16); f[3] = __uint_as_float(v.y & 0xffff0000u);
  f[4] = __uint_as_float(v.z << 16); f[5] = __uint_as_float(v.z & 0xffff0000u);
  f[6] = __uint_as_float(v.w << 16); f[7] = __uint_as_float(v.w & 0xffff0000u);
}
__device__ __forceinline__ int dir_chunk(int d, int c) { return d == 0 ? c : (c < 2 ? 1 - c : 131 - c); }

__device__ void phase_init(const Params& P, int bid, int nblk, char* smem) {
  const int tid = ltid();
  if (bid == 0 && tid < 2 * DEPTH) P.qctr[tid] = 0u;
  size_t total4 = (size_t)NTOK * 256;
  {
    const size_t st4 = (size_t)nblk * NT;
    auto srcp = [&](size_t i) -> const float4* {
      int r = (int)(i >> 8), c4 = (int)(i & 255);
      int b = r / TOK, t = r % TOK;
      const float4* src = (t < CTX) ? (const float4*)(P.ctx + ((size_t)(b * CTX + t)) * DM)
                                    : (const float4*)(P.x + ((size_t)(b * SEQ + t - CTX)) * DM);
      return src + c4;
    };
    for (size_t i0 = (size_t)bid * NT + tid; i0 < total4; i0 += st4 * 4) {
      const size_t i1 = i0 + st4, i2 = i0 + 2 * st4, i3 = i0 + 3 * st4;
      const float4 v0 = *srcp(i0);
      const float4 v1 = *srcp(i1 < total4 ? i1 : i0);
      const float4 v2 = *srcp(i2 < total4 ? i2 : i0);
      const float4 v3 = *srcp(i3 < total4 ? i3 : i0);
      ((float4*)P.xres)[i0] = v0;
      if (i1 < total4) ((float4*)P.xres)[i1] = v1;
      if (i2 < total4) ((float4*)P.xres)[i2] = v2;
      if (i3 < total4) ((float4*)P.xres)[i3] = v3;
    }
  }
  float* sv = (float*)smem;
  float* red = sv + 3072;
  for (int i = tid; i < 3072; i += NT) {
    int row = i >> 10, k = i & 1023;
    float v = (row < 2) ? P.c[row * DM + k] : P.c_ctx[k];
    sv[i] = v / (1.f + __expf(-v));
  }
  __syncthreads();
  for (int item = bid; item < 4 * 96; item += nblk) {
    int l = item / 96, cgp = item % 96;
    int jj = tid & 63, kq = tid >> 6;
    int col = cgp * 64 + jj;
    const float* w = P.ada_w + (size_t)l * DM * 6144 + col;
    float a0 = 0, a1 = 0, a2 = 0;
    for (int k = kq * 128; k < kq * 128 + 128; ++k) {
      float wv = w[(size_t)k * 6144];
      a0 += sv[k] * wv; a1 += sv[1024 + k] * wv; a2 += sv[2048 + k] * wv;
    }
    red[(kq * 3 + 0) * 64 + jj] = a0; red[(kq * 3 + 1) * 64 + jj] = a1; red[(kq * 3 + 2) * 64 + jj] = a2;
    __syncthreads();
    if (tid < 192) {
      int row = tid >> 6;
      float s = P.ada_b[l * 6144 + col];
#pragma unroll
      for (int q = 0; q < 8; ++q) s += red[(q * 3 + row) * 64 + jj];
      P.mod[(l * 3 + row) * 6144 + col] = s;
    }
    __syncthreads();
  }
}

__device__ void conv_tile(const float* __restrict__ W, int Nsrc, int K, ushort_t* Wt, int kt, int nt, int Nvalid, float* tile) {
  const int tid = ltid();
  {
    float4 v[2];
#pragma unroll
    for (int p = 0; p < 2; ++p) {
      int kk = p * 32 + (tid >> 4), nn = (tid & 15) * 4;
      int n = nt * 64 + nn;
      v[p] = make_float4(0, 0, 0, 0);
      if (n < Nvalid) v[p] = *(const float4*)(W + (size_t)(kt * 64 + kk) * Nsrc + n);
    }
#pragma unroll
    for (int p = 0; p < 2; ++p) {
      int kk = p * 32 + (tid >> 4), nn = (tid & 15) * 4;
      tile[kk * 65 + nn + 0] = v[p].x; tile[kk * 65 + nn + 1] = v[p].y; tile[kk * 65 + nn + 2] = v[p].z; tile[kk * 65 + nn + 3] = v[p].w;
    }
  }
  __syncthreads();
#pragma unroll
  for (int p = 0; p < 2; ++p) {
    int nn = p * 32 + (tid >> 4), kk = (tid & 15) * 4;
    uint2 o;
    o.x = pack2(tile[(kk + 0) * 65 + nn], tile[(kk + 1) * 65 + nn]);
    o.y = pack2(tile[(kk + 2) * 65 + nn], tile[(kk + 3) * 65 + nn]);
    *(uint2*)(Wt + (size_t)(nt * 64 + nn) * K + kt * 64 + kk) = o;
  }
  __syncthreads();
}
__device__ void phase_convw(const Params& P, int l, int bid, int nblk, char* smem) {
  float* tile = (float*)smem;
  const int n0 = 16 * 48, n1 = n0 + 256, n2 = n1 + 1024, n3 = n2 + 1024, n4 = n3 + 16;
  for (int it = bid; it < n4; it += nblk) {
    if (it < n0) conv_tile(P.w_in + (size_t)l * DM * IND, IND, DM, P.wt_in, it / 48, it % 48, IND, tile);
    else if (it < n1) { int i = it - n0; conv_tile(P.w_out + (size_t)l * DM * DM, DM, DM, P.wt_out, i / 16, i % 16, DM, tile); }
    else if (it < n2) { int i = it - n1; conv_tile(P.mlp_w1 + (size_t)l * DM * DFF, DFF, DM, P.w1t, i / 64, i % 64, DFF, tile); }
    else if (it < n3) { int i = it - n2; conv_tile(P.mlp_w2 + (size_t)l * DFF * DM, DM, DFF, P.w2t, i / 16, i % 16, DM, tile); }
    else { int i = it - n3; conv_tile(P.s5_glu_w + (size_t)l * 256 * 256, 256, 256, P.glut, i / 4, i % 4, 256, tile); }
  }
}

__device__ void phase_norm(const Params& P, int l, int which, int bid, int nblk) {
  const int wid = ltid() >> 6, lane = ltid() & 63;
  const float* g = (which == 0 ? P.norm1_g : P.norm2_g) + l * DM;
  const int shoff = which == 0 ? 0 : 3072, scoff = shoff + 1024;
  float4 gg[4];
#pragma unroll
  for (int i = 0; i < 4; ++i) gg[i] = *(const float4*)(g + (lane + 64 * i) * 4);
  const int nw = nblk * NW;
  for (int r0 = bid * NW + wid; r0 < NTOK; r0 += 2 * nw) {
    const int r1 = r0 + nw;
    const bool has1 = r1 < NTOK;
    const int rr1 = has1 ? r1 : r0;
    const int m0 = ((r0 % TOK) < CTX) ? 2 : r0 / TOK, m1 = ((rr1 % TOK) < CTX) ? 2 : rr1 / TOK;
    const float* md0 = P.mod + (l * 3 + m0) * 6144;
    const float* md1 = P.mod + (l * 3 + m1) * 6144;
    float4 v0[4], v1[4], sc0[4], sh0[4], sc1[4], sh1[4];
#pragma unroll
    for (int i = 0; i < 4; ++i) {
      v0[i] = ((const float4*)(P.xres + (size_t)r0 * DM))[lane + 64 * i];
      v1[i] = ((const float4*)(P.xres + (size_t)rr1 * DM))[lane + 64 * i];
      sc0[i] = *(const float4*)(md0 + scoff + (lane + 64 * i) * 4); sh0[i] = *(const float4*)(md0 + shoff + (lane + 64 * i) * 4);
      sc1[i] = *(const float4*)(md1 + scoff + (lane + 64 * i) * 4); sh1[i] = *(const float4*)(md1 + shoff + (lane + 64 * i) * 4);
    }
    float s0 = 0.f, s1 = 0.f;
#pragma unroll
    for (int i = 0; i < 4; ++i) {
      s0 += v0[i].x * v0[i].x + v0[i].y * v0[i].y + v0[i].z * v0[i].z + v0[i].w * v0[i].w;
      s1 += v1[i].x * v1[i].x + v1[i].y * v1[i].y + v1[i].z * v1[i].z + v1[i].w * v1[i].w;
    }
    s0 = wave_sum(s0); s1 = wave_sum(s1);
    const float rs0 = rsqrtf(s0 * (1.f / DM) + 1e-6f), rs1 = rsqrtf(s1 * (1.f / DM) + 1e-6f);
#pragma unroll
    for (int i = 0; i < 4; ++i) {
      const int col = (lane + 64 * i) * 4;
      uint2 o;
      o.x = pack2(v0[i].x * rs0 * gg[i].x * (1.f + sc0[i].x) + sh0[i].x, v0[i].y * rs0 * gg[i].y * (1.f + sc0[i].y) + sh0[i].y);
      o.y = pack2(v0[i].z * rs0 * gg[i].z * (1.f + sc0[i].z) + sh0[i].z, v0[i].w * rs0 * gg[i].w * (1.f + sc0[i].w) + sh0[i].w);
      *(uint2*)(P.h + (size_t)r0 * DM + col) = o;
      if (has1) {
        o.x = pack2(v1[i].x * rs1 * gg[i].x * (1.f + sc1[i].x) + sh1[i].x, v1[i].y * rs1 * gg[i].y * (1.f + sc1[i].y) + sh1[i].y);
        o.y = pack2(v1[i].z * rs1 * gg[i].z * (1.f + sc1[i].z) + sh1[i].z, v1[i].w * rs1 * gg[i].w * (1.f + sc1[i].w) + sh1[i].w);
        *(uint2*)(P.h + (size_t)r1 * DM + col) = o;
      }
    }
  }
}

namespace pg8 {
#define PG8_LAS __attribute__((address_space(3)))
typedef unsigned short bf16_t;
typedef ::bf16x8 bf16x8;
typedef ::f32x4 f32x4;
typedef unsigned u32x4 __attribute__((ext_vector_type(4)));
constexpr int BM = 256, BK = 64, HALF = 128, HTB = HALF * BK * 2  , STAGE_BYTES = 8 * HTB, NXCD = 8, WGM = 8;

__host__ __device__ __forceinline__ int lds_byte(int r, int c) { const int st = (r >> 4) * 2 + (c >> 5), rr = r & 15, cc = c & 31, ob = rr * 64 + cc * 2; return st * 1024 + (ob ^ (((ob >> 9) & 1) << 5)); }
__host__ __device__ __forceinline__ void stage_rc(int b, int& R, int& C) { const int st = b / 1024, sb = b % 1024, swz = sb ^ (((sb >> 9) & 1) << 5); R = (st >> 1) * 16 + swz / 64; C = (st & 1) * 32 + (swz % 64) / 2; }
__host__ __device__ __forceinline__ int perm32(int rho) { const int n = rho >> 4, i = rho & 15; return 8 * (i >> 2) + 4 * n + (i & 3); }

struct Unit { int pm, pn; int koff; };
struct Gemm { const bf16_t* A; const bf16_t* Bt; int M, N, K, ld; };
struct StaticOrder {
    int nM, nN, nwg, G, c;
    __host__ __device__ void init(int M, int N, int G_, int c_) { nM = M / BM; nN = N / BM; nwg = nM * nN; G = G_; c = c_; }
    __host__ __device__ bool next(int i, Unit& u) const {
        const long L = (long)i * G + c; if (L >= nwg) return false;
        int wgid = (int)L; { const int q = nwg / NXCD, r = nwg % NXCD, xcd = wgid % NXCD, off = wgid / NXCD; wgid = (xcd < r ? xcd * (q + 1) : r * (q + 1) + (xcd - r) * q) + off; }
        const int nig = WGM * nN, gid = wgid / nig, fm = gid * WGM, gsz = (nM - fm) < WGM ? (nM - fm) : WGM;
        u.pm = fm + ((wgid % nig) % gsz); u.pn = (wgid % nig) / gsz; u.koff = 0; return true;
    }
    __device__ __forceinline__ void a_ready(const Unit&) const {}
    __device__ __forceinline__ void done(const Unit&) const {}
};
template <class Epi, class Sched, bool STAMP = false>
__device__ __forceinline__ void gemm_phase(PG8_LAS unsigned char* lds, const Gemm g, const Sched& S, const Epi& E, unsigned long long* stamps) {
    const int tid = ltid(), wid = __builtin_amdgcn_readfirstlane(tid >> 6), lane = tid & 63, wr = wid >> 2, wc = wid & 3, fr = lane & 15, fq = lane >> 4;
    const int K = g.ld, nt = g.K / BK;
    int ts_lo = 0, ts_hi = 0, nts = 0; const unsigned long long rt_entry = STAMP ? (unsigned long long)wall_clock64() : 0ull;
#define PG8_STAMP() do { if (STAMP && wid == 0 && nts < 64) { const unsigned long long _c = (unsigned long long)clock64(); \
        ts_lo = (lane == nts) ? (int)(unsigned)_c : ts_lo; ts_hi = (lane == nts) ? (int)(unsigned)(_c >> 32) : ts_hi; ++nts; } } while (0)
    PG8_STAMP();
    unsigned voffA[2], voffB[2];
#pragma unroll
    for (int i = 0; i < 2; ++i) { int R, C; stage_rc(tid * 16 + i * 8192, R, C); const int Rb = Epi::PERM ? ((R & ~31) + perm32(R & 31)) : R;
        voffA[i] = (unsigned)(R * K + C) * 2u; voffB[i] = (unsigned)(Rb * K + C) * 2u; }
    const size_t kstep = (size_t)(BK * 2);
    const size_t hstep = (size_t)HALF * K * 2;
    const size_t tstep = 2 * hstep;
    const unsigned ldsw = (unsigned)wid * 1024u;
    const int aoff = lds_byte(wr * 64 + fr, fq * 8), boff = lds_byte(wc * 32 + fr, fq * 8);
#define PG8_SA(b, h) (((b) * 2 + (h)) * HTB)
#define PG8_SB(b, h) ((4 + (b) * 2 + (h)) * HTB)
#define PG8_STAGE(bufoff, gbase, voff) do { _Pragma("unroll") for (int _i = 0; _i < 2; ++_i) \
        __builtin_amdgcn_global_load_lds((const unsigned*)((const char*)(gbase) + (voff)[_i]), (PG8_LAS unsigned*)(lds + (bufoff) + ldsw + _i * 8192), 16, 0, 0); } while (0)
#define PG8_LDA(dst, b, h) do { _Pragma("unroll") for (int m = 0; m < 4; ++m) _Pragma("unroll") for (int k = 0; k < 2; ++k) dst[m][k] = *(const PG8_LAS bf16x8*)(lds + PG8_SA(b, h) + aoff + m * 2048 + k * 1024); } while (0)
#define PG8_LDB(dst, b, h) do { _Pragma("unroll") for (int n = 0; n < 2; ++n) _Pragma("unroll") for (int k = 0; k < 2; ++k) dst[n][k] = *(const PG8_LAS bf16x8*)(lds + PG8_SB(b, h) + boff + n * 2048 + k * 1024); } while (0)
#define PG8_MMA(ai, bj, At, Bt) do { __builtin_amdgcn_s_setprio(1); _Pragma("unroll") for (int m = 0; m < 4; ++m) _Pragma("unroll") for (int n = 0; n < 2; ++n) _Pragma("unroll") for (int k = 0; k < 2; ++k) \
        acc[ai][bj][m][n] = __builtin_amdgcn_mfma_f32_16x16x32_bf16(Bt[n][k], At[m][k], acc[ai][bj][m][n], 0, 0, 0); __builtin_amdgcn_s_setprio(0); } while (0)
#define PG8_WAIT_V(n) asm volatile("s_waitcnt vmcnt(" #n ")" ::: "memory")
#define PG8_WAIT_L(n) asm volatile("s_waitcnt lgkmcnt(" #n ")" ::: "memory")
#define PG8_BAR __builtin_amdgcn_s_barrier()
#define PG8_SCHED __builtin_amdgcn_sched_barrier(0)
    Unit cur, nxt; int ui = 0;
    if (!S.next(0, cur)) return;
    f32x4 acc[2][2][4][2];
#pragma unroll
    for (int a = 0; a < 2; ++a)
#pragma unroll
        for (int b = 0; b < 2; ++b)
#pragma unroll
            for (int m = 0; m < 4; ++m)
#pragma unroll
                for (int n = 0; n < 2; ++n) acc[a][b][m][n] = (f32x4){0.f, 0.f, 0.f, 0.f};
    bf16x8 At[4][2], B0[2][2], B1[2][2];
    const char* cA = (const char*)g.A + (size_t)cur.pm * tstep + cur.koff; const char* cB = (const char*)g.Bt + (size_t)cur.pn * tstep + cur.koff;
    S.a_ready(cur);
    PG8_STAGE(PG8_SB(0, 0), cB, voffB); PG8_STAGE(PG8_SA(0, 0), cA, voffA); PG8_STAGE(PG8_SB(0, 1), cB + hstep, voffB); PG8_STAGE(PG8_SA(0, 1), cA + hstep, voffA);
    if (wr == 1) PG8_BAR;
    PG8_WAIT_V(4); PG8_BAR;
    PG8_STAGE(PG8_SB(1, 0), cB + kstep, voffB); PG8_STAGE(PG8_SA(1, 0), cA + kstep, voffA); PG8_STAGE(PG8_SB(1, 1), cB + hstep + kstep, voffB);
    PG8_WAIT_V(6); PG8_BAR;
    PG8_STAMP();
    for (;;) {
        const bool has_next = S.next(ui + 1, nxt);
        const char* nA = has_next ? (const char*)g.A + (size_t)nxt.pm * tstep + nxt.koff : cA; const char* nB = has_next ? (const char*)g.Bt + (size_t)nxt.pn * tstep + nxt.koff : cB;
        for (int t = 0; t < nt; t += 2) {
            const bool last = (t == nt - 2);
            const char* a1 = cA + (size_t)(t + 1) * kstep;
            const char* a2 = last ? nA : cA + (size_t)(t + 2) * kstep; const char* b2 = last ? nB : cB + (size_t)(t + 2) * kstep;
            const char* a3 = a2 + kstep; const char* b3 = b2 + kstep;
            if (last && has_next) S.a_ready(nxt);
            PG8_LDB(B0, 0, 0); PG8_SCHED; PG8_LDA(At, 0, 0); PG8_STAGE(PG8_SA(1, 1), a1 + hstep, voffA);
            PG8_WAIT_L(8); PG8_BAR; PG8_WAIT_L(0); PG8_MMA(0, 0, At, B0); PG8_BAR; PG8_SCHED;
            PG8_LDB(B1, 0, 1); PG8_STAGE(PG8_SB(0, 0), b2, voffB);
            PG8_BAR; PG8_WAIT_L(0); PG8_MMA(0, 1, At, B1); PG8_BAR;
            PG8_LDA(At, 0, 1); PG8_STAGE(PG8_SA(0, 0), a2, voffA);
            PG8_BAR; PG8_WAIT_L(0); PG8_MMA(1, 0, At, B0); PG8_BAR; PG8_SCHED;
            PG8_STAGE(PG8_SB(0, 1), b2 + hstep, voffB);
            PG8_WAIT_V(6); PG8_BAR; PG8_MMA(1, 1, At, B1); PG8_BAR;
            PG8_LDB(B0, 1, 0); PG8_SCHED; PG8_LDA(At, 1, 0); PG8_STAGE(PG8_SA(0, 1), a2 + hstep, voffA);
            PG8_WAIT_L(8); PG8_BAR; PG8_WAIT_L(0); PG8_MMA(0, 0, At, B0); PG8_BAR; PG8_SCHED;
            PG8_LDB(B1, 1, 1); PG8_STAGE(PG8_SB(1, 0), b3, voffB);
            PG8_BAR; PG8_WAIT_L(0); PG8_MMA(0, 1, At, B1); PG8_BAR;
            PG8_LDA(At, 1, 1); PG8_STAGE(PG8_SA(1, 0), a3, voffA);
            PG8_BAR; PG8_WAIT_L(0); PG8_MMA(1, 0, At, B0); PG8_BAR; PG8_SCHED;
            PG8_STAGE(PG8_SB(1, 1), b3 + hstep, voffB);
            PG8_WAIT_V(6); PG8_BAR; PG8_MMA(1, 1, At, B1); PG8_BAR;
        }
        PG8_STAMP();
        if constexpr (!Epi::AFTER_DRAIN) { E(acc, cur, wr, wc, fr, fq); S.done(cur); }
        PG8_STAMP();
        if (!has_next) break;
#pragma unroll
        for (int a = 0; a < 2; ++a)
#pragma unroll
            for (int b = 0; b < 2; ++b)
#pragma unroll
                for (int m = 0; m < 4; ++m)
#pragma unroll
                    for (int n = 0; n < 2; ++n) acc[a][b][m][n] = (f32x4){0.f, 0.f, 0.f, 0.f};
        cur = nxt; cA = nA; cB = nB; ++ui;
    }
    PG8_WAIT_V(0);
    if (wr == 0) PG8_BAR;
    PG8_BAR;
    if constexpr (Epi::AFTER_DRAIN) { E.fused(acc, cur, wr, wc, fr, fq, lds, wid, lane); S.done(cur); }
    PG8_STAMP();
    if (STAMP && wid == 0) { stamps[lane] = lane < nts ? (((unsigned long long)(unsigned)ts_hi << 32) | (unsigned)ts_lo) : 0ull;
        if (lane == 62) stamps[62] = rt_entry; if (lane == 63) stamps[63] = (unsigned long long)wall_clock64(); }
#undef PG8_STAMP
#undef PG8_SA
#undef PG8_SB
#undef PG8_STAGE
#undef PG8_LDA
#undef PG8_LDB
#undef PG8_MMA
#undef PG8_WAIT_V
#undef PG8_WAIT_L
#undef PG8_BAR
#undef PG8_SCHED
}
}

struct EpiZin {
  static constexpr bool PERM = true, AFTER_DRAIN = false;
  ushort_t* z; float* gates;
  __device__ __forceinline__ void operator()(const pg8::f32x4 (&acc)[2][2][4][2], const pg8::Unit& u, int wr, int wc, int fr, int fq) const {
    asm volatile("" : "+v"(fr), "+v"(fq));
    const int row0 = u.pm * 256 + wr * 64 + fr, col0 = u.pn * 256 + wc * 32 + 8 * fq;
#pragma unroll
    for (int ai = 0; ai < 2; ++ai)
#pragma unroll
      for (int m = 0; m < 4; ++m) {
        const size_t row = (size_t)(row0 + ai * 128 + m * 16);
#pragma unroll
        for (int bj = 0; bj < 2; ++bj) {
          const int col = col0 + bj * 128;
          if (col < IND) {
            const pg8::f32x4 v0 = acc[ai][bj][m][0], v1 = acc[ai][bj][m][1];
            *(uint4*)(z + row * IND + col) = make_uint4(pack2(v0[0], v0[1]), pack2(v0[2], v0[3]), pack2(v1[0], v1[1]), pack2(v1[2], v1[3]));
            if (col >= ZC_MLG && col < ZC_MLG + 16) {
              float* gp = gates + row * 48 + (col - ZC_MLG);
              *(float4*)gp = make_float4(v0[0], v0[1], v0[2], v0[3]); *(float4*)(gp + 4) = make_float4(v1[0], v1[1], v1[2], v1[3]);
            } else if (col >= ZC_GLA) {
              float* gp = gates + row * 48 + 16 + (col - ZC_GLA);
              *(float4*)gp = make_float4(v0[0], v0[1], v0[2], v0[3]); *(float4*)(gp + 4) = make_float4(v1[0], v1[1], v1[2], v1[3]);
            }
          }
        }
      }
  }
};
struct EpiGlu {
  static constexpr bool PERM = true, AFTER_DRAIN = false;
  const ushort_t* s5g; const float* bias; ushort_t* mix;
  __device__ __forceinline__ void operator()(const pg8::f32x4 (&acc)[2][2][4][2], const pg8::Unit& u, int wr, int wc, int fr, int fq) const {
    asm volatile("" : "+v"(fr), "+v"(fq));
    const int row0 = u.pm * 256 + wr * 64 + fr, col0 = wc * 32 + 8 * fq;
    float4 bz[2][2];
#pragma unroll
    for (int bj = 0; bj < 2; ++bj) { bz[bj][0] = *(const float4*)(bias + col0 + bj * 128); bz[bj][1] = *(const float4*)(bias + col0 + bj * 128 + 4); }
#pragma unroll
    for (int ai = 0; ai < 2; ++ai) {
      uint4 gx[4][2];
#pragma unroll
      for (int m = 0; m < 4; ++m)
#pragma unroll
        for (int bj = 0; bj < 2; ++bj) gx[m][bj] = *(const uint4*)(s5g + (size_t)(row0 + ai * 128 + m * 16) * 256 + col0 + bj * 128);
#pragma unroll
      for (int m = 0; m < 4; ++m) {
        const size_t row = (size_t)(row0 + ai * 128 + m * 16);
#pragma unroll
        for (int bj = 0; bj < 2; ++bj) {
          const int col = col0 + bj * 128;
          float g[8], o[8];
          unpack8(gx[m][bj], g);
          const float4 b0 = bz[bj][0], b1 = bz[bj][1];
          const pg8::f32x4 v0 = acc[ai][bj][m][0], v1 = acc[ai][bj][m][1];
          o[0] = g[0] * sigmoidf_(v0[0] + b0.x); o[1] = g[1] * sigmoidf_(v0[1] + b0.y); o[2] = g[2] * sigmoidf_(v0[2] + b0.z); o[3] = g[3] * sigmoidf_(v0[3] + b0.w);
          o[4] = g[4] * sigmoidf_(v1[0] + b1.x); o[5] = g[5] * sigmoidf_(v1[1] + b1.y); o[6] = g[6] * sigmoidf_(v1[2] + b1.z); o[7] = g[7] * sigmoidf_(v1[3] + b1.w);
          *(uint4*)(mix + row * DM + col) = make_uint4(pack2(o[0], o[1]), pack2(o[2], o[3]), pack2(o[4], o[5]), pack2(o[6], o[7]));
        }
      }
    }
  }
};
struct EpiW1 {
  static constexpr bool PERM = true, AFTER_DRAIN = false;
  ushort_t* hidden;
  __device__ __forceinline__ void operator()(const pg8::f32x4 (&acc)[2][2][4][2], const pg8::Unit& u, int wr, int wc, int fr, int fq) const {
    asm volatile("" : "+v"(fr), "+v"(fq));
    const int row0 = u.pm * 256 + wr * 64 + fr, col0 = u.pn * 256 + wc * 32 + 8 * fq;
#pragma unroll
    for (int ai = 0; ai < 2; ++ai)
#pragma unroll
      for (int m = 0; m < 4; ++m) {
        const size_t row = (size_t)(row0 + ai * 128 + m * 16);
#pragma unroll
        for (int bj = 0; bj < 2; ++bj) {
          float o[8];
#pragma unroll
          for (int e = 0; e < 4; ++e) { float a = fmaxf(acc[ai][bj][m][0][e], 0.f), c = fmaxf(acc[ai][bj][m][1][e], 0.f); o[e] = a * a; o[4 + e] = c * c; }
          *(uint4*)(hidden + row * DFF + col0 + bj * 128) = make_uint4(pack2(o[0], o[1]), pack2(o[2], o[3]), pack2(o[4], o[5]), pack2(o[6], o[7]));
        }
      }
  }
};
template <bool ATOMIC>
struct EpiRes {
  static constexpr bool PERM = false, AFTER_DRAIN = false;
  float* xres; const float* gate;
  __device__ __forceinline__ void operator()(const pg8::f32x4 (&acc)[2][2][4][2], const pg8::Unit& u, int wr, int wc, int fr, int fq) const {
    asm volatile("" : "+v"(fr), "+v"(fq));
    const int row0 = u.pm * 256 + wr * 64 + fr, col0 = u.pn * 256 + wc * 32 + 4 * fq;
#pragma unroll
    for (int am = 0; am < 4; ++am) {
      const int ai = am >> 1;
      float4 gv[2][4], xv[2][4];
#pragma unroll
      for (int mm = 0; mm < 2; ++mm) {
        const int m = (am & 1) * 2 + mm;
        const int row = row0 + ai * 128 + m * 16;
        const int b = row / TOK, t = row % TOK;
        const float* gr = gate + ((t < CTX) ? 2 : b) * 6144;
        const float* xp = xres + (size_t)row * DM;
#pragma unroll
        for (int q = 0; q < 4; ++q) {
          const int col = col0 + (q >> 1) * 128 + (q & 1) * 16;
          gv[mm][q] = *(const float4*)(gr + col);
          if (!ATOMIC) xv[mm][q] = *(const float4*)(xp + col);
        }
      }
#pragma unroll
      for (int mm = 0; mm < 2; ++mm) {
        const int m = (am & 1) * 2 + mm;
        const int row = row0 + ai * 128 + m * 16;
        float* xp = xres + (size_t)row * DM;
#pragma unroll
        for (int q = 0; q < 4; ++q) {
          const int col = col0 + (q >> 1) * 128 + (q & 1) * 16;
          const pg8::f32x4 v = acc[ai][q >> 1][m][q & 1];
          const float4 g4 = gv[mm][q];
          if (ATOMIC) {
            atomicAdd(xp + col, g4.x * v[0]); atomicAdd(xp + col + 1, g4.y * v[1]); atomicAdd(xp + col + 2, g4.z * v[2]); atomicAdd(xp + col + 3, g4.w * v[3]);
          } else {
            float4 x = xv[mm][q];
            x.x += g4.x * v[0]; x.y += g4.y * v[1]; x.z += g4.z * v[2]; x.w += g4.w * v[3];
            *(float4*)(xp + col) = x;
          }
        }
      }
    }
  }
};
struct TailOrder {
  int first, nN, nun, nsplit, kbytes, c;
  __device__ bool next(int i, pg8::Unit& u) const {
    if (i > 0 || c >= nun * nsplit) return false;
    const int t = first + c / nsplit;
    u.pm = t / nN; u.pn = t % nN; u.koff = (c % nsplit) * kbytes; return true;
  }
  __device__ __forceinline__ void a_ready(const pg8::Unit&) const {}
  __device__ __forceinline__ void done(const pg8::Unit&) const {}
};
struct RowOrder {
  int nN, ntile, G, c;
  __device__ bool next(int i, pg8::Unit& u) const {
    const int t = i * G + c;
    if (t >= ntile) return false;
    u.pm = t / nN; u.pn = t % nN; u.koff = 0; return true;
  }
  __device__ __forceinline__ void a_ready(const pg8::Unit&) const {}
  __device__ __forceinline__ void done(const pg8::Unit&) const {}
};
enum { G_ZIN = 0, G_GLU = 1, G_WOUT = 2, G_W1 = 3, G_W2 = 4 };
template <int MODE>
__device__ void gemm_phase(const Params& P, int l, int bid, int nblk, char* smem) {
  PG8_LAS unsigned char* lds = (PG8_LAS unsigned char*)smem;
  __syncthreads();
  if (MODE == G_ZIN) {
    pg8::Gemm g{P.h, P.wt_in, NTOK, INDP, DM, DM};
    pg8::StaticOrder S; S.init(NTOK, INDP, nblk, bid);
    EpiZin E{P.z, P.gates};
    pg8::gemm_phase<EpiZin, pg8::StaticOrder, false>(lds, g, S, E, nullptr);
  } else if (MODE == G_GLU) {
    const int kg = launder_s(256);
    pg8::Gemm g{P.s5g, P.glut, NTOK, 256, kg, kg};
    pg8::StaticOrder S; S.init(NTOK, 256, nblk, bid);
    EpiGlu E{P.s5g, P.s5_glu_b + l * 256, P.mix};
    pg8::gemm_phase<EpiGlu, pg8::StaticOrder, false>(lds, g, S, E, nullptr);
  } else if (MODE == G_W1) {
    pg8::Gemm g{P.h, P.w1t, NTOK, DFF, DM, DM};
    pg8::StaticOrder S; S.init(NTOK, DFF, nblk, bid);
    EpiW1 E{P.hidden};
    pg8::gemm_phase<EpiW1, pg8::StaticOrder, false>(lds, g, S, E, nullptr);
  } else {
    const ushort_t* A = MODE == G_WOUT ? P.mix : P.hidden;
    const ushort_t* Bt = MODE == G_WOUT ? P.wt_out : P.w2t;
    const int K = MODE == G_WOUT ? DM : DFF;
    const float* gate = P.mod + (size_t)l * 3 * 6144 + (MODE == G_WOUT ? 2048 : 5120);
    const int ntile = (NTOK / 256) * 4;
    const int nfull = (ntile / nblk) * nblk;
    {
      pg8::Gemm g{A, Bt, NTOK, DM, K, K};
      RowOrder S{4, nfull, nblk, bid};
      EpiRes<false> E{P.xres, gate};
      pg8::gemm_phase<EpiRes<false>, RowOrder, false>(lds, g, S, E, nullptr);
    }
    if (nfull < ntile) {
      const int nun = ntile - nfull;
      int nsplit = nblk / nun; if (nsplit > K / 256) nsplit = K / 256; if (nsplit < 1) nsplit = 1;
      while ((K / 256) % nsplit) --nsplit;
      const int ks = K / nsplit;
      __syncthreads();
      pg8::Gemm g{A, Bt, NTOK, DM, ks, K};
      TailOrder S{nfull, 4, nun, nsplit, ks * 2, bid};
      EpiRes<true> E{P.xres, gate};
      pg8::gemm_phase<EpiRes<true>, TailOrder, false>(lds, g, S, E, nullptr);
    }
  }
  __syncthreads();
}

__device__ void s5_build_tab(const Params& P, int l, int dg, int lane);
__device__ void phase_prep(const Params& P, int l, int bid, int nblk, bool skip_rope = false) {
  {
    const int gw = bid * NW + (ltid() >> 6);
    if (gw < 32) s5_build_tab(P, l, gw, ltid() & 63);
  }
  const size_t gtid = (size_t)bid * NT + ltid(), gstride = (size_t)nblk * NT;
  const int cg = (int)(gtid & 63);
  const size_t nit = (size_t)NTOK * 64;
  {
    const int c = cg * 8;
    const float* cwp = P.ml_conv_w + (size_t)l * 3 * 512 + c;
    float w0[8], w1[8], w2[8], cb[8];
#pragma unroll
    for (int e = 0; e < 8; ++e) { w0[e] = cwp[e]; w1[e] = cwp[512 + e]; w2[e] = cwp[1024 + e]; cb[e] = P.ml_conv_b[l * 512 + c + e]; }
    const float sc = (c >= 256) ? 0.125f : 1.f;
    for (size_t idx0 = gtid; idx0 < nit; idx0 += 2 * gstride) {
      uint4 x0[2], xm[2], xp[2];
      bool hp[2], hn[2], ok[2];
      int rr[2];
#pragma unroll
      for (int q = 0; q < 2; ++q) {
        const size_t idx = idx0 + q * gstride;
        ok[q] = idx < nit;
        const int r = ok[q] ? (int)(idx >> 6) : (int)(idx0 >> 6);
        rr[q] = r;
        const int t = r % TOK;
        hp[q] = (t != 0 && t != CTX); hn[q] = (t != CTX - 1 && t != TOK - 1);
        x0[q] = *(const uint4*)(P.z + (size_t)r * IND + ZC_MLQ + c);
        xm[q] = *(const uint4*)(P.z + (size_t)(hp[q] ? r - 1 : r) * IND + ZC_MLQ + c);
        xp[q] = *(const uint4*)(P.z + (size_t)(hn[q] ? r + 1 : r) * IND + ZC_MLQ + c);
      }
#pragma unroll
      for (int q = 0; q < 2; ++q) {
        float a0[8], am[8], ap[8], o[8];
        unpack8(x0[q], a0); unpack8(xm[q], am); unpack8(xp[q], ap);
#pragma unroll
        for (int e = 0; e < 8; ++e) {
          float y = w1[e] * a0[e] + cb[e];
          if (hp[q]) y += w0[e] * am[e];
          if (hn[q]) y += w2[e] * ap[e];
          o[e] = y * sigmoidf_(y) * sc;
        }
        if (ok[q]) *(uint4*)(P.mlqk + (size_t)rr[q] * 512 + c) = make_uint4(pack2(o[0], o[1]), pack2(o[2], o[3]), pack2(o[4], o[5]), pack2(o[6], o[7]));
      }
    }
  }
  {
    const int dk = cg * 4, d = dk >> 7, kk = dk & 127;
    const float* W = P.gla_alpha_w + ((size_t)(l * 2 + d) * 16) * 128 + kk;
    float4 wr[16];
#pragma unroll
    for (int q = 0; q < 16; ++q) wr[q] = *(const float4*)(W + q * 128);
    const float4 bias = *(const float4*)(P.gla_alpha_b + (l * 2 + d) * 128 + kk);
    for (size_t idx0 = gtid; idx0 < nit; idx0 += 2 * gstride) {
      float4 ga[2][4];
      bool ok[2];
      int rr[2];
#pragma unroll
      for (int q = 0; q < 2; ++q) {
        const size_t idx = idx0 + q * gstride;
        ok[q] = idx < nit;
        rr[q] = ok[q] ? (int)(idx >> 6) : (int)(idx0 >> 6);
        const float4* a4 = (const float4*)(P.gates + (size_t)rr[q] * 48 + 16 + d * 16);
#pragma unroll
        for (int e = 0; e < 4; ++e) ga[q][e] = a4[e];
      }
#pragma unroll
      for (int q = 0; q < 2; ++q) {
        float4 v = bias;
#pragma unroll
        for (int e = 0; e < 4; ++e) {
          const float av[4] = {ga[q][e].x, ga[q][e].y, ga[q][e].z, ga[q][e].w};
#pragma unroll
          for (int f = 0; f < 4; ++f) {
            const float4 w = wr[e * 4 + f];
            v.x += av[f] * w.x; v.y += av[f] * w.y; v.z += av[f] * w.z; v.w += av[f] * w.w;
          }
        }
        float4 o;
        o.x = __expf(logsigmoidf_(v.x) * (1.f / 16.f)); o.y = __expf(logsigmoidf_(v.y) * (1.f / 16.f));
        o.z = __expf(logsigmoidf_(v.z) * (1.f / 16.f)); o.w = __expf(logsigmoidf_(v.w) * (1.f / 16.f));
        if (ok[q]) *(float4*)(P.alpha + (size_t)rr[q] * 256 + dk) = o;
      }
    }
  }
  if (skip_rope) return;
  {
    const float qscale = 0.17677669529663687f * 1.4426950408889634f;
    const int which = cg >> 5, hm = (cg >> 2) & 7, quad = cg & 3;
    const int f0 = (quad & 1) * 4;
    float inv[4];
#pragma unroll
    for (int e = 0; e < 4; ++e) {
      const int f = f0 + e;
      inv[e] = f == 0 ? 1.f : f == 1 ? 0.31622776601683794f : f == 2 ? 0.1f : f == 3 ? 0.031622776601683794f
             : f == 4 ? 0.01f : f == 5 ? 0.0031622776601683794f : f == 6 ? 0.001f : 0.00031622776601683794f;
    }
    const int colb = (which ? ZC_DAK : ZC_DAQ) + hm * 32 + quad * 8;
    for (size_t idx0 = gtid; idx0 < nit; idx0 += 2 * gstride) {
      uint4 xv[2];
      bool ok[2];
      int rr[2];
#pragma unroll
      for (int q = 0; q < 2; ++q) {
        const size_t idx = idx0 + q * gstride;
        ok[q] = idx < nit;
        rr[q] = ok[q] ? (int)(idx >> 6) : (int)(idx0 >> 6);
        xv[q] = *(const uint4*)(P.z + (size_t)rr[q] * IND + colb);
      }
#pragma unroll
      for (int q = 0; q < 2; ++q) {
        float x[8];
        unpack8(xv[q], x);
        const int t = rr[q] % TOK;
        if (t >= CTX) {
          const int tl = t - CTX;
          const float posv = (quad < 2) ? (float)(tl >> 6) : (float)(tl & 63);
#pragma unroll
          for (int e = 0; e < 4; ++e) {
            const float ang = posv * inv[e];
            const float cs = __cosf(ang), sn = __sinf(ang);
            const float x1 = x[2 * e], x2 = x[2 * e + 1];
            x[2 * e] = x1 * cs - x2 * sn;
            x[2 * e + 1] = x1 * sn + x2 * cs;
          }
        }
        if (!which) {
#pragma unroll
          for (int e = 0; e < 8; ++e) x[e] *= qscale;
        }
        if (ok[q]) *(uint4*)(P.z + (size_t)rr[q] * IND + colb) = make_uint4(pack2(x[0], x[1]), pack2(x[2], x[3]), pack2(x[4], x[5]), pack2(x[6], x[7]));
      }
    }
  }
}

struct S5Lam { float lbr, lbi; };
__device__ __forceinline__ void s5_disc(const Params& P, int gi, int p, float dt, float& lbr, float& lbi, float& fr_, float& fi_) {
  const int idx = gi * 64 + p;
  const float lre = P.s5_lam_re[idx], lim = P.s5_lam_im[idx];
  const float mag = __expf(lre * dt);
  lbr = mag * __cosf(lim * dt); lbi = mag * __sinf(lim * dt);
  const float den = lre * lre + lim * lim;
  fr_ = ((lbr - 1.f) * lre + lbi * lim) / den;
  fi_ = (lbi * lre - (lbr - 1.f) * lim) / den;
}
__device__ __forceinline__ void s5_bfrags(const Params& P, int l, int d, int g, int lane, bf16x8 (&bfr)[8], S5Lam& lam) {
  const int fr = lane & 15, fq = lane >> 4;
  const int gi = (l * 2 + d) * 16 + g;
  const float dt = __expf(P.s5_log_step[gi]);
  {
    float a, b2;
    s5_disc(P, gi, lane, dt, lam.lbr, lam.lbi, a, b2);
  }
#pragma unroll
  for (int nt = 0; nt < 8; ++nt) {
    const int n = nt * 16 + fr, p = n >> 1, ri = n & 1;
    float lbr, lbi, fr_, fi_;
    s5_disc(P, gi, p, dt, lbr, lbi, fr_, fi_);
    const float* bre = P.s5_b_re + (size_t)(gi * 64 + p) * 16 + (fq & 1) * 8;
    const float* bim = P.s5_b_im + (size_t)(gi * 64 + p) * 16 + (fq & 1) * 8;
#pragma unroll
    for (int e = 0; e < 8; ++e) {
      const float br = bre[e], bi = bim[e];
      float v = ri == 0 ? fr_ * br - fi_ * bi : fr_ * bi + fi_ * br;
      if (fq >= 2) v = 0.f;
      bfr[nt][e] = (short)f2bf(v);
    }
  }
}
__device__ __forceinline__ void s5_cfrags(const Params& P, int l, int d, int g, int lane, bf16x8 (&cb)[4]) {
  const int fr = lane & 15, fq = lane >> 4;
  const float* cre = P.s5_c_re + ((size_t)((l * 2 + d) * 16 + g) * 16 + fr) * 64;
  const float* cim = P.s5_c_im + ((size_t)((l * 2 + d) * 16 + g) * 16 + fr) * 64;
#pragma unroll
  for (int ks = 0; ks < 4; ++ks) {
#pragma unroll
    for (int e = 0; e < 8; ++e) {
      int k = ks * 32 + fq * 8 + e, p = k >> 1;
      float v = (e & 1) ? -cim[p] : cre[p];
      cb[ks][e] = (short)f2bf(v);
    }
  }
}
__device__ void s5_build_tab(const Params& P, int l, int dg, int lane) {
  bf16x8 bfr[8], cb[4];
  S5Lam lam;
  s5_bfrags(P, l, dg >> 4, dg & 15, lane, bfr, lam);
  s5_cfrags(P, l, dg >> 4, dg & 15, lane, cb);
  uint4* t = P.s5tab + (size_t)dg * 13 * 64 + lane;
#pragma unroll
  for (int f = 0; f < 8; ++f) t[f * 64] = __builtin_bit_cast(uint4, bfr[f]);
#pragma unroll
  for (int f = 0; f < 4; ++f) t[(8 + f) * 64] = __builtin_bit_cast(uint4, cb[f]);
  t[12 * 64] = make_uint4(__float_as_uint(lam.lbr), __float_as_uint(lam.lbi), 0u, 0u);
}
__device__ __forceinline__ void s5_load_tab(const Params& P, int d, int g, int lane, bf16x8 (&bfr)[8], S5Lam& lam) {
  const uint4* t = P.s5tab + (size_t)(d * 16 + g) * 13 * 64 + lane;
#pragma unroll
  for (int f = 0; f < 8; ++f) bfr[f] = __builtin_bit_cast(bf16x8, t[f * 64]);
  const uint4 lv = t[12 * 64];
  lam.lbr = __uint_as_float(lv.x); lam.lbi = __uint_as_float(lv.y);
}
__device__ __forceinline__ void s5_load_ctab(const Params& P, int d, int g, int lane, bf16x8 (&cb)[4]) {
  const uint4* t = P.s5tab + (size_t)(d * 16 + g) * 13 * 64 + lane;
#pragma unroll
  for (int f = 0; f < 4; ++f) cb[f] = __builtin_bit_cast(bf16x8, t[(8 + f) * 64]);
}
#define S5_BU_STRIDE 132
__device__ __forceinline__ uint4 s5_load_u(const Params& P, size_t row0, int g, int DIRv, int sbi, int lane) {
  const int fr = lane & 15, fq = lane >> 4;
  const int sp = sbi * 16 + fr;
  const size_t row = row0 + (DIRv == 0 ? sp : 127 - sp);
  uint4 a = make_uint4(0u, 0u, 0u, 0u);
  if (fq < 2) a = *(const uint4*)(P.z + row * IND + ZC_S5U + g * 16 + fq * 8);
  return a;
}
__device__ __forceinline__ void s5_bu_to_lds(const uint4 ua, const bf16x8 (&bfr)[8], float* BuS, int lane) {
  const int fr = lane & 15, fq = lane >> 4;
  const bf16x8 a = __builtin_bit_cast(bf16x8, ua);
#pragma unroll
  for (int nt = 0; nt < 8; ++nt) {
    f32x4 acc = f32x4{0.f, 0.f, 0.f, 0.f};
    acc = __builtin_amdgcn_mfma_f32_16x16x32_bf16(a, bfr[nt], acc, 0, 0, 0);
#pragma unroll
    for (int jx = 0; jx < 4; ++jx) BuS[(fq * 4 + jx) * S5_BU_STRIDE + nt * 16 + fr] = acc[jx];
  }
}
__device__ void unit_s5_p1(const Params& P, int l, int unit, char* smem) {
  const int wid = ltid() >> 6, lane = ltid() & 63;
  float* BuS = (float*)(smem + wid * (16 * S5_BU_STRIDE * 4));
  {
    int item = unit * NW + wid;
    int c = item % NCH, g = (item / NCH) % 16, d = (item / (NCH * 16)) % 2, b = item / (NCH * 32);
    int j = dir_chunk(d, c);
    const size_t row0 = (size_t)(b * TOK + j * 128);
    bf16x8 bfr[8];
    S5Lam lam;
    s5_load_tab(P, d, g, lane, bfr, lam);
    float hr = 0.f, hi = 0.f;
    uint4 ua = s5_load_u(P, row0, g, d, 0, lane);
    for (int sbi = 0; sbi < 8; ++sbi) {
      __syncthreads();
      s5_bu_to_lds(ua, bfr, BuS, lane);
      __syncthreads();
      if (sbi + 1 < 8) ua = s5_load_u(P, row0, g, d, sbi + 1, lane);
      for (int tii = 0; tii < 16; ++tii) {
        const float2 bu = *(const float2*)(BuS + tii * S5_BU_STRIDE + 2 * lane);
        const float nr = lam.lbr * hr - lam.lbi * hi + bu.x;
        const float ni = lam.lbr * hi + lam.lbi * hr + bu.y;
        hr = nr; hi = ni;
      }
    }
    float2* st = (float2*)(P.s5st + (size_t)item * 128);
    st[lane] = make_float2(hr, hi);
  }
}
__device__ void phase_s5_p2(const Params& P, int l, int bid, int nblk) {
  const int wid = ltid() >> 6, lane = ltid() & 63;
  for (int it = ((bid + nblk - 194 % nblk) % nblk) * NW + wid; it < B_ * 2 * 16; it += nblk * NW) {
    int g = it % 16, d = (it / 16) % 2;
    int gi = (l * 2 + d) * 16 + g, idx = gi * 64 + lane;
    float lre = P.s5_lam_re[idx], lim = P.s5_lam_im[idx];
    float dt = __expf(P.s5_log_step[gi]);
    float mag = __expf(lre * dt);
    float ar = mag * __cosf(lim * dt), ai = mag * __sinf(lim * dt);
#pragma unroll
    for (int i = 0; i < 7; ++i) { float nr = ar * ar - ai * ai, t = ar * ai, ni = t + t; ar = nr; ai = ni; }
    float cr, ci;
    asm volatile("v_mov_b32 %0, 0\n\tv_mov_b32 %1, 0" : "=v"(cr), "=v"(ci));
    float2* st = (float2*)(P.s5st + (size_t)it * NCH * 128);
    for (int c0 = 0; c0 < NCH; c0 += 26) {
      float2 x[26];
#pragma unroll
      for (int i = 0; i < 26; ++i) x[i] = st[(c0 + i) * 64 + lane];
#pragma unroll
      for (int i = 0; i < 26; ++i) {
        st[(c0 + i) * 64 + lane] = make_float2(cr, ci);
        float nr = ar * cr - ai * ci + x[i].x;
        float ni = ar * ci + ai * cr + x[i].y;
        cr = nr; ci = ni;
      }
    }
  }
}
template <int DIR>
__device__ __forceinline__ void s5_p3_dir(const Params& P, int l, int b, int g, int j, int lane, float* BuS, ushort_t* hs, ushort_t* ys) {
  const int fr = lane & 15, fq = lane >> 4;
  const int c = dir_chunk(DIR, j);
  const size_t row0 = (size_t)(b * TOK + j * 128);
  bf16x8 bfr[8];
  S5Lam lam;
  s5_load_tab(P, DIR, g, lane, bfr, lam);
  bf16x8 cb[4];
  s5_load_ctab(P, DIR, g, lane, cb);
  float2 st = ((const float2*)(P.s5st + (size_t)(((b * 2 + DIR) * 16 + g) * NCH + c) * 128))[lane];
  float hr = st.x, hi = st.y;
  const int col = g * 16 + fr;
  const float dsk = P.s5_d[l * 256 + col];
  uint4 ua = s5_load_u(P, row0, g, DIR, 0, lane);
#pragma unroll 1
  for (int sbi = 0; sbi < 8; ++sbi) {
    const int nsb = DIR == 0 ? sbi : 7 - sbi;
    __syncthreads();
    s5_bu_to_lds(ua, bfr, BuS, lane);
    __syncthreads();
    if (sbi + 1 < 8) ua = s5_load_u(P, row0, g, DIR, sbi + 1, lane);
    ushort_t uraw[4] = {0, 0, 0, 0};
    if (DIR == 1) {
#pragma unroll
      for (int jx = 0; jx < 4; ++jx) uraw[jx] = P.z[(row0 + nsb * 16 + fq * 4 + jx) * IND + ZC_S5U + col];
    }
    for (int tii = 0; tii < 16; ++tii) {
      const int tin = DIR == 0 ? tii : 15 - tii;
      const float2 bu = *(const float2*)(BuS + tii * S5_BU_STRIDE + 2 * lane);
      const float nr = lam.lbr * hr - lam.lbi * hi + bu.x;
      const float ni = lam.lbr * hi + lam.lbi * hr + bu.y;
      hr = nr; hi = ni;
      *(unsigned*)(hs + tin * 136 + 2 * lane) = pack2(hr, hi);
    }
    __syncthreads();
    f32x4 acc = f32x4{0.f, 0.f, 0.f, 0.f};
#pragma unroll
    for (int ks = 0; ks < 4; ++ks) {
      bf16x8 a = *(const bf16x8*)(hs + fr * 136 + ks * 32 + fq * 8);
      acc = __builtin_amdgcn_mfma_f32_16x16x32_bf16(a, cb[ks], acc, 0, 0, 0);
    }
    if (DIR == 0) {
#pragma unroll
      for (int jx = 0; jx < 4; ++jx) ys[(nsb * 16 + fq * 4 + jx) * 16 + fr] = f2bf(acc[jx]);
    } else {
#pragma unroll
      for (int jx = 0; jx < 4; ++jx) {
        const int tl = nsb * 16 + fq * 4 + jx;
        const size_t r = row0 + tl;
        float uval = bf2f(uraw[jx]);
        float y = acc[jx] + bf2f(ys[tl * 16 + fr]) + dsk * uval;
        float t3 = 0.7978845608028654f * (y + 0.044715f * y * y * y);
        float gl = y * (1.f - 1.f / (1.f + __expf(2.f * t3)));
        P.s5g[r * 256 + col] = f2bf(gl);
      }
    }
  }
}
#define S5_WAVE_LDS (16 * S5_BU_STRIDE * 4 + 16 * 136 * 2 + 128 * 16 * 2)
__device__ void unit_s5_p3(const Params& P, int l, int unit, char* smem) {
  const int wid = ltid() >> 6, lane = ltid() & 63;
  char* base = smem + wid * S5_WAVE_LDS;
  float* BuS = (float*)base;
  ushort_t* hs = (ushort_t*)(base + 16 * S5_BU_STRIDE * 4);
  ushort_t* ys = hs + 16 * 136;
  {
    int item = unit * NW + wid;
    int j = item % NCH, g = (item / NCH) % 16, b = item / (NCH * 16);
    s5_p3_dir<0>(P, l, b, g, j, lane, BuS, hs, ys);
    s5_p3_dir<1>(P, l, b, g, j, lane, BuS, hs, ys);
  }
}

struct MlRegs { uint4 k0, k1, q0, q1, v0, v1; float ig, fp; };
__device__ __forceinline__ void st16(float* dst, uint4 a, uint4 b) {
  float f[16];
  unpack8(a, f); unpack8(b, f + 8);
  float4* d = (float4*)dst;
  d[0] = make_float4(f[0], f[1], f[2], f[3]); d[1] = make_float4(f[4], f[5], f[6], f[7]);
  d[2] = make_float4(f[8], f[9], f[10], f[11]); d[3] = make_float4(f[12], f[13], f[14], f[15]);
}
__device__ __forceinline__ void ml_load(const Params& P, int l, int b, int h, int d, int j, int sb, int lane, bool need_q, MlRegs& R) {
  const int ti = lane >> 2, part = lane & 3;
  const int sl = sb * 16 + ti;
  const int nl = d == 0 ? sl : 127 - sl;
  const size_t r = (size_t)(b * TOK + j * 128 + nl);
  const uint4* sk = (const uint4*)(P.mlqk + r * 512 + 256 + h * 64 + part * 16);
  R.k0 = sk[0]; R.k1 = sk[1];
  if (need_q) { const uint4* sq = (const uint4*)(P.mlqk + r * 512 + h * 64 + part * 16); R.q0 = sq[0]; R.q1 = sq[1]; }
  const uint4* sv = (const uint4*)(P.z + r * IND + ZC_MLV + h * 64 + part * 16);
  R.v0 = sv[0]; R.v1 = sv[1];
  if (part == 0) {
    R.ig = P.gates[r * 48 + (2 * d) * 4 + h] + P.ml_gate_b[l * 16 + (2 * d) * 4 + h];
    R.fp = P.gates[r * 48 + (2 * d + 1) * 4 + h] + P.ml_gate_b[l * 16 + (2 * d + 1) * 4 + h];
  }
}
__device__ __forceinline__ void ml_store(const MlRegs& R, int lane, bool need_q, float* ks, float* qs, float* vs, float* gs) {
  const int ti = lane >> 2, part = lane & 3;
  st16(ks + ti * 64 + part * 16, R.k0, R.k1);
  if (need_q) st16(qs + ti * 64 + part * 16, R.q0, R.q1);
  st16(vs + ti * 64 + part * 16, R.v0, R.v1);
  if (part == 0) { gs[ti * 2] = R.ig; gs[ti * 2 + 1] = logsigmoidf_(R.fp); }
}
#define ML_WAVE_LDS (3 * 1024 + 32)
__device__ __forceinline__ float wave_scan_add(float v, int lane) {
#pragma unroll
  for (int o = 1; o < 64; o <<= 1) { float t = __shfl_up(v, o); if (lane >= o) v += t; }
  return v;
}
__device__ __forceinline__ float wave_scan_max(float v, int lane) {
#pragma unroll
  for (int o = 1; o < 64; o <<= 1) { float t = __shfl_up(v, o); if (lane >= o) v = fmaxf(v, t); }
  return v;
}
#define ML3_ITEM_LDS 38912
__device__ void unit_ml_p1(const Params& P, int l, int unit, char* smem) {
  const int tid = ltid(), wid = tid >> 6, lane = tid & 63, r = lane & 31, h = lane >> 5;
  const int sub = wid >> 2, w4 = wid & 3, kt = w4 >> 1, vt = w4 & 1, t256 = tid & 255;
  const int item = unit * 2 + sub;
  const int c = item % NCH, d = (item / NCH) % 2, hh = (item / (NCH * 2)) % 4, b = item / (NCH * 8);
  const int j = dir_chunk(d, c);
  ushort_t* Ktc = (ushort_t*)(smem + sub * ML3_ITEM_LDS);
  ushort_t* Vtc = Ktc + 64 * 136;
  float* eS = (float*)(Vtc + 64 * 136);
  float* st = P.mlst + (size_t)item * MLST_SZ;
  const float LOG2E = 1.4426950408889634f;
  const size_t row0 = (size_t)(b * TOK + j * 128);
  __syncthreads();
  if (w4 == 0) {
    const float gbi = P.ml_gate_b[l * 16 + (2 * d) * 4 + hh], gbf = P.ml_gate_b[l * 16 + (2 * d + 1) * 4 + hh];
    float ig[2], lf[2];
#pragma unroll
    for (int q = 0; q < 2; ++q) {
      const int s = 2 * lane + q;
      const int nl = d == 0 ? s : 127 - s;
      ig[q] = P.gates[(row0 + nl) * 48 + (2 * d) * 4 + hh] + gbi;
      lf[q] = logsigmoidf_(P.gates[(row0 + nl) * 48 + (2 * d + 1) * 4 + hh] + gbf);
    }
    const float c1 = lf[0] + lf[1];
    const float incl = wave_scan_add(c1, lane);
    const float F0 = incl - c1 + lf[0], F1 = incl;
    const float b0 = ig[0] - F0, b1 = ig[1] - F1;
    float bm = fmaxf(b0, b1);
#pragma unroll
    for (int o = 32; o; o >>= 1) bm = fmaxf(bm, __shfl_xor(bm, o));
    const float Ftot = __shfl(incl, 63);
    eS[2 * lane] = __builtin_amdgcn_exp2f((b0 - bm) * LOG2E);
    eS[2 * lane + 1] = __builtin_amdgcn_exp2f((b1 - bm) * LOG2E);
    if (lane == 0) { st[4160] = Ftot + bm; st[4161] = Ftot; }
  }
  __syncthreads();
  {
    uint4 kx[4], vx[4];
#pragma unroll
    for (int i = 0; i < 4; ++i) {
      const int id = t256 + 256 * i, s = id >> 3, ck = id & 7;
      const int nl = d == 0 ? s : 127 - s;
      kx[i] = *(const uint4*)(P.mlqk + (row0 + nl) * 512 + 256 + hh * 64 + ck * 8);
      vx[i] = *(const uint4*)(P.z + (row0 + nl) * IND + ZC_MLV + hh * 64 + ck * 8);
    }
#pragma unroll
    for (int i = 0; i < 4; ++i) {
      const int id = t256 + 256 * i, s = id >> 3, ck = id & 7;
      const float es = eS[s];
      float kf[8];
      unpack8(kx[i], kf);
      ushort_t* kd = Ktc + (ck * 8) * 136 + s;
#pragma unroll
      for (int e = 0; e < 8; ++e) kd[e * 136] = f2bf(kf[e] * es);
      const uint4 vv = vx[i];
      ushort_t* vd = Vtc + (ck * 8) * 136 + s;
      vd[0 * 136] = (ushort_t)(vv.x & 0xffffu); vd[1 * 136] = (ushort_t)(vv.x >> 16);
      vd[2 * 136] = (ushort_t)(vv.y & 0xffffu); vd[3 * 136] = (ushort_t)(vv.y >> 16);
      vd[4 * 136] = (ushort_t)(vv.z & 0xffffu); vd[5 * 136] = (ushort_t)(vv.z >> 16);
      vd[6 * 136] = (ushort_t)(vv.w & 0xffffu); vd[7 * 136] = (ushort_t)(vv.w >> 16);
    }
  }
  __syncthreads();
  f32x16 C;
#pragma unroll
  for (int i = 0; i < 16; ++i) C[i] = 0.f;
  float nsum = 0.f;
#pragma unroll
  for (int ks = 0; ks < 8; ++ks) {
    const uint4 ar = *(const uint4*)(Ktc + (kt * 32 + r) * 136 + 16 * ks + 8 * h);
    const uint4 br = *(const uint4*)(Vtc + (vt * 32 + r) * 136 + 16 * ks + 8 * h);
    C = __builtin_amdgcn_mfma_f32_32x32x16_bf16(__builtin_bit_cast(bf16x8, ar), __builtin_bit_cast(bf16x8, br), C, 0, 0, 0);
    float af[8];
    unpack8(ar, af);
    nsum += ((af[0] + af[1]) + (af[2] + af[3])) + ((af[4] + af[5]) + (af[6] + af[7]));
  }
#pragma unroll
  for (int i = 0; i < 16; ++i) st[(size_t)(kt * 32 + (i & 3) + 8 * (i >> 2) + 4 * h) * 64 + vt * 32 + r] = C[i];
  nsum += __shfl_xor(nsum, 32);
  if (vt == 0 && h == 0) st[4096 + kt * 32 + r] = nsum;
}
__device__ void phase_ml_p2(const Params& P, int bid, int nblk) {
  const int wid = ltid() >> 6, lane = ltid() & 63;
  for (int it = bid * NW + wid; it < 16 * 65; it += nblk * NW) {
    int bhd = it / 65, slab = it % 65;
    int e = slab * 64 + lane;
    float st = 0.f, m = 0.f;
    float* base = P.mlst + (size_t)bhd * NCH * MLST_SZ;
    for (int c0 = 0; c0 < NCH; c0 += 26) {
      float x[26], gt[26], bt[26];
#pragma unroll
      for (int i = 0; i < 26; ++i) {
        const float* pc = base + (size_t)(c0 + i) * MLST_SZ;
        x[i] = pc[e]; gt[i] = pc[4160]; bt[i] = pc[4161];
      }
#pragma unroll
      for (int i = 0; i < 26; ++i) {
        float* pc = base + (size_t)(c0 + i) * MLST_SZ;
        float mn = fmaxf(bt[i] + m, gt[i]);
        float a = __expf(bt[i] + m - mn), s = __expf(gt[i] - mn);
        pc[e] = st;
        st = a * st + s * x[i];
        if (slab == 0 && lane == 0) pc[4162] = m;
        m = mn;
      }
    }
  }
}
__device__ void unit_ml_p3(const Params& P, int l, int unit, char* smem) {
  const int tid = ltid(), wid = tid >> 6, lane = tid & 63, r = lane & 31, h = lane >> 5;
  const int sub = wid >> 2, tt = wid & 3, t256 = tid & 255;
  const int item = unit * 2 + sub;
  const int c = item % NCH, d = (item / NCH) % 2, hh = (item / (NCH * 2)) % 4, b = item / (NCH * 8);
  const int j = dir_chunk(d, c);
  ushort_t* Kc = (ushort_t*)(smem + sub * ML3_ITEM_LDS);
  ushort_t* Vtc = Kc + 128 * 72;
  float* bS = (float*)(Vtc + 64 * 136);
  float* MS = bS + 128;
  float* FS = MS + 128;
  const float* st = P.mlst + (size_t)item * MLST_SZ;
  const float m_prev = st[4162];
  const float LOG2E = 1.4426950408889634f;
  const size_t row0 = (size_t)(b * TOK + j * 128);
  __syncthreads();
  {
    uint4 kx[4], vx[4];
#pragma unroll
    for (int i = 0; i < 4; ++i) {
      const int id = t256 + 256 * i, s = id >> 3, ck = id & 7;
      const int nl = d == 0 ? s : 127 - s;
      kx[i] = *(const uint4*)(P.mlqk + (row0 + nl) * 512 + 256 + hh * 64 + ck * 8);
      vx[i] = *(const uint4*)(P.z + (row0 + nl) * IND + ZC_MLV + hh * 64 + ck * 8);
    }
#pragma unroll
    for (int i = 0; i < 4; ++i) {
      const int id = t256 + 256 * i, s = id >> 3, ck = id & 7;
      *(uint4*)(Kc + s * 72 + ck * 8) = kx[i];
      const uint4 vv = vx[i];
      ushort_t* vd = Vtc + (ck * 8) * 136 + s;
      vd[0 * 136] = (ushort_t)(vv.x & 0xffffu); vd[1 * 136] = (ushort_t)(vv.x >> 16);
      vd[2 * 136] = (ushort_t)(vv.y & 0xffffu); vd[3 * 136] = (ushort_t)(vv.y >> 16);
      vd[4 * 136] = (ushort_t)(vv.z & 0xffffu); vd[5 * 136] = (ushort_t)(vv.z >> 16);
      vd[6 * 136] = (ushort_t)(vv.w & 0xffffu); vd[7 * 136] = (ushort_t)(vv.w >> 16);
    }
  }
  if (tt == 0) {
    const float gbi = P.ml_gate_b[l * 16 + (2 * d) * 4 + hh], gbf = P.ml_gate_b[l * 16 + (2 * d + 1) * 4 + hh];
    float ig[2], lf[2];
#pragma unroll
    for (int q = 0; q < 2; ++q) {
      const int s = 2 * lane + q;
      const int nl = d == 0 ? s : 127 - s;
      ig[q] = P.gates[(row0 + nl) * 48 + (2 * d) * 4 + hh] + gbi;
      lf[q] = logsigmoidf_(P.gates[(row0 + nl) * 48 + (2 * d + 1) * 4 + hh] + gbf);
    }
    const float c1 = lf[0] + lf[1];
    const float incl = wave_scan_add(c1, lane);
    const float F0 = incl - c1 + lf[0], F1 = incl;
    const float b0 = ig[0] - F0, b1 = ig[1] - F1;
    const float pm1 = fmaxf(b0, b1);
    const float pincl = wave_scan_max(pm1, lane);
    float pexcl = __shfl_up(pincl, 1);
    if (lane == 0) pexcl = -INFINITY;
    const float M0 = fmaxf(m_prev, fmaxf(pexcl, b0)), M1 = fmaxf(m_prev, pincl);
    bS[2 * lane] = b0; bS[2 * lane + 1] = b1;
    MS[2 * lane] = M0; MS[2 * lane + 1] = M1;
    FS[2 * lane] = F0; FS[2 * lane + 1] = F1;
  }
  __syncthreads();
  const int tl = tt * 32 + r;
  const size_t qrow = row0 + (d == 0 ? tl : 127 - tl);
  bf16x8 Qf[4];
#pragma unroll
  for (int ks = 0; ks < 4; ++ks) Qf[ks] = *(const bf16x8*)(P.mlqk + qrow * 512 + hh * 64 + 16 * ks + 8 * h);
  const float Mt = MS[tl], Mtc = Mt * LOG2E;
  f32x16 O[2];
#pragma unroll
  for (int mt = 0; mt < 2; ++mt)
#pragma unroll
    for (int i = 0; i < 16; ++i) O[mt][i] = 0.f;
  float dsum = 0.f;
  for (int ss = 0; ss <= tt; ++ss) {
    f32x16 S;
#pragma unroll
    for (int i = 0; i < 16; ++i) S[i] = 0.f;
#pragma unroll
    for (int ks = 0; ks < 4; ++ks) {
      const bf16x8 a = *(const bf16x8*)(Kc + (ss * 32 + r) * 72 + 16 * ks + 8 * h);
      S = __builtin_amdgcn_mfma_f32_32x32x16_bf16(a, Qf[ks], S, 0, 0, 0);
    }
    float p[16];
#pragma unroll
    for (int g = 0; g < 4; ++g) {
      const float4 bv = *(const float4*)(bS + ss * 32 + 8 * g + 4 * h);
      const float bb[4] = {bv.x, bv.y, bv.z, bv.w};
#pragma unroll
      for (int e = 0; e < 4; ++e) {
        const int sidx = ss * 32 + 8 * g + 4 * h + e;
        float w = __builtin_amdgcn_exp2f(fmaf(bb[e], LOG2E, -Mtc));
        if (sidx > tl) w = 0.f;
        const float pv = S[4 * g + e] * w;
        p[4 * g + e] = pv;
        dsum += pv;
      }
    }
    bf16x8 Pf[2];
#pragma unroll
    for (int s2 = 0; s2 < 2; ++s2) {
      uint4 w4;
      w4.x = pack2(p[8 * s2 + 0], p[8 * s2 + 1]); w4.y = pack2(p[8 * s2 + 2], p[8 * s2 + 3]);
      w4.z = pack2(p[8 * s2 + 4], p[8 * s2 + 5]); w4.w = pack2(p[8 * s2 + 6], p[8 * s2 + 7]);
      Pf[s2] = __builtin_bit_cast(bf16x8, w4);
    }
#pragma unroll
    for (int mt = 0; mt < 2; ++mt)
#pragma unroll
      for (int s2 = 0; s2 < 2; ++s2) {
        const ushort_t* vp = Vtc + (mt * 32 + r) * 136 + ss * 32 + 16 * s2 + 4 * h;
        const uint2 lo = *(const uint2*)(vp), hi = *(const uint2*)(vp + 8);
        const bf16x8 a = __builtin_bit_cast(bf16x8, make_uint4(lo.x, lo.y, hi.x, hi.y));
        O[mt] = __builtin_amdgcn_mfma_f32_32x32x16_bf16(a, Pf[s2], O[mt], 0, 0, 0);
      }
  }
  dsum += __shfl_xor(dsum, 32);
  f32x16 Oi[2];
#pragma unroll
  for (int mt = 0; mt < 2; ++mt)
#pragma unroll
    for (int i = 0; i < 16; ++i) Oi[mt][i] = 0.f;
  float nq = 0.f;
#pragma unroll
  for (int ks = 0; ks < 4; ++ks) {
    const int k0 = 16 * ks + 8 * h;
#pragma unroll
    for (int mt = 0; mt < 2; ++mt) {
      const float* cp = st + (size_t)k0 * 64 + mt * 32 + r;
      uint4 w4;
      w4.x = pack2(cp[0 * 64], cp[1 * 64]); w4.y = pack2(cp[2 * 64], cp[3 * 64]);
      w4.z = pack2(cp[4 * 64], cp[5 * 64]); w4.w = pack2(cp[6 * 64], cp[7 * 64]);
      Oi[mt] = __builtin_amdgcn_mfma_f32_32x32x16_bf16(__builtin_bit_cast(bf16x8, w4), Qf[ks], Oi[mt], 0, 0, 0);
    }
    float qf[8];
    unpack8(__builtin_bit_cast(uint4, Qf[ks]), qf);
    const float4 n0 = *(const float4*)(st + 4096 + k0), n1 = *(const float4*)(st + 4096 + k0 + 4);
    nq += n0.x * qf[0] + n0.y * qf[1] + n0.z * qf[2] + n0.w * qf[3] + n1.x * qf[4] + n1.y * qf[5] + n1.z * qf[6] + n1.w * qf[7];
  }
  nq += __shfl_xor(nq, 32);
  const float at = __builtin_amdgcn_exp2f(m_prev * LOG2E - Mtc);
  const float den = dsum + at * nq;
  const float mt_full = FS[tl] + Mt;
  const float inv = 1.f / fmaxf(fabsf(den), __builtin_amdgcn_exp2f(-mt_full * LOG2E));
  ushort_t* outp = d == 0 ? (P.mix + qrow * DM + 256 + hh * 64) : (P.z + qrow * IND + ZC_MLQ + hh * 64);
#pragma unroll
  for (int mt = 0; mt < 2; ++mt)
#pragma unroll
    for (int g = 0; g < 4; ++g) {
      const int v0 = mt * 32 + 8 * g + 4 * h;
      uint2 o;
      o.x = pack2((O[mt][4 * g + 0] + at * Oi[mt][4 * g + 0]) * inv, (O[mt][4 * g + 1] + at * Oi[mt][4 * g + 1]) * inv);
      o.y = pack2((O[mt][4 * g + 2] + at * Oi[mt][4 * g + 2]) * inv, (O[mt][4 * g + 3] + at * Oi[mt][4 * g + 3]) * inv);
      *(uint2*)(outp + v0) = o;
    }
}

#define GL_WAVE_LDS 13312
template <bool OUT>
__device__ void unit_gl_mfma(const Params& P, int unit, char* smem) {
  const int tid = ltid(), wid = tid >> 6, lane = tid & 63, r = lane & 31, h = lane >> 5;
  const int item = unit * NW + wid;
  const int c = item % NCH, d = (item / NCH) % 2, hh = (item / (NCH * 2)) % 4, b = item / (NCH * 8);
  const int j = dir_chunk(d, c);
  ushort_t* qT = (ushort_t*)(smem + wid * GL_WAVE_LDS);
  ushort_t* kT = qT + 32 * 40;
  ushort_t* kH = kT + 32 * 40;
  ushort_t* Vt = kH + 32 * 40;
  float* Dv = (float*)(Vt + 64 * 40);
  float* st = P.glast + (size_t)item * GLST_SZ;
  const size_t row0 = (size_t)(b * TOK + j * 128);
  f32x16 R[2];
#pragma unroll
  for (int vt = 0; vt < 2; ++vt)
#pragma unroll
    for (int i = 0; i < 16; ++i) R[vt][i] = OUT ? st[(size_t)((i & 3) + 8 * (i >> 2) + 4 * h) * 64 + vt * 32 + r] : 0.f;
  float aprod = 1.f;
  const float qscale = 0.17677669529663687f;
  for (int u = 0; u < 4; ++u) {
    __syncthreads();
    {
      float al[32];
      ushort_t xr[32];
      const int xcol = (h == 0 ? ZC_GLQ : ZC_GLK) + hh * 32 + r;
#pragma unroll
      for (int s2 = 0; s2 < 32; ++s2) {
        const int sp = 32 * u + s2;
        const size_t row = row0 + (d == 0 ? sp : 127 - sp);
        al[s2] = P.alpha[row * 256 + d * 128 + hh * 32 + r];
        xr[s2] = P.z[row * IND + xcol];
      }
      uint4 vv[4];
      {
        const int sp = 32 * u + (lane >> 1), vh = lane & 1;
        const size_t row = row0 + (d == 0 ? sp : 127 - sp);
        const uint4* sv = (const uint4*)(P.z + row * IND + ZC_GLV + hh * 64 + vh * 32);
#pragma unroll
        for (int q = 0; q < 4; ++q) vv[q] = sv[q];
      }
      float A = 1.f;
      float kr[32];
#pragma unroll
      for (int s2 = 0; s2 < 32; ++s2) {
        A *= al[s2];
        kr[s2] = (h == 0) ? bf2f(xr[s2]) * qscale * A : bf2f(xr[s2]) * __builtin_amdgcn_rcpf(A);
      }
      if (OUT) {
        ushort_t* dst = h == 0 ? qT : kT;
#pragma unroll
        for (int s2 = 0; s2 < 32; ++s2) dst[s2 * 40 + r] = f2bf(kr[s2]);
      }
      if (h == 1) {
        Dv[r] = A;
#pragma unroll
        for (int s2 = 0; s2 < 32; s2 += 2) *(unsigned*)(kH + r * 40 + s2) = pack2(kr[s2] * A, kr[s2 + 1] * A);
      } else {
        aprod *= A;
      }
#pragma unroll
      for (int q = 0; q < 4; ++q) {
        ushort_t* vd = Vt + ((lane & 1) * 32 + q * 8) * 40 + (lane >> 1);
        vd[0 * 40] = (ushort_t)(vv[q].x & 0xffffu); vd[1 * 40] = (ushort_t)(vv[q].x >> 16);
        vd[2 * 40] = (ushort_t)(vv[q].y & 0xffffu); vd[3 * 40] = (ushort_t)(vv[q].y >> 16);
        vd[4 * 40] = (ushort_t)(vv[q].z & 0xffffu); vd[5 * 40] = (ushort_t)(vv[q].z >> 16);
        vd[6 * 40] = (ushort_t)(vv[q].w & 0xffffu); vd[7 * 40] = (ushort_t)(vv[q].w >> 16);
      }
    }
    __syncthreads();
    if (OUT) {
      f32x16 Pm;
#pragma unroll
      for (int i = 0; i < 16; ++i) Pm[i] = 0.f;
#pragma unroll
      for (int ks = 0; ks < 2; ++ks) {
        const bf16x8 ak = *(const bf16x8*)(kT + r * 40 + 16 * ks + 8 * h);
        const bf16x8 bq = *(const bf16x8*)(qT + r * 40 + 16 * ks + 8 * h);
        Pm = __builtin_amdgcn_mfma_f32_32x32x16_bf16(ak, bq, Pm, 0, 0, 0);
      }
#pragma unroll
      for (int i = 0; i < 16; ++i) { const int sl = (i & 3) + 8 * (i >> 2) + 4 * h; if (sl > r) Pm[i] = 0.f; }
      f32x16 O[2];
#pragma unroll
      for (int vt = 0; vt < 2; ++vt)
#pragma unroll
        for (int i = 0; i < 16; ++i) O[vt][i] = 0.f;
#pragma unroll
      for (int s2 = 0; s2 < 2; ++s2) {
        uint4 w4;
        w4.x = pack2(Pm[8 * s2 + 0], Pm[8 * s2 + 1]); w4.y = pack2(Pm[8 * s2 + 2], Pm[8 * s2 + 3]);
        w4.z = pack2(Pm[8 * s2 + 4], Pm[8 * s2 + 5]); w4.w = pack2(Pm[8 * s2 + 6], Pm[8 * s2 + 7]);
        const bf16x8 Pf = __builtin_bit_cast(bf16x8, w4);
        const ushort_t* qp = qT + r * 40 + 16 * s2 + 4 * h;
        const uint2 ql = *(const uint2*)(qp), qh = *(const uint2*)(qp + 8);
        const bf16x8 Bq = __builtin_bit_cast(bf16x8, make_uint4(ql.x, ql.y, qh.x, qh.y));
#pragma unroll
        for (int vt = 0; vt < 2; ++vt) {
          const ushort_t* vp = Vt + (vt * 32 + r) * 40 + 16 * s2 + 4 * h;
          const uint2 lo = *(const uint2*)(vp), hi = *(const uint2*)(vp + 8);
          O[vt] = __builtin_amdgcn_mfma_f32_32x32x16_bf16(__builtin_bit_cast(bf16x8, make_uint4(lo.x, lo.y, hi.x, hi.y)), Pf, O[vt], 0, 0, 0);
          uint4 r4;
          r4.x = pack2(R[vt][8 * s2 + 0], R[vt][8 * s2 + 1]); r4.y = pack2(R[vt][8 * s2 + 2], R[vt][8 * s2 + 3]);
          r4.z = pack2(R[vt][8 * s2 + 4], R[vt][8 * s2 + 5]); r4.w = pack2(R[vt][8 * s2 + 6], R[vt][8 * s2 + 7]);
          O[vt] = __builtin_amdgcn_mfma_f32_32x32x16_bf16(__builtin_bit_cast(bf16x8, r4), Bq, O[vt], 0, 0, 0);
        }
      }
      const int tp = 32 * u + r;
      const size_t qrow = row0 + (d == 0 ? tp : 127 - tp);
      ushort_t* outp = d == 0 ? (P.mix + qrow * DM + 768 + hh * 64) : (P.z + qrow * IND + ZC_MLK + hh * 64);
#pragma unroll
      for (int vt = 0; vt < 2; ++vt)
#pragma unroll
        for (int g = 0; g < 4; ++g) {
          uint2 o;
          o.x = pack2(O[vt][4 * g + 0], O[vt][4 * g + 1]); o.y = pack2(O[vt][4 * g + 2], O[vt][4 * g + 3]);
          *(uint2*)(outp + vt * 32 + 8 * g + 4 * h) = o;
        }
    }
#pragma unroll
    for (int g = 0; g < 4; ++g) {
      const float4 dv = *(const float4*)(Dv + 8 * g + 4 * h);
#pragma unroll
      for (int vt = 0; vt < 2; ++vt) { R[vt][4 * g + 0] *= dv.x; R[vt][4 * g + 1] *= dv.y; R[vt][4 * g + 2] *= dv.z; R[vt][4 * g + 3] *= dv.w; }
    }
#pragma unroll
    for (int s2 = 0; s2 < 2; ++s2) {
      const bf16x8 ak = *(const bf16x8*)(kH + r * 40 + 16 * s2 + 8 * h);
#pragma unroll
      for (int vt = 0; vt < 2; ++vt) {
        const bf16x8 bv = *(const bf16x8*)(Vt + (vt * 32 + r) * 40 + 16 * s2 + 8 * h);
        R[vt] = __builtin_amdgcn_mfma_f32_32x32x16_bf16(ak, bv, R[vt], 0, 0, 0);
      }
    }
  }
  if (!OUT) {
#pragma unroll
    for (int vt = 0; vt < 2; ++vt)
#pragma unroll
      for (int i = 0; i < 16; ++i) st[(size_t)((i & 3) + 8 * (i >> 2) + 4 * h) * 64 + vt * 32 + r] = R[vt][i];
    if (h == 0) st[2048 + r] = aprod;
  }
}
__device__ void unit_gl_p1(const Params& P, int unit, char* smem) { unit_gl_mfma<false>(P, unit, smem); }
__device__ void phase_gl_p2(const Params& P, int bid, int nblk) {
  const int wid = ltid() >> 6, lane = ltid() & 63;
  for (int it = ((bid + nblk - 130 % nblk) % nblk) * NW + wid; it < 16 * 32; it += nblk * NW) {
    int bhd = it / 32, slab = it % 32;
    int e = slab * 64 + lane;
    float st = 0.f;
    float* base = P.glast + (size_t)bhd * NCH * GLST_SZ;
    for (int c0 = 0; c0 < NCH; c0 += 26) {
      float x[26], A[26];
#pragma unroll
      for (int i = 0; i < 26; ++i) {
        const float* pc = base + (size_t)(c0 + i) * GLST_SZ;
        x[i] = pc[e]; A[i] = pc[2048 + slab];
      }
#pragma unroll
      for (int i = 0; i < 26; ++i) {
        float* pc = base + (size_t)(c0 + i) * GLST_SZ;
        pc[e] = st;
        st = A[i] * st + x[i];
      }
    }
  }
}
__device__ void unit_gl_p3(const Params& P, int unit, char* smem) { unit_gl_mfma<true>(P, unit, smem); }
__device__ void phase_finish(const Params& P, int l, int bid, int nblk) {
  const int wid = ltid() >> 6, lane = ltid() & 63;
  const int ch = lane * 4;
  const float4 gml = *(const float4*)(P.ml_norm_g + l * 256 + ch);
  const float4 ggl = *(const float4*)(P.gla_norm_g + l * 64 + (ch & 63));
  const int nw = nblk * NW;
  for (int it0 = bid * NW + wid; it0 < NTOK * 2; it0 += 4 * nw) {
    uint2 a[4], bb[4], gz[4];
#pragma unroll
    for (int q = 0; q < 4; ++q) {
      const int it = it0 + q * nw;
      const int itc = it < NTOK * 2 ? it : it0;
      const int r = itc >> 1, which = itc & 1;
      a[q] = *(const uint2*)(P.mix + (size_t)r * DM + (which ? 768 : 256) + ch);
      bb[q] = *(const uint2*)(P.z + (size_t)r * IND + (which ? ZC_MLK : ZC_MLQ) + ch);
      gz[q] = *(const uint2*)(P.z + (size_t)r * IND + (which ? ZC_GLR : ZC_MLO) + ch);
    }
#pragma unroll
    for (int q = 0; q < 4; ++q) {
      const int it = it0 + q * nw;
      const int r = it >> 1, which = it & 1;
      float v[4];
      v[0] = __uint_as_float(a[q].x << 16) + __uint_as_float(bb[q].x << 16);
      v[1] = __uint_as_float(a[q].x & 0xffff0000u) + __uint_as_float(bb[q].x & 0xffff0000u);
      v[2] = __uint_as_float(a[q].y << 16) + __uint_as_float(bb[q].y << 16);
      v[3] = __uint_as_float(a[q].y & 0xffff0000u) + __uint_as_float(bb[q].y & 0xffff0000u);
      float ss = v[0] * v[0] + v[1] * v[1] + v[2] * v[2] + v[3] * v[3];
      ss += __shfl_xor(ss, 1); ss += __shfl_xor(ss, 2); ss += __shfl_xor(ss, 4); ss += __shfl_xor(ss, 8);
      const float rstd = rsqrtf(ss * (1.f / 64.f) + 1e-6f);
      const float gt[4] = {__uint_as_float(gz[q].x << 16), __uint_as_float(gz[q].x & 0xffff0000u), __uint_as_float(gz[q].y << 16),
                           __uint_as_float(gz[q].y & 0xffff0000u)};
      const float4 gn = which == 0 ? gml : ggl;
      const float gnv[4] = {gn.x, gn.y, gn.z, gn.w};
      float o[4];
#pragma unroll
      for (int i = 0; i < 4; ++i) {
        const float sg = sigmoidf_(gt[i]);
        o[i] = (v[i] * rstd * gnv[i]) * (which == 0 ? sg : gt[i] * sg);
      }
      if (it < NTOK * 2) {
        uint2 ov; ov.x = pack2(o[0], o[1]); ov.y = pack2(o[2], o[3]);
        *(uint2*)(P.mix + (size_t)r * DM + (which ? 768 : 256) + ch) = ov;
      }
    }
  }
}

__device__ void phase_vt(const Params& P, int bid, int nblk, char* smem) {
  ushort_t* tile = (ushort_t*)smem;
  const int tid = ltid();
  const int nitems = B_ * 4 * (TOK / 64);
  for (int it = bid; it < nitems; it += nblk) {
    const int tb = it % 260, head = (it / 260) % 4, b = it / 1040;
    __syncthreads();
    {
      int id = tid, tok = id >> 3, vc = id & 7;
      uint4 v = *(const uint4*)(P.z + (size_t)(b * TOK + tb * 64 + tok) * IND + ZC_DAV + head * 64 + vc * 8);
      unsigned* d = (unsigned*)(tile + tok * 66 + vc * 8);
      d[0] = v.x; d[1] = v.y; d[2] = v.z; d[3] = v.w;
    }
    __syncthreads();
    {
      int id = tid, v = id >> 3, tc = id & 7;
      unsigned w[4];
#pragma unroll
      for (int e = 0; e < 4; ++e)
        w[e] = (unsigned)tile[(tc * 8 + 2 * e) * 66 + v] | ((unsigned)tile[(tc * 8 + 2 * e + 1) * 66 + v] << 16);
      *(uint4*)(P.vt + (size_t)((b * 4 + head) * 64 + v) * TOK + tb * 64 + tc * 8) = make_uint4(w[0], w[1], w[2], w[3]);
    }
  }
}

__device__ void phase_attn(const Params& P, int l, int bid, int nblk, char* smem) {
  ushort_t* Ks = (ushort_t*)smem;
  ushort_t* Vt = Ks + 128 * 72;
  constexpr int SLOT = 128 * 72 + 64 * 136;
  const int tid = ltid(), wid = tid >> 6, lane = tid & 63, r = lane & 31, h = lane >> 5;
  const float lam_init = 0.8f - 0.6f * __expf(-0.3f * (float)l);
  float lam;
  {
    const float* lp = P.da_lam + l * 128;
    float s01 = 0.f, s23 = 0.f;
    for (int i = 0; i < 32; ++i) { s01 += lp[i] * lp[32 + i]; s23 += lp[64 + i] * lp[96 + i]; }
    lam = __expf(s01) - __expf(s23) + lam_init;
  }
  const float LOG2E = 1.4426950408889634f;
  const int nitems = 512 + 8;
  const int krow = tid >> 2, kck = (tid & 3) * 2;
  const int vrow = tid >> 3, vck = (tid & 7) * 2;
  for (int item = bid; item < nitems; item += nblk) {
    int b, head, q0, nkeys;
    if (item < 512) { int qb = item % 64; head = (item / 64) % 4; b = item / 256; q0 = CTX + qb * 256; nkeys = TOK; }
    else { int i2 = item - 512; head = i2 % 4; b = i2 / 4; q0 = 0; nkeys = CTX; }
    const size_t qrow = (size_t)(b * TOK + q0 + wid * 32 + r);
    bf16x8 Qf[2][2];
#pragma unroll
    for (int mp = 0; mp < 2; ++mp)
#pragma unroll
      for (int s = 0; s < 2; ++s) Qf[mp][s] = *(const bf16x8*)(P.z + qrow * IND + ZC_DAQ + head * 64 + mp * 32 + 16 * s + 8 * h);
    f32x16 O[2][2];
#pragma unroll
    for (int mp = 0; mp < 2; ++mp)
#pragma unroll
      for (int mt = 0; mt < 2; ++mt)
#pragma unroll
        for (int i = 0; i < 16; ++i) O[mp][mt][i] = 0.f;
    float m[2] = {0.f, 0.f}, lsum[2] = {0.f, 0.f};
    bf16x8 Bm[2];
#pragma unroll
    for (int mp = 0; mp < 2; ++mp)
#pragma unroll
      for (int e = 0; e < 8; ++e) Bm[mp][e] = 0;
    bf16x8 Aone;
#pragma unroll
    for (int e = 0; e < 8; ++e) Aone[e] = (h == 0 && e == 0) ? (short)0x3F80 : (short)0;
    const ushort_t* kbase = P.z + (size_t)(b * TOK) * IND + ZC_DAK + head * 64 + (size_t)krow * IND + kck * 8;
    const ushort_t* vbase = P.vt + (size_t)((b * 4 + head) * 64 + vrow) * TOK + vck * 8;
    ushort_t* kst = Ks + krow * 72 + kck * 8;
    ushort_t* vst = Vt + vrow * 136 + vck * 8;
    const int nst = nkeys / 128;
    uint4 ka0 = ((const uint4*)kbase)[0], ka1 = ((const uint4*)kbase)[1];
    uint4 va0 = ((const uint4*)vbase)[0], va1 = ((const uint4*)vbase)[1];
    uint4 kb0 = ka0, kb1 = ka1, vb0 = va0, vb1 = va1;
    if (nst > 1) {
      const uint4* kp = (const uint4*)(kbase + (size_t)128 * IND); const uint4* vp = (const uint4*)(vbase + 128);
      kb0 = kp[0]; kb1 = kp[1]; vb0 = vp[0]; vb1 = vp[1];
    }
    __syncthreads();
    ((uint4*)kst)[0] = ka0; ((uint4*)kst)[1] = ka1; ((uint4*)vst)[0] = va0; ((uint4*)vst)[1] = va1;
    ((uint4*)(kst + SLOT))[0] = kb0; ((uint4*)(kst + SLOT))[1] = kb1; ((uint4*)(vst + SLOT))[0] = vb0; ((uint4*)(vst + SLOT))[1] = vb1;
    __syncthreads();
    f32x16 Sc[2], Sn[2];
#pragma unroll
    for (int mp = 0; mp < 2; ++mp) {
#pragma unroll
      for (int i = 0; i < 16; ++i) { Sc[mp][i] = 0.f; Sn[mp][i] = 0.f; }
#pragma unroll
      for (int s2 = 0; s2 < 2; ++s2) {
        bf16x8 a = *(const bf16x8*)(Ks + r * 72 + mp * 32 + 16 * s2 + 8 * h);
        Sc[mp] = __builtin_amdgcn_mfma_f32_32x32x16_bf16(a, Qf[mp][s2], Sc[mp], 0, 0, 0);
      }
    }
    int rb = 0;
    for (int st = 0; st < nst; ++st) {
      const int rb1 = rb == 2 ? 0 : rb + 1, rb2 = rb1 == 2 ? 0 : rb1 + 1;
      const ushort_t* Kc = Ks + rb * SLOT;
      const ushort_t* Vc = Vt + rb * SLOT;
      const ushort_t* Kn = Ks + rb1 * SLOT;
      const bool stage2 = st + 2 < nst;
#pragma unroll
      for (int kb = 0; kb < 4; ++kb) {
        if (stage2 && kb == 0) { const uint4* kp = (const uint4*)(kbase + (size_t)((st + 2) * 128) * IND); ka0 = kp[0]; ka1 = kp[1]; }
        if (stage2 && kb == 2) { const uint4* vp = (const uint4*)(vbase + (st + 2) * 128); va0 = vp[0]; va1 = vp[1]; }
        const bool have_next = (kb < 3) || (st + 1 < nst);
        if (have_next) {
          const ushort_t* Kx = kb < 3 ? Kc + (kb + 1) * 32 * 72 : Kn;
#pragma unroll
          for (int mp = 0; mp < 2; ++mp) {
#pragma unroll
            for (int i = 0; i < 16; ++i) Sn[mp][i] = 0.f;
#pragma unroll
            for (int s2 = 0; s2 < 2; ++s2) {
              bf16x8 a = *(const bf16x8*)(Kx + r * 72 + mp * 32 + 16 * s2 + 8 * h);
              Sn[mp] = __builtin_amdgcn_mfma_f32_32x32x16_bf16(a, Qf[mp][s2], Sn[mp], 0, 0, 0);
            }
            Sn[mp] = __builtin_amdgcn_mfma_f32_32x32x16_bf16(Aone, Bm[mp], Sn[mp], 0, 0, 0);
          }
        }
        const bool first = (st == 0 && kb == 0);
#pragma unroll
        for (int mp = 0; mp < 2; ++mp) {
          float mx = Sc[mp][0];
#pragma unroll
          for (int i = 1; i < 16; ++i) mx = fmaxf(mx, Sc[mp][i]);
          mx = fmaxf(mx, __shfl_xor(mx, 32));
          if (first || __any(mx > 0.25f)) {
            const bool upd = first || mx > 0.25f;
            const float mn = upd ? bf2f(f2bf(m[mp] + mx + 0.25f)) : m[mp];
            const float dd = mn - m[mp];
            m[mp] = mn;
            const float al = first ? 1.f : __builtin_amdgcn_exp2f(-dd);
#pragma unroll
            for (int i = 0; i < 16; ++i) { Sc[mp][i] -= dd; Sn[mp][i] -= dd; O[mp][0][i] *= al; O[mp][1][i] *= al; }
            lsum[mp] *= al;
            Bm[mp][0] = (h == 0) ? (short)f2bf(-mn) : (short)0;
          }
          bf16x8 Pf[2];
          {
            float p[16];
            float ps = 0.f;
#pragma unroll
            for (int i = 0; i < 16; ++i) { p[i] = __builtin_amdgcn_exp2f(Sc[mp][i]); ps += p[i]; }
            lsum[mp] += ps;
#pragma unroll
            for (int s2 = 0; s2 < 2; ++s2) {
              uint4 w;
              w.x = pack2(p[8 * s2 + 0], p[8 * s2 + 1]); w.y = pack2(p[8 * s2 + 2], p[8 * s2 + 3]);
              w.z = pack2(p[8 * s2 + 4], p[8 * s2 + 5]); w.w = pack2(p[8 * s2 + 6], p[8 * s2 + 7]);
              Pf[s2] = __builtin_bit_cast(bf16x8, w);
            }
          }
#pragma unroll
          for (int mt = 0; mt < 2; ++mt)
#pragma unroll
            for (int s2 = 0; s2 < 2; ++s2) {
              const ushort_t* vp = Vc + (mt * 32 + r) * 136 + kb * 32 + 16 * s2 + 4 * h;
              uint2 lo = *(const uint2*)(vp), hi = *(const uint2*)(vp + 8);
              bf16x8 a = __builtin_bit_cast(bf16x8, make_uint4(lo.x, lo.y, hi.x, hi.y));
              O[mp][mt] = __builtin_amdgcn_mfma_f32_32x32x16_bf16(a, Pf[s2], O[mp][mt], 0, 0, 0);
            }
        }
        Sc[0] = Sn[0]; Sc[1] = Sn[1];
        if (stage2 && kb == 1) { ((uint4*)(kst + rb2 * SLOT))[0] = ka0; ((uint4*)(kst + rb2 * SLOT))[1] = ka1; }
        if (stage2 && kb == 3) { ((uint4*)(vst + rb2 * SLOT))[0] = va0; ((uint4*)(vst + rb2 * SLOT))[1] = va1; }
      }
      __syncthreads();
      rb = rb1;
    }
    const float l0 = lsum[0] + __shfl_xor(lsum[0], 32), l1 = lsum[1] + __shfl_xor(lsum[1], 32);
    const float i0 = 1.f / l0, i1 = lam / l1;
    float ss = 0.f;
#pragma unroll
    for (int mt = 0; mt < 2; ++mt)
#pragma unroll
      for (int i = 0; i < 16; ++i) {
        float v = O[0][mt][i] * i0 - O[1][mt][i] * i1;
        O[0][mt][i] = v;
        ss += v * v;
      }
    ss += __shfl_xor(ss, 32);
    const float rstd = rsqrtf(ss * (1.f / 64.f) + 1e-6f) * (1.f - lam_init);
    ushort_t* op = P.mix + qrow * DM + 512 + head * 64;
#pragma unroll
    for (int mt = 0; mt < 2; ++mt)
#pragma unroll
      for (int g = 0; g < 4; ++g) {
        const int v0 = mt * 32 + 8 * g + 4 * h;
        const float4 gn = *(const float4*)(P.da_norm_g + l * 64 + v0);
        uint2 o;
        o.x = pack2(O[0][mt][4 * g + 0] * rstd * gn.x, O[0][mt][4 * g + 1] * rstd * gn.y);
        o.y = pack2(O[0][mt][4 * g + 2] * rstd * gn.z, O[0][mt][4 * g + 3] * rstd * gn.w);
        *(uint2*)(op + v0) = o;
      }
  }
}

__device__ void phase_final(const Params& P, int bid, int nblk) {
  const int wid = ltid() >> 6, lane = ltid() & 63;
  float4 gg[4];
#pragma unroll
  for (int i = 0; i < 4; ++i) gg[i] = ((const float4*)P.final_norm_g)[lane + 64 * i];
  const int nw = nblk * NW;
  for (int q0 = bid * NW + wid; q0 < B_ * SEQ; q0 += 2 * nw) {
    const int q1 = q0 + nw;
    const bool has1 = q1 < B_ * SEQ;
    const int qq1 = has1 ? q1 : q0;
    const float4* x0 = (const float4*)(P.xres + (size_t)((q0 / SEQ) * TOK + CTX + q0 % SEQ) * DM);
    const float4* x1 = (const float4*)(P.xres + (size_t)((qq1 / SEQ) * TOK + CTX + qq1 % SEQ) * DM);
    float4 v0[4], v1[4];
#pragma unroll
    for (int i = 0; i < 4; ++i) { v0[i] = x0[lane + 64 * i]; v1[i] = x1[lane + 64 * i]; }
    float s0 = 0.f, s1 = 0.f;
#pragma unroll
    for (int i = 0; i < 4; ++i) {
      s0 += v0[i].x * v0[i].x + v0[i].y * v0[i].y + v0[i].z * v0[i].z + v0[i].w * v0[i].w;
      s1 += v1[i].x * v1[i].x + v1[i].y * v1[i].y + v1[i].z * v1[i].z + v1[i].w * v1[i].w;
    }
    s0 = wave_sum(s0); s1 = wave_sum(s1);
    const float rs0 = rsqrtf(s0 * (1.f / DM) + 1e-6f), rs1 = rsqrtf(s1 * (1.f / DM) + 1e-6f);
    float4* o0 = (float4*)(P.out + (size_t)q0 * DM);
    float4* o1 = (float4*)(P.out + (size_t)qq1 * DM);
#pragma unroll
    for (int i = 0; i < 4; ++i) {
      o0[lane + 64 * i] = make_float4(v0[i].x * rs0 * gg[i].x, v0[i].y * rs0 * gg[i].y, v0[i].z * rs0 * gg[i].z, v0[i].w * rs0 * gg[i].w);
      if (has1) o1[lane + 64 * i] = make_float4(v1[i].x * rs1 * gg[i].x, v1[i].y * rs1 * gg[i].y, v1[i].z * rs1 * gg[i].z, v1[i].w * rs1 * gg[i].w);
    }
  }
}

#define XB_TMO      128
#define XB_XCNT(j)  (256  + 64 * (j))
#define XB_XSUB(j)  (1280 + 64 * (j))
#define XB_XGEN(j)  (2304 + 64 * (j))
#define XB_TOP      3328
#define XB_TOPGEN   3392
#define XCD_BAR_WORDS 3456
#define XB_SPIN_CAP (1u << 20)
#define LAS __attribute__((address_space(3)))
__device__ __forceinline__ unsigned xb_ld(unsigned* p)              { return __hip_atomic_load(p, __ATOMIC_RELAXED, __HIP_MEMORY_SCOPE_AGENT); }
__device__ __forceinline__ unsigned xb_add(unsigned* p, unsigned v) { return __hip_atomic_fetch_add(p, v, __ATOMIC_RELAXED, __HIP_MEMORY_SCOPE_AGENT); }
__device__ __forceinline__ unsigned xb_xcc_id() { return (unsigned)__builtin_amdgcn_s_getreg((3 << 11) | 20) & 0xFu; }
#define XB_SPIN(cond, bar) do { unsigned _sp = 0; while (cond) { __builtin_amdgcn_s_sleep(1); \
    if ((++_sp & 255u) == 0u) { if (xb_ld(&(bar)[XB_TMO])) break; if (_sp > XB_SPIN_CAP) { atomicAdd(&(bar)[XB_TMO], 1u); break; } } } } while (0)
struct XcdBarrier { unsigned* bar; unsigned x; volatile LAS unsigned* st; };
__device__ __forceinline__ XcdBarrier xcd_barrier_post(unsigned* bar, volatile LAS unsigned* st) {
  XcdBarrier b; b.bar = bar; b.x = xb_xcc_id(); b.st = st;
  if (ltid() == 0) (void)xb_add(&bar[XB_XCNT(b.x)], 1u);
  return b;
}
__device__ __forceinline__ void xcd_barrier_complete(unsigned* bar, unsigned x, unsigned& nloc, unsigned& nx) {
  const unsigned G = gridDim.x * gridDim.y * gridDim.z;
  unsigned sum, cnt, mine, sp = 0u;
  for (;;) {
    sum = 0u; cnt = 0u; mine = 0u;
#pragma unroll
    for (unsigned j = 0; j < 16; ++j) { const unsigned c = xb_ld(&bar[XB_XCNT(j)]); sum += c; cnt += (c > 0u) ? 1u : 0u; mine = (j == x) ? c : mine; }
    if (sum == G) break;
    __builtin_amdgcn_s_sleep(1);
    if ((++sp & 255u) == 0u) { if (xb_ld(&bar[XB_TMO])) break; if (sp > XB_SPIN_CAP) { atomicAdd(&bar[XB_TMO], 1u); break; } }
  }
  nloc = mine > 0u ? mine : 1u; nx = cnt > 0u ? cnt : 1u;
}
__device__ __forceinline__ void xcd_barrier(const XcdBarrier& b) {
  asm volatile("s_waitcnt vmcnt(0)" ::: "memory");
  __syncthreads();
  if (ltid() == 0) {
    unsigned* bar = b.bar;
    __builtin_amdgcn_s_waitcnt(0);
    unsigned nloc = b.st[0], nx = b.st[1];
    if (nloc == 0u) { xcd_barrier_complete(bar, b.x, nloc, nx); b.st[0] = nloc; b.st[1] = nx; }
    const unsigned old = xb_add(&bar[XB_XSUB(b.x)], 1u);
    const unsigned gen = old / nloc;
    if (old + 1u == (gen + 1u) * nloc) {
      __builtin_amdgcn_fence(__ATOMIC_RELEASE, "agent");
      asm volatile("s_waitcnt vmcnt(0)" ::: "memory");
      const unsigned og = xb_add(&bar[XB_TOP], 1u);
      const unsigned tg = og / nx;
      if (og + 1u == (tg + 1u) * nx) xb_add(&bar[XB_TOPGEN], 1u);
      else XB_SPIN(xb_ld(&bar[XB_TOPGEN]) == tg, bar);
      __builtin_amdgcn_fence(__ATOMIC_ACQUIRE, "agent");
      xb_add(&bar[XB_XGEN(b.x)], 1u);
      asm volatile("s_waitcnt vmcnt(0)" ::: "memory");
    } else {
      XB_SPIN(xb_ld(&bar[XB_XGEN(b.x)]) == gen, bar);
      __builtin_amdgcn_fence(__ATOMIC_ACQUIRE, "agent");
      asm volatile("s_waitcnt vmcnt(0)" ::: "memory");
    }
  }
  __syncthreads();
}

constexpr int NPH = 11;
__device__ __forceinline__ int next_unit(unsigned* ctr, char* smem) {
  int* sh = (int*)(smem + SMEM_BYTES - 16);
  __syncthreads();
  if (ltid() == 0) *sh = (int)atomicAdd(ctr, 1u);
  __syncthreads();
  return *sh;
}
__device__ __forceinline__ void run_phase(const Params& P, int l, int ph, int bid, int nblk, char* smem) {
  bid = launder_s(bid); nblk = launder_s(nblk); l = launder_s(l);
  switch (ph) {
    case 0: phase_convw(P, l, bid, nblk, smem); phase_norm(P, l, 0, bid, nblk); break;
    case 1: gemm_phase<G_ZIN>(P, l, bid, nblk, smem); break;
    case 2: phase_vt(P, bid, nblk, smem); phase_prep(P, l, bid, nblk); break;
    case 3:
      for (;;) {
        const int u = next_unit(P.qctr + l * 2, smem);
        if (u >= 260 + 1040 + 1040) break;
        if (u < 260) unit_gl_p1(P, u, smem);
        else if (u < 1300) unit_s5_p1(P, l, u - 260, smem);
        else unit_ml_p1(P, l, u - 1300, smem);
      }
      break;
    case 4: phase_s5_p2(P, l, bid, nblk); phase_ml_p2(P, bid, nblk); phase_gl_p2(P, bid, nblk); __syncthreads();
            phase_attn(P, l, bid, nblk, smem); break;
    case 5:
      for (;;) {
        const int u = next_unit(P.qctr + l * 2 + 1, smem);
        if (u >= 520 + 260 + 1040) break;
        if (u < 520) unit_s5_p3(P, l, u, smem);
        else if (u < 780) unit_gl_p3(P, u - 520, smem);
        else unit_ml_p3(P, l, u - 780, smem);
      }
      break;
    case 6: phase_finish(P, l, bid, nblk); __syncthreads(); gemm_phase<G_GLU>(P, l, bid, nblk, smem); break;
    case 7: gemm_phase<G_WOUT>(P, l, bid, nblk, smem); break;
    case 8: phase_norm(P, l, 1, bid, nblk); break;
    case 9: gemm_phase<G_W1>(P, l, bid, nblk, smem); break;
    case 10: gemm_phase<G_W2>(P, l, bid, nblk, smem); break;
  }
}

#if MEGA
__global__ void __launch_bounds__(NT, 2) k_mega(Params P) {
  __shared__ __attribute__((aligned(16))) char smem[SMEM_BYTES];
  cg::grid_group grid = cg::this_grid();
  const int bid = blockIdx.x, nblk = gridDim.x;
  volatile LAS unsigned* st = (volatile LAS unsigned*)(smem + SMEM_BYTES - 32);
  if ((threadIdx.x & 63) == 0) g_wtab[hw_slot()] = threadIdx.x >> 6;
  if (threadIdx.x == 0) { st[0] = 0u; st[1] = 0u; }
  __syncthreads();
  for (int i = bid * NT + ltid(); i < XCD_BAR_WORDS; i += nblk * NT) P.xbar[i] = 0u;
  phase_init(P, bid, nblk, smem);
  grid.sync();
  XcdBarrier xb = xcd_barrier_post(P.xbar, st);
  for (int l = 0; l < DEPTH; ++l) {
    for (int ph = 0; ph < NPH; ++ph) {
#ifdef ONLYPH
      if (ph != ONLYPH) continue;
#endif
      run_phase(P, l, ph, bid, nblk, smem);
      xcd_barrier(xb);
#if PROBE >= 10 && PROBE <= 12
      if (ph == 3 || ph == 5) {
        const bool p3 = (ph == 5);
        if (PROBE == 10) { const int n = p3 ? 520 : 1040; for (int u = bid; u < n; u += nblk) { if (p3) unit_s5_p3(P, l, u, smem); else unit_s5_p1(P, l, u, smem); } }
        if (PROBE == 11) { for (int u = bid; u < 260; u += nblk) { if (p3) unit_gl_p3(P, u, smem); else unit_gl_p1(P, u, smem); } }
        if (PROBE == 12) { for (int u = bid; u < 1040; u += nblk) { if (p3) unit_ml_p3(P, l, u, smem); else unit_ml_p1(P, l, u, smem); } }
        xcd_barrier(xb);
      }
#elif PROBE == 8
      if (ph == 0 || ph == 8) { run_phase(P, l, ph, bid, nblk, smem); xcd_barrier(xb); }
      if (ph == 6) { gemm_phase<G_GLU>(P, l, bid, nblk, smem); xcd_barrier(xb); }
      if (ph == 2) { phase_prep(P, l, bid, nblk, true); xcd_barrier(xb); }
#endif
    }
  }
  phase_final(P, bid, nblk);
}
#endif

extern "C" void kernel_launch(void* const* d_in, const int* in_sizes, int n_in, void* d_out, int out_size, void* d_ws,
                              size_t ws_size, hipStream_t stream) {
  Params P{};
  const float** pp = (const float**)&P;
  for (int i = 0; i < 32; ++i) pp[i] = (const float*)d_in[i];
  P.out = (float*)d_out;
  char* w = (char*)d_ws;
  size_t off = 0;
  auto take = [&](size_t bytes) { char* p = w + off; off += (bytes + 255) & ~(size_t)255; return p; };
  P.xres = (float*)take((size_t)NTOK * DM * 4);
  char* R = take((size_t)NTOK * DFF * 2);
  P.z = (ushort_t*)R;
  P.mix = (ushort_t*)(R + (size_t)NTOK * IND * 2);
  P.hidden = (ushort_t*)R;
  P.wt_in = (ushort_t*)take((size_t)INDP * DM * 2);
  P.wt_out = (ushort_t*)take((size_t)DM * DM * 2);
  P.w1t = (ushort_t*)take((size_t)DFF * DM * 2);
  P.w2t = (ushort_t*)take((size_t)DM * DFF * 2);
  P.glut = (ushort_t*)take((size_t)256 * 256 * 2);
  P.mlqk = (ushort_t*)take((size_t)NTOK * 512 * 2);
  P.s5g = (ushort_t*)take((size_t)NTOK * 256 * 2);
  P.mlst = (float*)take((size_t)B_ * 4 * 2 * NCH * MLST_SZ * 4);
  P.mod = (float*)take((size_t)DEPTH * 3 * 6144 * 4);
  P.qctr = (unsigned*)take(256);
  P.s5tab = (uint4*)take((size_t)32 * 13 * 64 * 16);
  P.xbar = (unsigned*)take((size_t)XCD_BAR_WORDS * 4);
  if (off > ws_size) { fprintf(stderr, "ws too small: need %zu have %zu\n", off, ws_size); return; }
  char* o = (char*)d_out;
  size_t ooff = 0;
  auto otake = [&](size_t bytes) { char* p = o + ooff; ooff += (bytes + 255) & ~(size_t)255; return p; };
  P.h = (ushort_t*)otake((size_t)NTOK * DM * 2);
  {
    char* hb = (char*)P.h;
    size_t ho = 0;
    auto htake = [&](size_t bytes) { char* p = hb + ho; ho += (bytes + 255) & ~(size_t)255; return p; };
    P.alpha = (float*)htake((size_t)NTOK * 256 * 4);
    P.s5st = (float*)htake((size_t)B_ * 2 * 16 * NCH * 128 * 4);
    P.glast = (float*)htake((size_t)B_ * 4 * 2 * NCH * GLST_SZ * 4);
    if (ho > (size_t)NTOK * DM * 2) { fprintf(stderr, "alias overflow\n"); return; }
  }
  P.gates = (float*)otake((size_t)NTOK * 48 * 4);
  P.vt = (ushort_t*)otake((size_t)B_ * 4 * 64 * TOK * 2);
  if (ooff > (size_t)out_size * 4) { fprintf(stderr, "out scratch too small\n"); return; }

#if MEGA
  static int grid_blocks = 0;
  if (!grid_blocks) {
    int dev = 0, cus = 0, per_cu = 0;
    hipGetDevice(&dev);
    hipDeviceGetAttribute(&cus, hipDeviceAttributeMultiprocessorCount, dev);
    hipOccupancyMaxActiveBlocksPerMultiprocessor(&per_cu, k_mega, NT, 0);
    if (per_cu > 1) per_cu = 1;
    grid_blocks = cus * per_cu;
  }
  void* args[] = {&P};
  hipError_t e = hipLaunchCooperativeKernel((void*)k_mega, dim3(grid_blocks), dim3(NT), args, 0, stream);
  if (e != hipSuccess) fprintf(stderr, "cooperative launch failed: %s (grid %d)\n", hipGetErrorString(e), grid_blocks);
#endif
}
```
